# Optimizing an MI355X kernel written in HIP

```python
import jax
import jax.numpy as jnp
from jax import lax
import numpy as np

D_MODEL = 1024
BATCH = 4
SEQ = 4096
DEPTH = 2

POOL_WINDOWS = (2, 4, 8, 16)
POOL_GROUPS = 4
POOL_GROUP_W = D_MODEL // 16
POOL_W = POOL_GROUPS * POOL_GROUP_W
CONV_W = D_MODEL // 4
CONV_K = 31
RWKV_HEAD = 64
RWKV_W = D_MODEL // 2
RWKV_HEADS = RWKV_W // RWKV_HEAD
W_LORA = 32
A_LORA = 32
V_LORA = 16
G_LORA = 64
RWKV_COLS = 3 * RWKV_W + W_LORA + A_LORA + G_LORA
RWKV_SPLITS = (RWKV_W, 2 * RWKV_W, 3 * RWKV_W, 3 * RWKV_W + W_LORA, 3 * RWKV_W + W_LORA + A_LORA)
N_BRANCH = 3
OFF_CONV = POOL_W
OFF_RWKV = OFF_CONV + 2 * CONV_W
OFF_GATE = OFF_RWKV + RWKV_COLS
OFF_VRES = OFF_GATE + N_BRANCH * D_MODEL
IN_COLS = OFF_VRES
D_FF = 2816
N_EXPERTS = 8
TOP_K = 2
D_FF_EXPERT = 3584
N_DENSE = (DEPTH + 1) // 2
N_MOE = DEPTH // 2
RMS_EPS = 1e-6
LN_EPS = 1e-5
GN_EPS = 64e-5

kernel_name = 'hybrid_pool_conv_rwkv7_moe_adaln'


def _rms(x, g):
    xf = x.astype(jnp.float32)
    y = xf * lax.rsqrt(jnp.mean(xf * xf, axis=-1, keepdims=True) + RMS_EPS)
    return (y * g.astype(jnp.float32)).astype(x.dtype)


def _ada(x, c, w, b, g):
    mod = jax.nn.silu(c) @ w + b
    shift, scale, gate = jnp.split(mod, 3, axis=-1)
    h = _rms(x, g) * (1 + scale[:, None, :]) + shift[:, None, :]
    return h, gate[:, None, :]


def _shift(z):
    return jnp.pad(z, ((0, 0), (1, 0), (0, 0)))[:, :-1]


def _pool_mixer(u, pool_w, pool_scale, pool_proj):
    b_, s_, _ = u.shape
    uf = u.astype(jnp.float32).reshape(b_, s_, POOL_GROUPS, POOL_GROUP_W)
    cs = jnp.cumsum(uf, axis=1)
    pos = jnp.arange(1, s_ + 1, dtype=jnp.float32)
    outs = []
    for gi, win in enumerate(POOL_WINDOWS):
        csg = cs[:, :, gi]
        lag = jnp.pad(csg, ((0, 0), (win, 0), (0, 0)))[:, :s_]
        cnt = jnp.minimum(pos, float(win))[None, :, None]
        outs.append((csg - lag) / cnt - uf[:, :, gi])
    p = jnp.stack(outs, axis=2).astype(u.dtype)
    p = jnp.einsum('bsgc,gcd->bsgd', p, pool_w).reshape(b_, s_, POOL_W) * pool_scale
    return p @ pool_proj


def _conv_module(z, conv_w, conv_b, ln_g, ln_b, proj):
    a, b = jnp.split(z, 2, axis=-1)
    u = a * jax.nn.sigmoid(b)
    u = lax.conv_general_dilated(u, conv_w[:, None, :].astype(u.dtype), (1,), ((CONV_K - 1, 0),),
                                 dimension_numbers=('NWC', 'WIO', 'NWC'),
                                 feature_group_count=CONV_W) + conv_b
    uf = u.astype(jnp.float32)
    mean = jnp.mean(uf, axis=-1, keepdims=True)
    var = jnp.mean(jnp.square(uf - mean), axis=-1, keepdims=True)
    un = ((uf - mean) * lax.rsqrt(var + LN_EPS)).astype(u.dtype) * ln_g + ln_b
    return jax.nn.silu(un) @ proj


def _wkv7_scan(r, w, k, v, kk, a):
    def step(state, inp):
        r_t, w_t, k_t, v_t, kk_t, a_t = inp
        sa = jnp.einsum('bhij,bhj->bhi', state, -kk_t)
        state = (state * w_t[:, :, None, :]
                 + sa[..., None] * (kk_t * a_t)[:, :, None, :]
                 + v_t[..., None] * k_t[:, :, None, :])
        return state, jnp.einsum('bhij,bhj->bhi', state, r_t)
    b_, s_, h_, n_ = r.shape
    s0 = jnp.zeros((b_, h_, n_, n_), jnp.float32)
    xs = tuple(jnp.moveaxis(t, 1, 0) for t in (r, w, k, v, kk, a))
    _, out = lax.scan(step, s0, xs)
    return jnp.moveaxis(out, 0, 1)


def _rwkv7_branch(zr, mu, w0, w2, a0, a2, g2, k_scale, k_a, r_k, lnx_g, lnx_b, proj, vres):
    f32 = jnp.float32
    b_, s_, _ = zr.shape
    hd = lambda t: t.astype(f32).reshape(b_, s_, RWKV_HEADS, RWKV_HEAD)
    zr = zr + (_shift(zr) - zr) * mu
    r, k, v, wd, ad, gd = jnp.split(zr, RWKV_SPLITS, axis=-1)
    w = -jax.nn.softplus(-(w0 + jnp.tanh(wd) @ w2).astype(f32)) - 0.5
    decay = jnp.exp(-jnp.exp(w))
    a = jax.nn.sigmoid((a0 + ad @ a2).astype(f32))
    g = jax.nn.sigmoid(gd) @ g2
    if vres is not None:
        v_first, vd, v0, v2 = vres
        v = v + (v_first - v) * jax.nn.sigmoid(v0 + vd @ v2)
    kk = hd(k * k_scale)
    kk = kk / jnp.maximum(jnp.sqrt(jnp.sum(kk * kk, axis=-1, keepdims=True)), 1e-12)
    kh = hd(k * (1 + (a - 1) * k_a))
    rh = hd(r)
    vh = hd(v)
    o = _wkv7_scan(rh, hd(decay), kh, vh, kk, hd(a))
    mean = jnp.mean(o, axis=-1, keepdims=True)
    var = jnp.mean(jnp.square(o - mean), axis=-1, keepdims=True)
    o = ((o - mean) * lax.rsqrt(var + GN_EPS)).reshape(b_, s_, RWKV_W) * lnx_g + lnx_b
    bonus = jnp.sum(rh * kh * r_k.reshape(RWKV_HEADS, RWKV_HEAD), axis=-1, keepdims=True) * vh
    o = (o + bonus.reshape(b_, s_, RWKV_W)) * g
    return o.astype(zr.dtype) @ proj, v


def _swiglu(h, w1, w3, w2):
    return (jax.nn.silu(h @ w1) * (h @ w3)) @ w2


def _moe(h, router, w1, w3, w2):
    b_, s_, d_ = h.shape
    t = h.reshape(-1, d_)
    logits = (t @ router).astype(jnp.float32)
    vals, idx = lax.top_k(logits, TOP_K)
    wts = jax.nn.softmax(vals, axis=-1)
    gate = jnp.sum(jax.nn.one_hot(idx, N_EXPERTS, dtype=jnp.float32) * wts[..., None], axis=1).astype(h.dtype)
    y = jnp.zeros_like(t)
    for e in range(N_EXPERTS):
        y = y + gate[:, e:e + 1] * _swiglu(t, w1[e], w3[e], w2[e])
    return y.reshape(b_, s_, d_)


def setup_inputs(seed: int = 0) -> dict:
    key = jax.random.key(seed)
    ks = iter(jax.random.split(key, 64))
    nrm = lambda shape, s: jax.random.normal(next(ks), shape, jnp.float32) * s
    uni = lambda shape: jax.random.uniform(next(ks), shape, jnp.float32)
    D = D_MODEL
    L = DEPTH
    LV = DEPTH - 1
    w0 = jnp.broadcast_to(jnp.linspace(-6.0, 1.0, RWKV_W, dtype=jnp.float32), (L, RWKV_W)) + nrm((L, RWKV_W), 0.1)
    return {
        'x': nrm((BATCH, SEQ, D), 1.0),
        'c': nrm((BATCH, D), 1.0),
        'ada_w': nrm((L, 2, D, 3 * D), 0.5 * D ** -0.5),
        'ada_b': nrm((L, 2, 3 * D), 0.01),
        'norm_g': 1.0 + nrm((L, 2, D), 0.02),
        'w_in': nrm((L, D, IN_COLS), D ** -0.5),
        'pool_w': nrm((L, POOL_GROUPS, POOL_GROUP_W, POOL_GROUP_W), POOL_GROUP_W ** -0.5),
        'pool_scale': 1.0 + nrm((L, POOL_W), 0.1),
        'pool_proj': nrm((L, POOL_W, D), POOL_W ** -0.5),
        'conv_w': nrm((L, CONV_K, CONV_W), CONV_K ** -0.5),
        'conv_b': nrm((L, CONV_W), 0.01),
        'conv_ln_g': 1.0 + nrm((L, CONV_W), 0.02),
        'conv_ln_b': nrm((L, CONV_W), 0.01),
        'conv_proj': nrm((L, CONV_W, D), CONV_W ** -0.5),
        'rwkv_mu': uni((L, RWKV_COLS)),
        'rwkv_w0': w0,
        'rwkv_w2': nrm((L, W_LORA, RWKV_W), 0.5 * W_LORA ** -0.5),
        'rwkv_a0': nrm((L, RWKV_W), 0.1),
        'rwkv_a2': nrm((L, A_LORA, RWKV_W), 0.5 * A_LORA ** -0.5),
        'rwkv_g2': nrm((L, G_LORA, RWKV_W), G_LORA ** -0.5),
        'rwkv_kk_scale': 0.85 + nrm((L, RWKV_W), 0.05),
        'rwkv_ka': 1.0 + nrm((L, RWKV_W), 0.05),
        'rwkv_rk': nrm((L, RWKV_W), 0.1),
        'rwkv_lnx_g': 1.0 + nrm((L, RWKV_W), 0.02),
        'rwkv_lnx_b': nrm((L, RWKV_W), 0.01),
        'rwkv_proj': nrm((L, RWKV_W, D), RWKV_W ** -0.5),
        'vres_w_down': nrm((LV, D, V_LORA), D ** -0.5),
        'vres_mu': uni((LV, V_LORA)),
        'vres_v0': 1.0 + nrm((LV, RWKV_W), 0.1),
        'vres_v2': nrm((LV, V_LORA, RWKV_W), 0.5 * V_LORA ** -0.5),
        'w_o': nrm((L, D, D), D ** -0.5),
        'ffn_w1': nrm((N_DENSE, D, D_FF), D ** -0.5),
        'ffn_w3': nrm((N_DENSE, D, D_FF), D ** -0.5),
        'ffn_w2': nrm((N_DENSE, D_FF, D), D_FF ** -0.5),
        'moe_router': nrm((N_MOE, D, N_EXPERTS), D ** -0.5),
        'moe_w1': nrm((N_MOE, N_EXPERTS, D, D_FF_EXPERT), D ** -0.5),
        'moe_w3': nrm((N_MOE, N_EXPERTS, D, D_FF_EXPERT), D ** -0.5),
        'moe_w2': nrm((N_MOE, N_EXPERTS, D_FF_EXPERT, D), D_FF_EXPERT ** -0.5),
        'final_norm_g': 1.0 + nrm((D,), 0.02),
    }


def reference(x, c, ada_w, ada_b, norm_g, w_in, pool_w, pool_scale, pool_proj,
              conv_w, conv_b, conv_ln_g, conv_ln_b, conv_proj,
              rwkv_mu, rwkv_w0, rwkv_w2, rwkv_a0, rwkv_a2, rwkv_g2, rwkv_kk_scale, rwkv_ka,
              rwkv_rk, rwkv_lnx_g, rwkv_lnx_b, rwkv_proj,
              vres_w_down, vres_mu, vres_v0, vres_v2, w_o,
              ffn_w1, ffn_w3, ffn_w2, moe_router, moe_w1, moe_w3, moe_w2, final_norm_g):
    v_first = None
    for l in range(DEPTH):
        h, gate = _ada(x, c, ada_w[l, 0], ada_b[l, 0], norm_g[l, 0])
        if l == 0:
            w_cat = w_in[l]
        else:
            w_cat = jnp.concatenate([w_in[l], vres_w_down[l - 1]], axis=1)
        z = h @ w_cat
        y_pool = _pool_mixer(z[..., :OFF_CONV], pool_w[l], pool_scale[l], pool_proj[l])
        y_conv = _conv_module(z[..., OFF_CONV:OFF_RWKV], conv_w[l], conv_b[l],
                              conv_ln_g[l], conv_ln_b[l], conv_proj[l])
        vres = None
        if l > 0:
            zv = z[..., OFF_VRES:]
            zv = zv + (_shift(zv) - zv) * vres_mu[l - 1]
            vres = (v_first, zv, vres_v0[l - 1], vres_v2[l - 1])
        y_rwkv, v_l = _rwkv7_branch(z[..., OFF_RWKV:OFF_GATE], rwkv_mu[l], rwkv_w0[l], rwkv_w2[l],
                                    rwkv_a0[l], rwkv_a2[l], rwkv_g2[l], rwkv_kk_scale[l], rwkv_ka[l],
                                    rwkv_rk[l], rwkv_lnx_g[l], rwkv_lnx_b[l], rwkv_proj[l], vres)
        if l == 0:
            v_first = v_l
        g_p, g_c, g_r = jnp.split(jax.nn.sigmoid(z[..., OFF_GATE:OFF_VRES]), N_BRANCH, axis=-1)
        merged = g_p * y_pool + g_c * y_conv + g_r * y_rwkv
        x = x + gate * (merged @ w_o[l])
        h, gate = _ada(x, c, ada_w[l, 1], ada_b[l, 1], norm_g[l, 1])
        if l % 2 == 0:
            i = l // 2
            y = _swiglu(h, ffn_w1[i], ffn_w3[i], ffn_w2[i])
        else:
            i = l // 2
            y = _moe(h, moe_router[i], moe_w1[i], moe_w3[i], moe_w2[i])
        x = x + gate * y
    return _rms(x, final_norm_g)
```

```cpp
#include <hip/hip_runtime.h>
#include <cstdint>
#include <cstdio>

#define DEV __device__ __forceinline__
#define LAS __attribute__((address_space(3)))
typedef unsigned short bf16;
typedef float f32x4 __attribute__((ext_vector_type(4)));
typedef float f32x2 __attribute__((ext_vector_type(2)));
typedef unsigned u32x4 __attribute__((ext_vector_type(4)));
typedef unsigned u32x2 __attribute__((ext_vector_type(2)));

constexpr int D = 1024, NB = 4, SEQ = 4096, T = NB * SEQ, NL = 2;
constexpr int IN_COLS = 5504, OFF_CONV = 256, OFF_RWKV = 768, OFF_GATE = 2432;
constexpr int RW = 512, NH = 8, HD = 64;
constexpr int DFF = 2816, NE = 8, DFE = 3584;
constexpr int ZR_W = 1792, ZG_W = 3072, ZP_W = 256, ZC_W = 512, ZN = 5632;
constexpr int NCH = 64, CH = 64;
constexpr int SCQ = 6 * 64;
constexpr float RMS_EPS = 1e-6f, LN_EPS = 1e-5f, GN_EPS = 64e-5f;

constexpr size_t MiB = 1u << 20;
constexpr size_t WS_CTL = 0;
constexpr size_t WS_MOD = 1 * MiB;
constexpr size_t WS_H = 51 * MiB;
constexpr size_t WS_U = 83 * MiB;
constexpr size_t WS_VF = 115 * MiB;
constexpr size_t WS_G = 147 * MiB;
constexpr size_t WS_BON = 163 * MiB;
constexpr size_t WS_ZG = 164 * MiB;
constexpr size_t WS_ZR = 260 * MiB;
constexpr size_t WS_ZP = 316 * MiB;
constexpr size_t WS_ZC = 324 * MiB;
constexpr size_t WS_LS = 260 * MiB;
constexpr size_t WS_PM = 292 * MiB;
constexpr size_t WS_SC = 340 * MiB;
constexpr size_t WS_MRG = 51 * MiB;
constexpr size_t WS_HID = 340 * MiB;
constexpr size_t WS_P2 = 260 * MiB;
constexpr size_t WS_LTOK = 83 * MiB;
constexpr size_t WS_LW = 84 * MiB;
constexpr size_t WS_Y = 85 * MiB;
constexpr size_t WS_EH = 149 * MiB;
constexpr size_t WS_EG = 261 * MiB;
constexpr size_t WS_NEED = 532 * MiB;

struct Params {
    const float* in[39];
    float* out; unsigned char* ws;
};

DEV float bf2f(bf16 b) { return __uint_as_float(((unsigned)b) << 16); }
DEV unsigned f2bf(float f) { unsigned u = __float_as_uint(f); return (u + 0x7fffu + ((u >> 16) & 1u)) >> 16; }
DEV unsigned pk2(float lo, float hi) { return f2bf(lo) | (f2bf(hi) << 16); }
typedef float f32x16 __attribute__((ext_vector_type(16)));
#define DPPF(old, x, ctrl, rmask) __builtin_bit_cast(float, __builtin_amdgcn_update_dpp(__builtin_bit_cast(int, (float)(old)), __builtin_bit_cast(int, (float)(x)), ctrl, rmask, 0xF, false))
DEV float wave_sum(float x) {
    x += DPPF(0.f, x, 0xB1, 0xF); x += DPPF(0.f, x, 0x4E, 0xF); x += DPPF(0.f, x, 0x141, 0xF); x += DPPF(0.f, x, 0x140, 0xF);
    x += DPPF(0.f, x, 0x142, 0xA); x += DPPF(0.f, x, 0x143, 0xC);
    return __builtin_bit_cast(float, __builtin_amdgcn_readlane(__builtin_bit_cast(int, x), 63));
}
#define SLD16(dst, ptr, off) asm volatile("s_load_dwordx16 %0, %1, %2 glc" : "=s"(dst) : "s"(ptr), "n"(off))
#define SLD4(dst, ptr, off) asm volatile("s_load_dwordx4 %0, %1, %2 glc" : "=s"(dst) : "s"(ptr), "n"(off))
DEV float sigmoidf_(float x) { return 1.0f / (1.0f + __expf(-x)); }
DEV float siluf_(float x) { return x / (1.0f + __expf(-x)); }
DEV float softplusf_(float y) { return fmaxf(y, 0.f) + log1pf(__expf(-fabsf(y))); }

DEV void mod_phase(const Params& p, LAS unsigned char* lds) {
    LAS float* sc = (LAS float*)lds;
    LAS float* red = (LAS float*)(lds + 16384);
    const int tid = threadIdx.x, lane = tid & 63, wv = tid >> 6;
    const float* c = p.in[1];
    for (int i = tid; i < 4096; i += 512) sc[i] = siluf_(c[i]);
    __syncthreads();
    float* MOD = (float*)(p.ws + WS_MOD);
    for (int item = blockIdx.x; item < 4 * 48; item += gridDim.x) {
        const int lk = item / 48, nb = item % 48, n = nb * 64 + lane;
        const float* W = p.in[2] + (size_t)lk * 1024 * 3072;
        float a0 = 0.f, a1 = 0.f, a2 = 0.f, a3 = 0.f;
        for (int k = wv * 128; k < wv * 128 + 128; ++k) {
            const float w = W[(size_t)k * 3072 + n];
            a0 += sc[k] * w; a1 += sc[1024 + k] * w; a2 += sc[2048 + k] * w; a3 += sc[3072 + k] * w;
        }
        red[(wv * 4 + 0) * 64 + lane] = a0; red[(wv * 4 + 1) * 64 + lane] = a1; red[(wv * 4 + 2) * 64 + lane] = a2; red[(wv * 4 + 3) * 64 + lane] = a3;
        __syncthreads();
        if (tid < 256) {
            const int b = tid >> 6; float s = p.in[3][lk * 3072 + n];
            for (int w8 = 0; w8 < 8; ++w8) s += red[(w8 * 4 + b) * 64 + lane];
            MOD[(size_t)(lk * 4 + b) * 3072 + n] = s;
        }
        __syncthreads();
    }
}

template <bool ROUTER>
DEV void norm_phase(const Params& p, int lk, const float* xin) {
    const int tid = threadIdx.x, lane = tid & 63, wv = tid >> 6;
    const int gw = blockIdx.x * 8 + wv, ngw = gridDim.x * 8;
    bf16* H = (bf16*)(p.ws + WS_H);
    const float* MOD = (const float*)(p.ws + WS_MOD);
    const float* g = p.in[4] + (size_t)lk * 1024;
    for (int r0 = gw * 8; r0 < T; r0 += ngw * 8) {
        const int b = r0 / SEQ;
        const float* mod = MOD + (size_t)(lk * 4 + b) * 3072;
        f32x4 gs[4], sh[4];
#pragma unroll
        for (int j = 0; j < 4; ++j) {
            const int d = 4 * lane + 256 * j;
            const f32x4 gg = *(const f32x4*)(g + d), scl = *(const f32x4*)(mod + 1024 + d);
            gs[j] = gg * (scl + 1.0f); sh[j] = *(const f32x4*)(mod + d);
        }
        for (int r = r0; r < r0 + 8; ++r) {
            const float* xr = xin + (size_t)r * D;
            f32x4 v[4]; float ss = 0.f;
#pragma unroll
            for (int j = 0; j < 4; ++j) { v[j] = *(const f32x4*)(xr + 4 * lane + 256 * j); ss += (v[j].x * v[j].x + v[j].y * v[j].y) + (v[j].z * v[j].z + v[j].w * v[j].w); }
            const float rstd = 1.0f / sqrtf(wave_sum(ss) * (1.0f / D) + RMS_EPS);
#pragma unroll
            for (int j = 0; j < 4; ++j) v[j] = v[j] * rstd * gs[j] + sh[j];
#pragma unroll
            for (int j = 0; j < 4; ++j) { u32x2 o; o.x = pk2(v[j].x, v[j].y); o.y = pk2(v[j].z, v[j].w); *(u32x2*)(H + (size_t)r * D + 4 * lane + 256 * j) = o; }
            if (ROUTER) {
                const float* R = p.in[34];
                float lg[8];
#pragma unroll
                for (int e = 0; e < 8; ++e) lg[e] = 0.f;
#pragma unroll
                for (int j = 0; j < 4; ++j)
#pragma unroll
                    for (int q = 0; q < 4; ++q) {
                        const int d = 4 * lane + 256 * j + q; const float hv = v[j][q];
                        const f32x4 w0 = *(const f32x4*)(R + (size_t)d * 8), w1 = *(const f32x4*)(R + (size_t)d * 8 + 4);
                        lg[0] += hv * w0.x; lg[1] += hv * w0.y; lg[2] += hv * w0.z; lg[3] += hv * w0.w;
                        lg[4] += hv * w1.x; lg[5] += hv * w1.y; lg[6] += hv * w1.z; lg[7] += hv * w1.w;
                    }
#pragma unroll
                for (int e = 0; e < 8; ++e) lg[e] = wave_sum(lg[e]);
                int ea = 0; float va = lg[0];
#pragma unroll
                for (int e = 1; e < 8; ++e) if (lg[e] > va) { va = lg[e]; ea = e; }
                int eb = -1; float vb = -3.0e38f;
#pragma unroll
                for (int e = 0; e < 8; ++e) if (e != ea && lg[e] > vb) { vb = lg[e]; eb = e; }
                const float wa = 1.0f / (1.0f + __expf(vb - va)), wb = 1.0f - wa;
                if (lane == 0) {
                    unsigned* cnt = (unsigned*)(p.ws + WS_CTL);
                    int* LT = (int*)(p.ws + WS_LTOK); float* LW = (float*)(p.ws + WS_LW);
                    const unsigned pa = atomicAdd(cnt + ea, 1u), pb = atomicAdd(cnt + eb, 1u);
                    LT[ea * T + pa] = r * 2 + 0; LW[ea * T + pa] = wa;
                    LT[eb * T + pb] = r * 2 + 1; LW[eb * T + pb] = wb;
                }
            }
        }
    }
}

DEV void mixer_phase(const Params& p, int l, LAS unsigned char* lds) {
    const bf16* Zr = (const bf16*)(p.ws + WS_ZR); const bf16* Zp = (const bf16*)(p.ws + WS_ZP); const bf16* Zc = (const bf16*)(p.ws + WS_ZC);
    bf16* U = (bf16*)(p.ws + WS_U); float* VF = (float*)(p.ws + WS_VF); bf16* G = (bf16*)(p.ws + WS_G); float* BON = (float*)(p.ws + WS_BON);
    float* SC = (float*)(p.ws + WS_SC);
    for (int blk = blockIdx.x; blk < T / 64; blk += gridDim.x) {
        int tid_ = threadIdx.x; asm volatile("" : "+v"(tid_));
        const int tid = tid_, lane = tid & 63, wv = __builtin_amdgcn_readfirstlane(tid >> 6);
        const int m0 = blk * 64, b = m0 / SEQ, tl0 = m0 % SEQ;
        {
            LAS bf16* sp = (LAS bf16*)lds;
            for (int ci = tid; ci < 79 * 32; ci += 512) {
                const int tt = ci >> 5, c8 = (ci & 31) * 8, tl = tl0 - 15 + tt;
                u32x4 v = (u32x4){0u, 0u, 0u, 0u};
                if (tl >= 0) v = *(const u32x4*)(Zp + (size_t)(b * SEQ + tl) * ZP_W + c8);
                *(LAS u32x4*)(sp + tt * 256 + c8) = v;
            }
            __syncthreads();
            const int ch = tid & 255, half = tid >> 8, gi = ch >> 6, win = 2 << gi;
            for (int i = half * 32; i < half * 32 + 32; ++i) {
                float s = 0.f;
                for (int q = 0; q < win; ++q) s += bf2f(sp[(i + 15 - q) * 256 + ch]);
                const int tl = tl0 + i; const float cnt = (float)((tl + 1) < win ? (tl + 1) : win);
                const float val = s / cnt - bf2f(sp[(i + 15) * 256 + ch]);
                U[(size_t)(m0 + i) * D + ch] = (bf16)f2bf(val);
            }
            __syncthreads();
        }
        {
            LAS float* ug = (LAS float*)lds;
            LAS float* cw = (LAS float*)(lds + 94 * 1024);
            for (int idx = tid; idx < 94 * 128; idx += 512) {
                const int tt = idx >> 7, c2 = (idx & 127) * 2, tl = tl0 - 30 + tt;
                float u0 = 0.f, u1 = 0.f;
                if (tl >= 0) {
                    const bf16* zr = Zc + (size_t)(b * SEQ + tl) * ZC_W;
                    const unsigned av = *(const unsigned*)(zr + c2), bv = *(const unsigned*)(zr + 256 + c2);
                    const float a0 = __uint_as_float(av << 16), a1 = __uint_as_float(av & 0xffff0000u), b0 = __uint_as_float(bv << 16), b1 = __uint_as_float(bv & 0xffff0000u);
                    u0 = a0 * sigmoidf_(b0); u1 = a1 * sigmoidf_(b1);
                }
                ug[tt * 256 + c2] = u0; ug[tt * 256 + c2 + 1] = u1;
            }
            const float* CW = p.in[9] + (size_t)l * 31 * 256;
            for (int idx = tid; idx < 31 * 256; idx += 512) cw[idx] = CW[idx];
            __syncthreads();
            const int c4 = 4 * lane;
            const f32x4 cb = *(const f32x4*)(p.in[10] + l * 256 + c4), lg = *(const f32x4*)(p.in[11] + l * 256 + c4), lb = *(const f32x4*)(p.in[12] + l * 256 + c4);
            for (int i = wv; i < 64; i += 8) {
                f32x4 acc = cb;
#pragma unroll 4
                for (int k = 0; k < 31; ++k) acc += *(const LAS f32x4*)(ug + (i + k) * 256 + c4) * *(const LAS f32x4*)(cw + k * 256 + c4);
                const float mean = wave_sum((acc.x + acc.y) + (acc.z + acc.w)) * (1.0f / 256.0f);
                const f32x4 d = acc - mean;
                const float var = wave_sum((d.x * d.x + d.y * d.y) + (d.z * d.z + d.w * d.w)) * (1.0f / 256.0f);
                const float rstd = 1.0f / sqrtf(var + LN_EPS);
                const f32x4 un = d * rstd * lg + lb;
                u32x2 o; o.x = pk2(siluf_(un.x), siluf_(un.y)); o.y = pk2(siluf_(un.z), siluf_(un.w));
                *(u32x2*)(U + (size_t)(m0 + i) * D + 256 + c4) = o;
            }
            __syncthreads();
        }
        {
            LAS float* LA = (LAS float*)lds;
            const float* mu = p.in[14] + (size_t)l * 1664;
            for (int idx = tid; idx < 64 * 144; idx += 512) {
                const int i = idx / 144, c = idx % 144, m = m0 + i, tl = tl0 + i;
                const float zt = bf2f(Zr[(size_t)m * ZR_W + 1536 + c]);
                const float zp = tl > 0 ? bf2f(Zr[(size_t)(m - 1) * ZR_W + 1536 + c]) : 0.f;
                const float mm = c < 128 ? mu[1536 + c] : p.in[27][c - 128];
                const float zs = zt + (zp - zt) * mm;
                LA[idx] = c < 32 ? tanhf(zs) : (c < 64 ? zs : (c < 128 ? sigmoidf_(zs) : zs));
            }
            const int ch = tid, hh = wv;
            const float mur = mu[ch], muk = mu[512 + ch], muv = mu[1024 + ch];
            const int fo = (lane >> 2) * 20 + (lane & 3);
            __syncthreads();
            {
                float w2c[32], a2c[32];
                int chA = ch; asm volatile("" : "+v"(chA));
#pragma unroll
                for (int j = 0; j < 32; ++j) { w2c[j] = p.in[16][(size_t)(l * 32 + j) * 512 + chA]; a2c[j] = p.in[18][(size_t)(l * 32 + j) * 512 + chA]; }
                const float w0 = p.in[15][l * 512 + ch], a0 = p.in[17][l * 512 + ch], ksc = p.in[20][l * 512 + ch], kac = p.in[21][l * 512 + ch], rkc = p.in[22][l * 512 + ch];
                float zrp = 0.f, zkp = 0.f;
                if (tl0 > 0) { const bf16* zr = Zr + (size_t)(m0 - 1) * ZR_W; zrp = bf2f(zr[ch]); zkp = bf2f(zr[512 + ch]); }
                for (int i = 0; i < 64; ++i) {
                    const int m = m0 + i, tl = tl0 + i;
                    const bf16* zr = Zr + (size_t)m * ZR_W;
                    const float zrt = bf2f(zr[ch]), zkt = bf2f(zr[512 + ch]);
                    const float r = zrt + (zrp - zrt) * mur, k = zkt + (zkp - zkt) * muk;
                    zrp = zrt; zkp = zkt;
                    float wl = w0, al = a0;
                    const LAS float* la = LA + i * 144;
#pragma unroll
                    for (int j = 0; j < 32; ++j) { wl += la[j] * w2c[j]; al += la[32 + j] * a2c[j]; }
                    const float w = -softplusf_(-wl) - 0.5f, decay = expf(-expf(w));
                    const float a = sigmoidf_(al);
                    float kk = k * ksc; const float nrm = sqrtf(wave_sum(kk * kk)); kk = kk / fmaxf(nrm, 1e-12f);
                    const float kp = k * (1.0f + (a - 1.0f) * kac), kka = kk * a;
                    const float bon = wave_sum(r * kp * rkc);
                    float* rec = SC + ((size_t)(b * NH + hh) * SEQ + tl) * SCQ + fo;
                    rec[0] = decay; rec[4] = kka; rec[8] = kp; rec[12] = r;
                    if (tl > 0) rec[16 - SCQ] = kk;
                    if (tl == SEQ - 1) rec[16] = 0.f;
                    if (lane == 0) BON[(size_t)m * NH + hh] = bon;
                }
            }
            {
                float g2c[64], v2c[16];
                int chB = ch; asm volatile("" : "+v"(chB));
#pragma unroll
                for (int j = 0; j < 64; ++j) g2c[j] = p.in[19][(size_t)(l * 64 + j) * 512 + chB];
#pragma unroll
                for (int j = 0; j < 16; ++j) v2c[j] = l ? p.in[29][(size_t)j * 512 + chB] : 0.f;
                const float v0 = l ? p.in[28][ch] : 0.f;
                float zvp = 0.f;
                if (tl0 > 0) zvp = bf2f(Zr[(size_t)(m0 - 1) * ZR_W + 1024 + ch]);
                for (int i = 0; i < 64; ++i) {
                    const int m = m0 + i, tl = tl0 + i;
                    const float zvt = bf2f(Zr[(size_t)m * ZR_W + 1024 + ch]);
                    float v = zvt + (zvp - zvt) * muv;
                    zvp = zvt;
                    float gl = 0.f, vl = v0;
                    const LAS float* la = LA + i * 144;
#pragma unroll
                    for (int j = 0; j < 64; ++j) gl += la[64 + j] * g2c[j];
                    if (l) {
#pragma unroll
                        for (int j = 0; j < 16; ++j) vl += la[128 + j] * v2c[j];
                        v = v + (VF[(size_t)m * RW + ch] - v) * sigmoidf_(vl);
                    } else VF[(size_t)m * RW + ch] = v;
                    SC[((size_t)(b * NH + hh) * SEQ + tl) * SCQ + 320 + lane] = v;
                    G[(size_t)m * RW + ch] = (bf16)f2bf(gl);
                }
            }
            __syncthreads();
        }
    }
}

template <int MODE> DEV void blk4(float& s0, float& s1, float& s2, float& s3, const f32x16& a, const f32x4& c, float sa, float vv, float& o, float& san) {
    if (MODE == 2)
    asm volatile(
        "v_mul_f32 %0, %8, %0\n v_mul_f32 %1, %9, %1\n v_mul_f32 %2, %10, %2\n v_mul_f32 %3, %11, %3\n"
        "v_fmac_f32 %0, %12, %6\n v_fmac_f32 %1, %13, %6\n v_fmac_f32 %2, %14, %6\n v_fmac_f32 %3, %15, %6\n"
        "v_fmac_f32 %0, %16, %7\n v_fmac_f32 %1, %17, %7\n v_fmac_f32 %2, %18, %7\n v_fmac_f32 %3, %19, %7\n"
        "v_fmac_f32 %4, %20, %0\n v_fmac_f32 %5, %24, %0\n v_fmac_f32 %4, %21, %1\n v_fmac_f32 %5, %25, %1\n"
        "v_fmac_f32 %4, %22, %2\n v_fmac_f32 %5, %26, %2\n v_fmac_f32 %4, %23, %3\n v_fmac_f32 %5, %27, %3\n"
        : "+v"(s0), "+v"(s1), "+v"(s2), "+v"(s3), "+v"(o), "+v"(san)
        : "v"(sa), "v"(vv), "s"(a[0]), "s"(a[1]), "s"(a[2]), "s"(a[3]), "s"(a[4]), "s"(a[5]), "s"(a[6]), "s"(a[7]), "s"(a[8]), "s"(a[9]), "s"(a[10]), "s"(a[11]),
          "s"(a[12]), "s"(a[13]), "s"(a[14]), "s"(a[15]), "s"(c[0]), "s"(c[1]), "s"(c[2]), "s"(c[3]));
    if (MODE == 0)
    asm volatile(
        "v_mul_f32 %0, %8, %0\n v_mul_f32 %1, %9, %1\n v_mul_f32 %2, %10, %2\n v_mul_f32 %3, %11, %3\n"
        "v_fmac_f32 %0, %12, %6\n v_fmac_f32 %1, %13, %6\n v_fmac_f32 %2, %14, %6\n v_fmac_f32 %3, %15, %6\n"
        "v_fmac_f32 %0, %16, %7\n v_fmac_f32 %1, %17, %7\n v_fmac_f32 %2, %18, %7\n v_fmac_f32 %3, %19, %7\n"
        "v_fmac_f32 %5, %24, %0\n v_fmac_f32 %5, %25, %1\n v_fmac_f32 %5, %26, %2\n v_fmac_f32 %5, %27, %3\n"
        : "+v"(s0), "+v"(s1), "+v"(s2), "+v"(s3), "+v"(o), "+v"(san)
        : "v"(sa), "v"(vv), "s"(a[0]), "s"(a[1]), "s"(a[2]), "s"(a[3]), "s"(a[4]), "s"(a[5]), "s"(a[6]), "s"(a[7]), "s"(a[8]), "s"(a[9]), "s"(a[10]), "s"(a[11]),
          "s"(a[12]), "s"(a[13]), "s"(a[14]), "s"(a[15]), "s"(c[0]), "s"(c[1]), "s"(c[2]), "s"(c[3]));
    if (MODE == 1)
    asm volatile(
        "v_mul_f32 %0, %8, %0\n v_mul_f32 %1, %9, %1\n v_mul_f32 %2, %10, %2\n v_mul_f32 %3, %11, %3\n"
        "v_fmac_f32 %0, %12, %6\n v_fmac_f32 %1, %13, %6\n v_fmac_f32 %2, %14, %6\n v_fmac_f32 %3, %15, %6\n"
        "v_fmac_f32 %5, %24, %0\n v_fmac_f32 %5, %25, %1\n v_fmac_f32 %5, %26, %2\n v_fmac_f32 %5, %27, %3\n"
        : "+v"(s0), "+v"(s1), "+v"(s2), "+v"(s3), "+v"(o), "+v"(san)
        : "v"(sa), "v"(vv), "s"(a[0]), "s"(a[1]), "s"(a[2]), "s"(a[3]), "s"(a[4]), "s"(a[5]), "s"(a[6]), "s"(a[7]), "s"(a[8]), "s"(a[9]), "s"(a[10]), "s"(a[11]),
          "s"(a[12]), "s"(a[13]), "s"(a[14]), "s"(a[15]), "s"(c[0]), "s"(c[1]), "s"(c[2]), "s"(c[3]));
}
#define SCAN_BLK(MODE, JB, A, C, NA, NC, NOFF) \
    SLD16(NA, rec, NOFF); SLD4(NC, rec, NOFF + 64); \
    blk4<MODE>(S[JB * 4], S[JB * 4 + 1], S[JB * 4 + 2], S[JB * 4 + 3], A, C, sa, vv, o, san); \
    asm volatile("s_waitcnt lgkmcnt(0)" : "+s"(NA), "+s"(NC));
#define SCAN_STEP(MODE) \
    SCAN_BLK(MODE, 0, a0, c0, a1, c1, 80) SCAN_BLK(MODE, 1, a1, c1, a0, c0, 160) SCAN_BLK(MODE, 2, a0, c0, a1, c1, 240) SCAN_BLK(MODE, 3, a1, c1, a0, c0, 320) \
    SCAN_BLK(MODE, 4, a0, c0, a1, c1, 400) SCAN_BLK(MODE, 5, a1, c1, a0, c0, 480) SCAN_BLK(MODE, 6, a0, c0, a1, c1, 560) SCAN_BLK(MODE, 7, a1, c1, a0, c0, 640) \
    SCAN_BLK(MODE, 8, a0, c0, a1, c1, 720) SCAN_BLK(MODE, 9, a1, c1, a0, c0, 800) SCAN_BLK(MODE, 10, a0, c0, a1, c1, 880) SCAN_BLK(MODE, 11, a1, c1, a0, c0, 960) \
    SCAN_BLK(MODE, 12, a0, c0, a1, c1, 1040) SCAN_BLK(MODE, 13, a1, c1, a0, c0, 1120) SCAN_BLK(MODE, 14, a0, c0, a1, c1, 1200) SCAN_BLK(MODE, 15, a1, c1, a0, c0, 1536)

DEV void scan_pass1(const Params& p) {
    const int lane = threadIdx.x & 63, wv = __builtin_amdgcn_readfirstlane(threadIdx.x >> 6);
    const float* SC = (const float*)(p.ws + WS_SC); float* LS = (float*)(p.ws + WS_LS); float* PM = (float*)(p.ws + WS_PM);
    for (int u = blockIdx.x * 8 + wv; u < 32 * NCH; u += gridDim.x * 8) {
        const int bh = u / NCH, c = u % NCH;
        const float* base = SC + ((size_t)bh * SEQ + (size_t)c * CH) * SCQ;
        float S[64];
        f32x16 a0, a1; f32x4 c0, c1;
        {
#pragma unroll
            for (int j = 0; j < 64; ++j) S[j] = 0.f;
            const float* rec = base; float sa = 0.f;
            SLD16(a0, rec, 0); SLD4(c0, rec, 64); asm volatile("s_waitcnt lgkmcnt(0)" : "+s"(a0), "+s"(c0));
            for (int t = 0; t < CH; ++t) {
                const float vv = rec[320 + lane]; float o = 0.f, san = 0.f;
                SCAN_STEP(0)
                sa = -san; rec += SCQ;
            }
            float* o = LS + ((size_t)u * 64 + lane) * 64;
#pragma unroll
            for (int j = 0; j < 64; j += 4) *(f32x4*)(o + j) = (f32x4){S[j], S[j + 1], S[j + 2], S[j + 3]};
        }
        if (c > 0) {
#pragma unroll
            for (int j = 0; j < 64; ++j) S[j] = (j == lane) ? 1.f : 0.f;
            const float* rec = base;
            float sa = -(rec - SCQ)[(lane >> 2) * 20 + 16 + (lane & 3)];
            SLD16(a0, rec, 0); SLD4(c0, rec, 64); asm volatile("s_waitcnt lgkmcnt(0)" : "+s"(a0), "+s"(c0));
            for (int t = 0; t < CH; ++t) {
                const float vv = 0.f; float o = 0.f, san = 0.f;
                SCAN_STEP(1)
                sa = -san; rec += SCQ;
            }
            float* o = PM + ((size_t)u * 64 + lane) * 64;
#pragma unroll
            for (int j = 0; j < 64; j += 4) *(f32x4*)(o + j) = (f32x4){S[j], S[j + 1], S[j + 2], S[j + 3]};
        }
    }
}
DEV void scan_carry(const Params& p, LAS unsigned char* lds) {
    LAS float* cur = (LAS float*)lds;
    const int tid = threadIdx.x, ri = tid >> 6, jp = tid & 63;
    float* LS = (float*)(p.ws + WS_LS); const float* PM = (const float*)(p.ws + WS_PM);
    for (int u = blockIdx.x; u < 32 * 8; u += gridDim.x) {
        const int bh = u >> 3, i = (u & 7) * 8 + ri;
        float s = 0.f;
        __syncthreads();
        cur[ri * 64 + jp] = 0.f;
        __syncthreads();
        for (int c = 0; c < NCH; ++c) {
            const float* Pc = PM + (size_t)(bh * NCH + c) * 4096;
            float* Lc = LS + (size_t)(bh * NCH + c) * 4096 + i * 64 + jp;
            float acc = *Lc;
            if (c > 0) {
#pragma unroll 16
                for (int j = 0; j < 64; ++j) acc += cur[ri * 64 + j] * Pc[j * 64 + jp];
            }
            *Lc = s;
            __syncthreads();
            s = acc; cur[ri * 64 + jp] = acc;
            __syncthreads();
        }
    }
}
DEV void scan_pass2(const Params& p, int l) {
    const int lane = threadIdx.x & 63, wv = __builtin_amdgcn_readfirstlane(threadIdx.x >> 6);
    const float* SC = (const float*)(p.ws + WS_SC); const float* LS = (const float*)(p.ws + WS_LS);
    const bf16* G = (const bf16*)(p.ws + WS_G); const float* BON = (const float*)(p.ws + WS_BON); bf16* U = (bf16*)(p.ws + WS_U);
    for (int u = blockIdx.x * 8 + wv; u < 32 * NCH; u += gridDim.x * 8) {
        const int bh = u / NCH, c = u % NCH, b = bh >> 3, hh = bh & 7;
        const float* rec = SC + ((size_t)bh * SEQ + (size_t)c * CH) * SCQ;
        const float lg = p.in[23][l * 512 + hh * 64 + lane], lb = p.in[24][l * 512 + hh * 64 + lane];
        float S[64];
        const float* s0 = LS + ((size_t)u * 64 + lane) * 64;
#pragma unroll
        for (int j = 0; j < 64; j += 4) { const f32x4 v = *(const f32x4*)(s0 + j); S[j] = v.x; S[j + 1] = v.y; S[j + 2] = v.z; S[j + 3] = v.w; }
        float sa = 0.f;
        f32x16 a0, a1; f32x4 c0, c1;
        if (c > 0) {
            const float* pr = rec - SCQ;
#pragma unroll
            for (int q = 0; q < 4; ++q) {
                f32x4 k0, k1, k2, k3;
                SLD4(k0, pr, q * 320 + 64); SLD4(k1, pr, q * 320 + 144); SLD4(k2, pr, q * 320 + 224); SLD4(k3, pr, q * 320 + 304);
                asm volatile("s_waitcnt lgkmcnt(0)" : "+s"(k0), "+s"(k1), "+s"(k2), "+s"(k3));
#pragma unroll
                for (int e = 0; e < 4; ++e) { sa -= S[q * 16 + e] * k0[e]; sa -= S[q * 16 + 4 + e] * k1[e]; sa -= S[q * 16 + 8 + e] * k2[e]; sa -= S[q * 16 + 12 + e] * k3[e]; }
            }
        }
        SLD16(a0, rec, 0); SLD4(c0, rec, 64); asm volatile("s_waitcnt lgkmcnt(0)" : "+s"(a0), "+s"(c0));
        for (int t = 0; t < CH; ++t) {
            const float vv = rec[320 + lane]; float o = 0.f, san = 0.f;
            SCAN_STEP(2)
            sa = -san; rec += SCQ;
            const int m = b * SEQ + c * CH + t;
            const float mean = wave_sum(o) * (1.0f / 64.0f), dlt = o - mean;
            const float var = wave_sum(dlt * dlt) * (1.0f / 64.0f);
            const float on = dlt * (1.0f / sqrtf(var + GN_EPS)) * lg + lb;
            const float res = (on + BON[(size_t)m * NH + hh] * vv) * bf2f(G[(size_t)m * RW + hh * 64 + lane]);
            U[(size_t)m * D + 512 + hh * 64 + lane] = (bf16)f2bf(res);
        }
    }
}

template <bool MOE>
DEV void final_phase(const Params& p) {
    const int lane = threadIdx.x & 63, wv = threadIdx.x >> 6;
    const float* g = p.in[38]; float* X = p.out;
    const bf16* Y = (const bf16*)(p.ws + WS_Y);
    const float* MOD = (const float*)(p.ws + WS_MOD);
    for (int r = blockIdx.x * 8 + wv; r < T; r += gridDim.x * 8) {
        const int b = r / SEQ;
        const float* gate = MOD + (size_t)(3 * 4 + b) * 3072 + 2048;
        f32x4 v[4]; float ss = 0.f;
#pragma unroll
        for (int j = 0; j < 4; ++j) {
            const int d = 4 * lane + 256 * j;
            v[j] = *(const f32x4*)(X + (size_t)r * D + d);
            if (MOE) {
                const u32x2 y0 = *(const u32x2*)(Y + (size_t)r * D + d), y1 = *(const u32x2*)(Y + (size_t)(T + r) * D + d);
                const f32x4 gt = *(const f32x4*)(gate + d);
                f32x4 ys;
                ys.x = __uint_as_float(y0.x << 16) + __uint_as_float(y1.x << 16); ys.y = __uint_as_float(y0.x & 0xffff0000u) + __uint_as_float(y1.x & 0xffff0000u);
                ys.z = __uint_as_float(y0.y << 16) + __uint_as_float(y1.y << 16); ys.w = __uint_as_float(y0.y & 0xffff0000u) + __uint_as_float(y1.y & 0xffff0000u);
                v[j] += gt * ys;
            }
            ss += (v[j].x * v[j].x + v[j].y * v[j].y) + (v[j].z * v[j].z + v[j].w * v[j].w);
        }
        const float rstd = 1.0f / sqrtf(wave_sum(ss) * (1.0f / D) + RMS_EPS);
#pragma unroll
        for (int j = 0; j < 4; ++j) { const int d = 4 * lane + 256 * j; *(f32x4*)(X + (size_t)r * D + d) = v[j] * rstd * *(const f32x4*)(g + d); }
    }
}

struct ColId { int z0, z1; DEV int operator()(int n) const { return n; } };
template <class ColMap, class Epi>
__global__ void __launch_bounds__(256) gemm_simple(const bf16* A, int lda, const int* rowmap, const unsigned* mcount, int M, const float* W, int ldw, int N, int K, ColMap cm, Epi epi) {
    __shared__ float As[16][68];
    __shared__ float Ws[16][68];
    const int Mr = mcount ? (int)*mcount : M;
    const int m0 = blockIdx.y * 64, n0 = blockIdx.x * 64;
    if (m0 >= Mr) return;
    const int tid = threadIdx.x, tx = tid & 15, ty = tid >> 4;
    float acc[4][4];
#pragma unroll
    for (int i = 0; i < 4; ++i)
#pragma unroll
        for (int j = 0; j < 4; ++j) acc[i][j] = 0.f;
    const int ar = tid >> 2, ak = (tid & 3) * 4;
    int arow = m0 + ar; if (arow >= Mr) arow = Mr - 1;
    const size_t aoff = (size_t)(rowmap ? (rowmap[arow] >> 1) : arow) * lda;
    const int wk = tid >> 4, wn = (tid & 15) * 4;
    int wc[4];
#pragma unroll
    for (int j = 0; j < 4; ++j) wc[j] = (n0 + wn + j < N) ? cm(n0 + wn + j) : -1;
    for (int k0 = 0; k0 < K; k0 += 16) {
        const u32x2 av = *(const u32x2*)(A + aoff + k0 + ak);
        As[ak + 0][ar] = __uint_as_float(av.x << 16); As[ak + 1][ar] = __uint_as_float(av.x & 0xffff0000u);
        As[ak + 2][ar] = __uint_as_float(av.y << 16); As[ak + 3][ar] = __uint_as_float(av.y & 0xffff0000u);
#pragma unroll
        for (int j = 0; j < 4; ++j) Ws[wk][wn + j] = wc[j] >= 0 ? W[(size_t)(k0 + wk) * ldw + wc[j]] : 0.f;
        __syncthreads();
#pragma unroll
        for (int k = 0; k < 16; ++k) {
            const f32x4 a = *(const f32x4*)&As[k][ty * 4], w = *(const f32x4*)&Ws[k][tx * 4];
#pragma unroll
            for (int i = 0; i < 4; ++i)
#pragma unroll
                for (int j = 0; j < 4; ++j) acc[i][j] += a[i] * w[j];
        }
        __syncthreads();
    }
#pragma unroll
    for (int i = 0; i < 4; ++i)
#pragma unroll
        for (int j = 0; j < 4; ++j) { const int m = m0 + ty * 4 + i, n = n0 + tx * 4 + j; if (m < Mr && n < N) epi(m, n, acc[i][j]); }
}

struct ColIn {
    int z0, z1;
    DEV int operator()(int n) const {
        if (n < 1664) return OFF_RWKV + n;
        if (n < 1792) return -1;
        if (n < 4864) return OFF_GATE + (n - 1792);
        if (n < 5120) return n - 4864;
        return OFF_CONV + (n - 5120);
    }
};
struct EpiZ { unsigned char* ws;
    DEV void operator()(int m, int n, float a) const {
        if (n < 1792) { if (n < 1664 || n >= 1680) ((bf16*)(ws + WS_ZR))[(size_t)m * ZR_W + n] = (bf16)f2bf(a); }
        else if (n < 4864) ((bf16*)(ws + WS_ZG))[(size_t)m * ZG_W + n - 1792] = (bf16)f2bf(sigmoidf_(a));
        else if (n < 5120) ((bf16*)(ws + WS_ZP))[(size_t)m * ZP_W + n - 4864] = (bf16)f2bf(a);
        else ((bf16*)(ws + WS_ZC))[(size_t)m * ZC_W + n - 5120] = (bf16)f2bf(a);
    } };
struct EpiZv { unsigned char* ws; int live, pad;
    DEV void operator()(int m, int n, float a) const { ((bf16*)(ws + WS_ZR))[(size_t)m * ZR_W + 1664 + n] = (bf16)f2bf(live ? a : 0.f); } };
struct EpiP2 { float* P2; const float* scale; int g, pad;
    DEV void operator()(int m, int n, float a) const { P2[(size_t)m * 256 + g * 64 + n] = a * scale[g * 64 + n]; } };
struct EpiMrg { float* acc; const bf16* Zg; int br, first;
    DEV void operator()(int m, int n, float a) const { const float v = bf2f(Zg[(size_t)m * ZG_W + br * 1024 + n]) * a; float* q = acc + (size_t)m * D + n; *q = first ? v : *q + v; } };
struct EpiRes { const float* xin; float* xout; const float* gate;
    DEV void operator()(int m, int n, float a) const { xout[(size_t)m * D + n] = xin[(size_t)m * D + n] + gate[(size_t)(m / SEQ) * 3072 + n] * a; } };
struct EpiBf { bf16* O; int ldo, pad; DEV void operator()(int m, int n, float a) const { O[(size_t)m * ldo + n] = (bf16)f2bf(a); } };
struct EpiSwi { bf16* O; const bf16* Gt; int ldo, pad; DEV void operator()(int m, int n, float a) const { O[(size_t)m * ldo + n] = (bf16)f2bf(siluf_(bf2f(Gt[(size_t)m * ldo + n])) * a); } };
struct EpiMoeOut { bf16* Y; const int* lt; const float* lw; DEV void operator()(int m, int n, float a) const { const int tk = lt[m]; Y[((size_t)(tk & 1) * T + (tk >> 1)) * D + n] = (bf16)f2bf(lw[m] * a); } };

__global__ void k_f32_to_bf16(const float* s, bf16* d, size_t n) { for (size_t i = (size_t)blockIdx.x * blockDim.x + threadIdx.x; i < n; i += (size_t)gridDim.x * blockDim.x) d[i] = (bf16)f2bf(s[i]); }

__global__ void __launch_bounds__(512, 2) k_mod(const Params p) { extern __shared__ __attribute__((aligned(16))) unsigned char lds[]; mod_phase(p, (LAS unsigned char*)lds); }
template <bool ROUTER> __global__ void __launch_bounds__(512, 2) k_norm(const Params p, int lk, const float* xin) { norm_phase<ROUTER>(p, lk, xin); }
__global__ void __launch_bounds__(512, 2) k_mixer(const Params p, int l) { extern __shared__ __attribute__((aligned(16))) unsigned char lds[]; mixer_phase(p, l, (LAS unsigned char*)lds); }
__global__ void __launch_bounds__(512, 2) k_scan1(const Params p) { scan_pass1(p); }
__global__ void __launch_bounds__(512, 2) k_carry(const Params p) { extern __shared__ __attribute__((aligned(16))) unsigned char lds[]; scan_carry(p, (LAS unsigned char*)lds); }
__global__ void __launch_bounds__(512, 2) k_scan2(const Params p, int l) { scan_pass2(p, l); }
template <bool MOE> __global__ void __launch_bounds__(512, 2) k_final(const Params p) { final_phase<MOE>(p); }
__global__ void k_fill(float* o, int n, float c) { int i = blockIdx.x * blockDim.x + threadIdx.x; if (i < n) o[i] = c; }

template <class CM, class E>
static void gemm(hipStream_t st, const bf16* A, int lda, const int* rowmap, const unsigned* mcount, int M, const float* W, int ldw, int N, int K, CM cm, E e) {
    dim3 grid((N + 63) / 64, (M + 63) / 64);
    hipLaunchKernelGGL((gemm_simple<CM, E>), grid, dim3(256), 0, st, A, lda, rowmap, mcount, M, W, ldw, N, K, cm, e);
}

constexpr int LDS_BYTES = 147456;

extern "C" void kernel_launch(void* const* d_in, const int* in_sizes, int n_in, void* d_out, int out_size, void* d_ws, size_t ws_size, hipStream_t stream) {
    if (n_in != 39 || out_size != T * D || ws_size < WS_NEED) { hipLaunchKernelGGL(k_fill, dim3((out_size + 255) / 256), dim3(256), 0, stream, (float*)d_out, out_size, 3.0f); return; }
    static bool attr = false;
    if (!attr) {
        hipFuncSetAttribute((const void*)k_mod, hipFuncAttributeMaxDynamicSharedMemorySize, LDS_BYTES);
        hipFuncSetAttribute((const void*)k_mixer, hipFuncAttributeMaxDynamicSharedMemorySize, LDS_BYTES);
        hipFuncSetAttribute((const void*)k_carry, hipFuncAttributeMaxDynamicSharedMemorySize, LDS_BYTES);
        attr = true;
    }
    Params p{};
    for (int i = 0; i < 39; ++i) p.in[i] = (const float*)d_in[i];
    p.out = (float*)d_out; p.ws = (unsigned char*)d_ws;
    unsigned char* ws = p.ws;
    const int G = 256;
    hipMemsetAsync(ws + WS_CTL, 0, 4096, stream);
    hipLaunchKernelGGL(k_mod, dim3(G), dim3(512), LDS_BYTES, stream, p);
    const float* MOD = (const float*)(ws + WS_MOD);
    bf16* H = (bf16*)(ws + WS_H); bf16* U = (bf16*)(ws + WS_U); bf16* MRG = (bf16*)(ws + WS_MRG);
    float* X = (float*)d_out;
    for (int l = 0; l < NL; ++l) {
        const float* xin = l == 0 ? p.in[0] : X;
        hipLaunchKernelGGL((k_norm<false>), dim3(G), dim3(512), 0, stream, p, l * 2 + 0, xin);
        gemm(stream, H, D, nullptr, nullptr, T, p.in[5] + (size_t)l * D * IN_COLS, IN_COLS, ZN, D, ColIn{0, 0}, EpiZ{ws});
        gemm(stream, H, D, nullptr, nullptr, T, p.in[26], 16, 16, D, ColId{0, 0}, EpiZv{ws, l, 0});
        hipLaunchKernelGGL(k_mixer, dim3(G), dim3(512), LDS_BYTES, stream, p, l);
        hipLaunchKernelGGL(k_scan1, dim3(G), dim3(512), 0, stream, p);
        hipLaunchKernelGGL(k_carry, dim3(G), dim3(512), LDS_BYTES, stream, p);
        hipLaunchKernelGGL(k_scan2, dim3(G), dim3(512), 0, stream, p, l);
        float* P2 = (float*)(ws + WS_P2);
        for (int g = 0; g < 4; ++g)
            gemm(stream, U + g * 64, D, nullptr, nullptr, T, p.in[6] + (size_t)(l * 4 + g) * 64 * 64, 64, 64, 64, ColId{0, 0}, EpiP2{P2, p.in[7] + l * 256, g, 0});
        bf16* P2b = (bf16*)(ws + WS_P2 + 16 * MiB);
        hipLaunchKernelGGL(k_f32_to_bf16, dim3(1024), dim3(256), 0, stream, (const float*)P2, P2b, (size_t)T * 256);
        float* ACC = (float*)(ws + WS_P2 + 24 * MiB);
        const bf16* Zg = (const bf16*)(ws + WS_ZG);
        gemm(stream, P2b, 256, nullptr, nullptr, T, p.in[8] + (size_t)l * 256 * D, D, D, 256, ColId{0, 0}, EpiMrg{ACC, Zg, 0, 1});
        gemm(stream, U + 256, D, nullptr, nullptr, T, p.in[13] + (size_t)l * 256 * D, D, D, 256, ColId{0, 0}, EpiMrg{ACC, Zg, 1, 0});
        gemm(stream, U + 512, D, nullptr, nullptr, T, p.in[25] + (size_t)l * 512 * D, D, D, 512, ColId{0, 0}, EpiMrg{ACC, Zg, 2, 0});
        hipLaunchKernelGGL(k_f32_to_bf16, dim3(1024), dim3(256), 0, stream, (const float*)ACC, MRG, (size_t)T * D);
        gemm(stream, MRG, D, nullptr, nullptr, T, p.in[30] + (size_t)l * D * D, D, D, D, ColId{0, 0}, EpiRes{xin, X, MOD + (size_t)((l * 2 + 0) * 4) * 3072 + 2048});
        if (l == 0) {
            hipLaunchKernelGGL((k_norm<false>), dim3(G), dim3(512), 0, stream, p, 1, (const float*)X);
            bf16* HG = (bf16*)(ws + WS_HID + 96 * MiB); bf16* HID = (bf16*)(ws + WS_HID);
            gemm(stream, H, D, nullptr, nullptr, T, p.in[31], DFF, DFF, D, ColId{0, 0}, EpiBf{HG, DFF, 0});
            gemm(stream, H, D, nullptr, nullptr, T, p.in[32], DFF, DFF, D, ColId{0, 0}, EpiSwi{HID, HG, DFF, 0});
            gemm(stream, HID, DFF, nullptr, nullptr, T, p.in[33], D, D, DFF, ColId{0, 0}, EpiRes{X, X, MOD + (size_t)(1 * 4) * 3072 + 2048});
        } else {
            hipLaunchKernelGGL((k_norm<true>), dim3(G), dim3(512), 0, stream, p, 3, (const float*)X);
            const unsigned* cnt = (const unsigned*)(ws + WS_CTL);
            const int* LT = (const int*)(ws + WS_LTOK); const float* LW = (const float*)(ws + WS_LW);
            bf16* EH = (bf16*)(ws + WS_EH); bf16* EG = (bf16*)(ws + WS_EG); bf16* Y = (bf16*)(ws + WS_Y);
            for (int e = 0; e < NE; ++e) {
                gemm(stream, H, D, LT + e * T, cnt + e, T, p.in[35] + (size_t)e * D * DFE, DFE, DFE, D, ColId{0, 0}, EpiBf{EG, DFE, 0});
                gemm(stream, H, D, LT + e * T, cnt + e, T, p.in[36] + (size_t)e * D * DFE, DFE, DFE, D, ColId{0, 0}, EpiSwi{EH, EG, DFE, 0});
                gemm(stream, EH, DFE, nullptr, cnt + e, T, p.in[37] + (size_t)e * DFE * D, D, D, DFE, ColId{0, 0}, EpiMoeOut{Y, LT + e * T, LW + e * T});
            }
        }
    }
    hipLaunchKernelGGL((k_final<true>), dim3(G), dim3(512), 0, stream, p);
}
```

```cpp
#include <hip/hip_runtime.h>
#include <cstdint>
#include <cstdio>

#define DEV __device__ __forceinline__
#define LAS __attribute__((address_space(3)))
typedef unsigned short bf16;
typedef float f32x4 __attribute__((ext_vector_type(4)));
typedef float f32x2 __attribute__((ext_vector_type(2)));
typedef unsigned u32x4 __attribute__((ext_vector_type(4)));
typedef unsigned u32x2 __attribute__((ext_vector_type(2)));

constexpr int D = 1024, NB = 4, SEQ = 4096, T = NB * SEQ, NL = 2;
constexpr int IN_COLS = 5504, OFF_CONV = 256, OFF_RWKV = 768, OFF_GATE = 2432;
constexpr int RW = 512, NH = 8, HD = 64;
constexpr int DFF = 2816, NE = 8, DFE = 3584;
constexpr int ZR_W = 1792, ZG_W = 3072, ZP_W = 256, ZC_W = 512, ZN = 5632;
constexpr int NCH = 64, CH = 64;
constexpr int SCQ = 6 * 64;
constexpr float RMS_EPS = 1e-6f, LN_EPS = 1e-5f, GN_EPS = 64e-5f;

constexpr size_t MiB = 1u << 20;
constexpr size_t WS_CTL = 0;
constexpr size_t WS_MOD = 1 * MiB;
constexpr size_t WS_H = 51 * MiB;
constexpr size_t WS_U = 83 * MiB;
constexpr size_t WS_VF = 115 * MiB;
constexpr size_t WS_G = 147 * MiB;
constexpr size_t WS_BON = 163 * MiB;
constexpr size_t WS_ZG = 164 * MiB;
constexpr size_t WS_ZR = 260 * MiB;
constexpr size_t WS_ZP = 316 * MiB;
constexpr size_t WS_ZC = 324 * MiB;
constexpr size_t WS_LS = 260 * MiB;
constexpr size_t WS_PM = 292 * MiB;
constexpr size_t WS_SC = 340 * MiB;
constexpr size_t WS_WIN = 4 * MiB;
constexpr size_t WS_WMIX = 26 * MiB;
constexpr size_t WS_WO = 30 * MiB;
constexpr size_t WS_W13 = 34 * MiB;
constexpr size_t WS_W2 = 45 * MiB;
constexpr size_t WS_MRG = 51 * MiB;
constexpr size_t WS_HID = 340 * MiB;
constexpr size_t WS_MW13 = 83 * MiB;
constexpr size_t WS_MW2 = 195 * MiB;
constexpr size_t WS_HS = 251 * MiB;
constexpr size_t WS_EH = 319 * MiB;
constexpr size_t WS_Y = 438 * MiB;
constexpr size_t WS_LTOK = 502 * MiB;
constexpr size_t WS_LW = 503 * MiB;
constexpr size_t WS_ROWTK = 504 * MiB;
constexpr size_t WS_ROWW = 505 * MiB;
constexpr size_t WS_NEED = 532 * MiB;

struct Params {
    const float* in[39];
    float* out; unsigned char* ws;
};

DEV int tid_fresh() { int t = threadIdx.x; asm volatile("" : "+v"(t)); return t; }
DEV float bf2f(bf16 b) { return __uint_as_float(((unsigned)b) << 16); }
DEV unsigned f2bf(float f) { unsigned u = __float_as_uint(f); return (u + 0x7fffu + ((u >> 16) & 1u)) >> 16; }
DEV unsigned pk2(float lo, float hi) { return f2bf(lo) | (f2bf(hi) << 16); }
typedef float f32x16 __attribute__((ext_vector_type(16)));
#define DPPF(old, x, ctrl, rmask) __builtin_bit_cast(float, __builtin_amdgcn_update_dpp(__builtin_bit_cast(int, (float)(old)), __builtin_bit_cast(int, (float)(x)), ctrl, rmask, 0xF, false))
DEV float wave_sum(float x) {
    x += DPPF(0.f, x, 0xB1, 0xF); x += DPPF(0.f, x, 0x4E, 0xF); x += DPPF(0.f, x, 0x141, 0xF); x += DPPF(0.f, x, 0x140, 0xF);
    x += DPPF(0.f, x, 0x142, 0xA); x += DPPF(0.f, x, 0x143, 0xC);
    return __builtin_bit_cast(float, __builtin_amdgcn_readlane(__builtin_bit_cast(int, x), 63));
}
#define SLD16(dst, ptr, off) asm volatile("s_load_dwordx16 %0, %1, %2 glc" : "=s"(dst) : "s"(ptr), "n"(off))
#define SLD4(dst, ptr, off) asm volatile("s_load_dwordx4 %0, %1, %2 glc" : "=s"(dst) : "s"(ptr), "n"(off))
DEV float sigmoidf_(float x) { return 1.0f / (1.0f + __expf(-x)); }
DEV float siluf_(float x) { return x / (1.0f + __expf(-x)); }
DEV float softplusf_(float y) { return fmaxf(y, 0.f) + log1pf(__expf(-fabsf(y))); }

DEV void mod_phase(const Params& p, LAS unsigned char* lds) {
    LAS float* sc = (LAS float*)lds;
    LAS float* red = (LAS float*)(lds + 16384);
    const int tid = tid_fresh(), lane = tid & 63, wv = tid >> 6;
    const float* c = p.in[1];
    for (int i = tid; i < 4096; i += 512) sc[i] = siluf_(c[i]);
    __syncthreads();
    float* MOD = (float*)(p.ws + WS_MOD);
    for (int item = blockIdx.x; item < 4 * 48; item += gridDim.x) {
        const int lk = item / 48, nb = item % 48, n = nb * 64 + lane;
        const float* W = p.in[2] + (size_t)lk * 1024 * 3072;
        float a0 = 0.f, a1 = 0.f, a2 = 0.f, a3 = 0.f;
        for (int k = wv * 128; k < wv * 128 + 128; ++k) {
            const float w = W[(size_t)k * 3072 + n];
            a0 += sc[k] * w; a1 += sc[1024 + k] * w; a2 += sc[2048 + k] * w; a3 += sc[3072 + k] * w;
        }
        red[(wv * 4 + 0) * 64 + lane] = a0; red[(wv * 4 + 1) * 64 + lane] = a1; red[(wv * 4 + 2) * 64 + lane] = a2; red[(wv * 4 + 3) * 64 + lane] = a3;
        __syncthreads();
        if (tid < 256) {
            const int b = tid >> 6; float s = p.in[3][lk * 3072 + n];
            for (int w8 = 0; w8 < 8; ++w8) s += red[(w8 * 4 + b) * 64 + lane];
            MOD[(size_t)(lk * 4 + b) * 3072 + n] = s;
        }
        __syncthreads();
    }
}

template <bool ROUTER>
DEV void norm_phase(const Params& p, int lk, const float* xin) {
    const int tid = tid_fresh(), lane = tid & 63, wv = tid >> 6;
    const int gw = blockIdx.x * 8 + wv, ngw = gridDim.x * 8;
    bf16* H = (bf16*)(p.ws + WS_H);
    const float* MOD = (const float*)(p.ws + WS_MOD);
    const float* g = p.in[4] + (size_t)lk * 1024;
    for (int r0 = gw * 8; r0 < T; r0 += ngw * 8) {
        const int b = r0 / SEQ;
        const float* mod = MOD + (size_t)(lk * 4 + b) * 3072;
        f32x4 gs[4], sh[4];
#pragma unroll
        for (int j = 0; j < 4; ++j) {
            const int d = 4 * lane + 256 * j;
            const f32x4 gg = *(const f32x4*)(g + d), scl = *(const f32x4*)(mod + 1024 + d);
            gs[j] = gg * (scl + 1.0f); sh[j] = *(const f32x4*)(mod + d);
        }
        for (int r = r0; r < r0 + 8; ++r) {
            const float* xr = xin + (size_t)r * D;
            f32x4 v[4]; float ss = 0.f;
#pragma unroll
            for (int j = 0; j < 4; ++j) { v[j] = *(const f32x4*)(xr + 4 * lane + 256 * j); ss += (v[j].x * v[j].x + v[j].y * v[j].y) + (v[j].z * v[j].z + v[j].w * v[j].w); }
            const float rstd = 1.0f / sqrtf(wave_sum(ss) * (1.0f / D) + RMS_EPS);
#pragma unroll
            for (int j = 0; j < 4; ++j) v[j] = v[j] * rstd * gs[j] + sh[j];
#pragma unroll
            for (int j = 0; j < 4; ++j) { u32x2 o; o.x = pk2(v[j].x, v[j].y); o.y = pk2(v[j].z, v[j].w); *(u32x2*)(H + (size_t)r * D + 4 * lane + 256 * j) = o; }
            if (ROUTER) {
                const float* R = p.in[34];
                float lg[8];
#pragma unroll
                for (int e = 0; e < 8; ++e) lg[e] = 0.f;
#pragma unroll
                for (int j = 0; j < 4; ++j)
#pragma unroll
                    for (int q = 0; q < 4; ++q) {
                        const int d = 4 * lane + 256 * j + q; const float hv = v[j][q];
                        const f32x4 w0 = *(const f32x4*)(R + (size_t)d * 8), w1 = *(const f32x4*)(R + (size_t)d * 8 + 4);
                        lg[0] += hv * w0.x; lg[1] += hv * w0.y; lg[2] += hv * w0.z; lg[3] += hv * w0.w;
                        lg[4] += hv * w1.x; lg[5] += hv * w1.y; lg[6] += hv * w1.z; lg[7] += hv * w1.w;
                    }
#pragma unroll
                for (int e = 0; e < 8; ++e) lg[e] = wave_sum(lg[e]);
                int ea = 0; float va = lg[0];
#pragma unroll
                for (int e = 1; e < 8; ++e) if (lg[e] > va) { va = lg[e]; ea = e; }
                int eb = -1; float vb = -3.0e38f;
#pragma unroll
                for (int e = 0; e < 8; ++e) if (e != ea && lg[e] > vb) { vb = lg[e]; eb = e; }
                const float wa = 1.0f / (1.0f + __expf(vb - va)), wb = 1.0f - wa;
                if (lane == 0) {
                    unsigned* cnt = (unsigned*)(p.ws + WS_CTL);
                    int* LT = (int*)(p.ws + WS_LTOK); float* LW = (float*)(p.ws + WS_LW);
                    const unsigned pa = atomicAdd(cnt + ea, 1u), pb = atomicAdd(cnt + eb, 1u);
                    LT[ea * T + pa] = r * 2 + 0; LW[ea * T + pa] = wa;
                    LT[eb * T + pb] = r * 2 + 1; LW[eb * T + pb] = wb;
                }
            }
        }
    }
}

DEV void mixer_phase(const Params& p, int l, LAS unsigned char* lds) {
    const bf16* Zr = (const bf16*)(p.ws + WS_ZR); const bf16* Zp = (const bf16*)(p.ws + WS_ZP); const bf16* Zc = (const bf16*)(p.ws + WS_ZC);
    bf16* U = (bf16*)(p.ws + WS_U); float* VF = (float*)(p.ws + WS_VF); bf16* G = (bf16*)(p.ws + WS_G); float* BON = (float*)(p.ws + WS_BON);
    float* SC = (float*)(p.ws + WS_SC);
    for (int blk = blockIdx.x; blk < T / 64; blk += gridDim.x) {
        int tid_ = threadIdx.x; asm volatile("" : "+v"(tid_));
        const int tid = tid_, lane = tid & 63, wv = __builtin_amdgcn_readfirstlane(tid >> 6);
        const int m0 = blk * 64, b = m0 / SEQ, tl0 = m0 % SEQ;
        {
            LAS bf16* sp = (LAS bf16*)lds;
            for (int ci = tid; ci < 79 * 32; ci += 512) {
                const int tt = ci >> 5, c8 = (ci & 31) * 8, tl = tl0 - 15 + tt;
                u32x4 v = (u32x4){0u, 0u, 0u, 0u};
                if (tl >= 0) v = *(const u32x4*)(Zp + (size_t)(b * SEQ + tl) * ZP_W + c8);
                *(LAS u32x4*)(sp + tt * 256 + c8) = v;
            }
            __syncthreads();
            const int ch = tid & 255, half = tid >> 8, gi = ch >> 6, win = 2 << gi;
            for (int i = half * 32; i < half * 32 + 32; ++i) {
                float s = 0.f;
                for (int q = 0; q < win; ++q) s += bf2f(sp[(i + 15 - q) * 256 + ch]);
                const int tl = tl0 + i; const float cnt = (float)((tl + 1) < win ? (tl + 1) : win);
                const float val = s / cnt - bf2f(sp[(i + 15) * 256 + ch]);
                U[(size_t)(m0 + i) * D + ch] = (bf16)f2bf(val);
            }
            __syncthreads();
        }
        {
            LAS float* ug = (LAS float*)lds;
            LAS float* cw = (LAS float*)(lds + 94 * 1024);
            for (int idx = tid; idx < 94 * 128; idx += 512) {
                const int tt = idx >> 7, c2 = (idx & 127) * 2, tl = tl0 - 30 + tt;
                float u0 = 0.f, u1 = 0.f;
                if (tl >= 0) {
                    const bf16* zr = Zc + (size_t)(b * SEQ + tl) * ZC_W;
                    const unsigned av = *(const unsigned*)(zr + c2), bv = *(const unsigned*)(zr + 256 + c2);
                    const float a0 = __uint_as_float(av << 16), a1 = __uint_as_float(av & 0xffff0000u), b0 = __uint_as_float(bv << 16), b1 = __uint_as_float(bv & 0xffff0000u);
                    u0 = a0 * sigmoidf_(b0); u1 = a1 * sigmoidf_(b1);
                }
                ug[tt * 256 + c2] = u0; ug[tt * 256 + c2 + 1] = u1;
            }
            const float* CW = p.in[9] + (size_t)l * 31 * 256;
            for (int idx = tid; idx < 31 * 256; idx += 512) cw[idx] = CW[idx];
            __syncthreads();
            const int c4 = 4 * lane;
            const f32x4 cb = *(const f32x4*)(p.in[10] + l * 256 + c4), lg = *(const f32x4*)(p.in[11] + l * 256 + c4), lb = *(const f32x4*)(p.in[12] + l * 256 + c4);
            for (int i = wv; i < 64; i += 8) {
                f32x4 acc = cb;
#pragma unroll 4
                for (int k = 0; k < 31; ++k) acc += *(const LAS f32x4*)(ug + (i + k) * 256 + c4) * *(const LAS f32x4*)(cw + k * 256 + c4);
                const float mean = wave_sum((acc.x + acc.y) + (acc.z + acc.w)) * (1.0f / 256.0f);
                const f32x4 d = acc - mean;
                const float var = wave_sum((d.x * d.x + d.y * d.y) + (d.z * d.z + d.w * d.w)) * (1.0f / 256.0f);
                const float rstd = 1.0f / sqrtf(var + LN_EPS);
                const f32x4 un = d * rstd * lg + lb;
                u32x2 o; o.x = pk2(siluf_(un.x), siluf_(un.y)); o.y = pk2(siluf_(un.z), siluf_(un.w));
                *(u32x2*)(U + (size_t)(m0 + i) * D + 256 + c4) = o;
            }
            __syncthreads();
        }
        {
            LAS float* LA = (LAS float*)lds;
            const float* mu = p.in[14] + (size_t)l * 1664;
            for (int idx = tid; idx < 64 * 144; idx += 512) {
                const int i = idx / 144, c = idx % 144, m = m0 + i, tl = tl0 + i;
                const float zt = bf2f(Zr[(size_t)m * ZR_W + 1536 + c]);
                const float zp = tl > 0 ? bf2f(Zr[(size_t)(m - 1) * ZR_W + 1536 + c]) : 0.f;
                const float mm = c < 128 ? mu[1536 + c] : p.in[27][c - 128];
                const float zs = zt + (zp - zt) * mm;
                LA[idx] = c < 32 ? tanhf(zs) : (c < 64 ? zs : (c < 128 ? sigmoidf_(zs) : zs));
            }
            const int ch = tid, hh = wv;
            const float mur = mu[ch], muk = mu[512 + ch], muv = mu[1024 + ch];
            const int fo = (lane >> 2) * 20 + (lane & 3);
            __syncthreads();
            {
                float w2c[32], a2c[32];
                int chA = ch; asm volatile("" : "+v"(chA));
#pragma unroll
                for (int j = 0; j < 32; ++j) { w2c[j] = p.in[16][(size_t)(l * 32 + j) * 512 + chA]; a2c[j] = p.in[18][(size_t)(l * 32 + j) * 512 + chA]; }
                const float w0 = p.in[15][l * 512 + ch], a0 = p.in[17][l * 512 + ch], ksc = p.in[20][l * 512 + ch], kac = p.in[21][l * 512 + ch], rkc = p.in[22][l * 512 + ch];
                float zrp = 0.f, zkp = 0.f;
                if (tl0 > 0) { const bf16* zr = Zr + (size_t)(m0 - 1) * ZR_W; zrp = bf2f(zr[ch]); zkp = bf2f(zr[512 + ch]); }
                for (int i = 0; i < 64; ++i) {
                    const int m = m0 + i, tl = tl0 + i;
                    const bf16* zr = Zr + (size_t)m * ZR_W;
                    const float zrt = bf2f(zr[ch]), zkt = bf2f(zr[512 + ch]);
                    const float r = zrt + (zrp - zrt) * mur, k = zkt + (zkp - zkt) * muk;
                    zrp = zrt; zkp = zkt;
                    float wl = w0, al = a0;
                    const LAS float* la = LA + i * 144;
#pragma unroll
                    for (int j = 0; j < 32; ++j) { wl += la[j] * w2c[j]; al += la[32 + j] * a2c[j]; }
                    const float w = -softplusf_(-wl) - 0.5f, decay = expf(-expf(w));
                    const float a = sigmoidf_(al);
                    float kk = k * ksc; const float nrm = sqrtf(wave_sum(kk * kk)); kk = kk / fmaxf(nrm, 1e-12f);
                    const float kp = k * (1.0f + (a - 1.0f) * kac), kka = kk * a;
                    const float bon = wave_sum(r * kp * rkc);
                    float* rec = SC + ((size_t)(b * NH + hh) * SEQ + tl) * SCQ + fo;
                    rec[0] = decay; rec[4] = kka; rec[8] = kp; rec[12] = r;
                    if (tl > 0) rec[16 - SCQ] = kk;
                    if (tl == SEQ - 1) rec[16] = 0.f;
                    if (lane == 0) BON[(size_t)m * NH + hh] = bon;
                }
            }
            {
                float g2c[64], v2c[16];
                int chB = ch; asm volatile("" : "+v"(chB));
#pragma unroll
                for (int j = 0; j < 64; ++j) g2c[j] = p.in[19][(size_t)(l * 64 + j) * 512 + chB];
#pragma unroll
                for (int j = 0; j < 16; ++j) v2c[j] = l ? p.in[29][(size_t)j * 512 + chB] : 0.f;
                const float v0 = l ? p.in[28][ch] : 0.f;
                float zvp = 0.f;
                if (tl0 > 0) zvp = bf2f(Zr[(size_t)(m0 - 1) * ZR_W + 1024 + ch]);
                for (int i = 0; i < 64; ++i) {
                    const int m = m0 + i, tl = tl0 + i;
                    const float zvt = bf2f(Zr[(size_t)m * ZR_W + 1024 + ch]);
                    float v = zvt + (zvp - zvt) * muv;
                    zvp = zvt;
                    float gl = 0.f, vl = v0;
                    const LAS float* la = LA + i * 144;
#pragma unroll
                    for (int j = 0; j < 64; ++j) gl += la[64 + j] * g2c[j];
                    if (l) {
#pragma unroll
                        for (int j = 0; j < 16; ++j) vl += la[128 + j] * v2c[j];
                        v = v + (VF[(size_t)m * RW + ch] - v) * sigmoidf_(vl);
                    } else VF[(size_t)m * RW + ch] = v;
                    SC[((size_t)(b * NH + hh) * SEQ + tl) * SCQ + 320 + lane] = v;
                    G[(size_t)m * RW + ch] = (bf16)f2bf(gl);
                }
            }
            __syncthreads();
        }
    }
}

template <int MODE> DEV void blk4(float& s0, float& s1, float& s2, float& s3, const f32x16& a, const f32x4& c, float sa, float vv, float& o, float& san) {
    if (MODE == 2)
    asm volatile(
        "v_mul_f32 %0, %8, %0\n v_mul_f32 %1, %9, %1\n v_mul_f32 %2, %10, %2\n v_mul_f32 %3, %11, %3\n"
        "v_fmac_f32 %0, %12, %6\n v_fmac_f32 %1, %13, %6\n v_fmac_f32 %2, %14, %6\n v_fmac_f32 %3, %15, %6\n"
        "v_fmac_f32 %0, %16, %7\n v_fmac_f32 %1, %17, %7\n v_fmac_f32 %2, %18, %7\n v_fmac_f32 %3, %19, %7\n"
        "v_fmac_f32 %4, %20, %0\n v_fmac_f32 %5, %24, %0\n v_fmac_f32 %4, %21, %1\n v_fmac_f32 %5, %25, %1\n"
        "v_fmac_f32 %4, %22, %2\n v_fmac_f32 %5, %26, %2\n v_fmac_f32 %4, %23, %3\n v_fmac_f32 %5, %27, %3\n"
        : "+v"(s0), "+v"(s1), "+v"(s2), "+v"(s3), "+v"(o), "+v"(san)
        : "v"(sa), "v"(vv), "s"(a[0]), "s"(a[1]), "s"(a[2]), "s"(a[3]), "s"(a[4]), "s"(a[5]), "s"(a[6]), "s"(a[7]), "s"(a[8]), "s"(a[9]), "s"(a[10]), "s"(a[11]),
          "s"(a[12]), "s"(a[13]), "s"(a[14]), "s"(a[15]), "s"(c[0]), "s"(c[1]), "s"(c[2]), "s"(c[3]));
    if (MODE == 0)
    asm volatile(
        "v_mul_f32 %0, %8, %0\n v_mul_f32 %1, %9, %1\n v_mul_f32 %2, %10, %2\n v_mul_f32 %3, %11, %3\n"
        "v_fmac_f32 %0, %12, %6\n v_fmac_f32 %1, %13, %6\n v_fmac_f32 %2, %14, %6\n v_fmac_f32 %3, %15, %6\n"
        "v_fmac_f32 %0, %16, %7\n v_fmac_f32 %1, %17, %7\n v_fmac_f32 %2, %18, %7\n v_fmac_f32 %3, %19, %7\n"
        "v_fmac_f32 %5, %24, %0\n v_fmac_f32 %5, %25, %1\n v_fmac_f32 %5, %26, %2\n v_fmac_f32 %5, %27, %3\n"
        : "+v"(s0), "+v"(s1), "+v"(s2), "+v"(s3), "+v"(o), "+v"(san)
        : "v"(sa), "v"(vv), "s"(a[0]), "s"(a[1]), "s"(a[2]), "s"(a[3]), "s"(a[4]), "s"(a[5]), "s"(a[6]), "s"(a[7]), "s"(a[8]), "s"(a[9]), "s"(a[10]), "s"(a[11]),
          "s"(a[12]), "s"(a[13]), "s"(a[14]), "s"(a[15]), "s"(c[0]), "s"(c[1]), "s"(c[2]), "s"(c[3]));
    if (MODE == 1)
    asm volatile(
        "v_mul_f32 %0, %8, %0\n v_mul_f32 %1, %9, %1\n v_mul_f32 %2, %10, %2\n v_mul_f32 %3, %11, %3\n"
        "v_fmac_f32 %0, %12, %6\n v_fmac_f32 %1, %13, %6\n v_fmac_f32 %2, %14, %6\n v_fmac_f32 %3, %15, %6\n"
        "v_fmac_f32 %5, %24, %0\n v_fmac_f32 %5, %25, %1\n v_fmac_f32 %5, %26, %2\n v_fmac_f32 %5, %27, %3\n"
        : "+v"(s0), "+v"(s1), "+v"(s2), "+v"(s3), "+v"(o), "+v"(san)
        : "v"(sa), "v"(vv), "s"(a[0]), "s"(a[1]), "s"(a[2]), "s"(a[3]), "s"(a[4]), "s"(a[5]), "s"(a[6]), "s"(a[7]), "s"(a[8]), "s"(a[9]), "s"(a[10]), "s"(a[11]),
          "s"(a[12]), "s"(a[13]), "s"(a[14]), "s"(a[15]), "s"(c[0]), "s"(c[1]), "s"(c[2]), "s"(c[3]));
}
#define SCAN_BLK(MODE, JB, A, C, NA, NC, NOFF) \
    SLD16(NA, rec, NOFF); SLD4(NC, rec, NOFF + 64); \
    blk4<MODE>(S[JB * 4], S[JB * 4 + 1], S[JB * 4 + 2], S[JB * 4 + 3], A, C, sa, vv, o, san); \
    asm volatile("s_waitcnt lgkmcnt(0)" : "+s"(NA), "+s"(NC));
#define SCAN_STEP(MODE) \
    SCAN_BLK(MODE, 0, a0, c0, a1, c1, 80) SCAN_BLK(MODE, 1, a1, c1, a0, c0, 160) SCAN_BLK(MODE, 2, a0, c0, a1, c1, 240) SCAN_BLK(MODE, 3, a1, c1, a0, c0, 320) \
    SCAN_BLK(MODE, 4, a0, c0, a1, c1, 400) SCAN_BLK(MODE, 5, a1, c1, a0, c0, 480) SCAN_BLK(MODE, 6, a0, c0, a1, c1, 560) SCAN_BLK(MODE, 7, a1, c1, a0, c0, 640) \
    SCAN_BLK(MODE, 8, a0, c0, a1, c1, 720) SCAN_BLK(MODE, 9, a1, c1, a0, c0, 800) SCAN_BLK(MODE, 10, a0, c0, a1, c1, 880) SCAN_BLK(MODE, 11, a1, c1, a0, c0, 960) \
    SCAN_BLK(MODE, 12, a0, c0, a1, c1, 1040) SCAN_BLK(MODE, 13, a1, c1, a0, c0, 1120) SCAN_BLK(MODE, 14, a0, c0, a1, c1, 1200) SCAN_BLK(MODE, 15, a1, c1, a0, c0, 1536)

DEV void scan_pass1(const Params& p) {
    const int tid = tid_fresh(), lane = tid & 63, wv = __builtin_amdgcn_readfirstlane(tid >> 6);
    const float* SC = (const float*)(p.ws + WS_SC); float* LS = (float*)(p.ws + WS_LS); float* PM = (float*)(p.ws + WS_PM);
    for (int u = blockIdx.x * 8 + wv; u < 32 * NCH; u += gridDim.x * 8) {
        const int bh = u / NCH, c = u % NCH;
        const float* base = SC + ((size_t)bh * SEQ + (size_t)c * CH) * SCQ;
        float S[64];
        f32x16 a0, a1; f32x4 c0, c1;
        {
#pragma unroll
            for (int j = 0; j < 64; ++j) S[j] = 0.f;
            const float* rec = base; float sa = 0.f;
            SLD16(a0, rec, 0); SLD4(c0, rec, 64); asm volatile("s_waitcnt lgkmcnt(0)" : "+s"(a0), "+s"(c0));
            for (int t = 0; t < CH; ++t) {
                const float vv = rec[320 + lane]; float o = 0.f, san = 0.f;
                SCAN_STEP(0)
                sa = -san; rec += SCQ;
            }
            float* o = LS + ((size_t)u * 64 + lane) * 64;
#pragma unroll
            for (int j = 0; j < 64; j += 4) *(f32x4*)(o + j) = (f32x4){S[j], S[j + 1], S[j + 2], S[j + 3]};
        }
        if (c > 0) {
#pragma unroll
            for (int j = 0; j < 64; ++j) S[j] = (j == lane) ? 1.f : 0.f;
            const float* rec = base;
            float sa = -(rec - SCQ)[(lane >> 2) * 20 + 16 + (lane & 3)];
            SLD16(a0, rec, 0); SLD4(c0, rec, 64); asm volatile("s_waitcnt lgkmcnt(0)" : "+s"(a0), "+s"(c0));
            for (int t = 0; t < CH; ++t) {
                const float vv = 0.f; float o = 0.f, san = 0.f;
                SCAN_STEP(1)
                sa = -san; rec += SCQ;
            }
            float* o = PM + ((size_t)u * 64 + lane) * 64;
#pragma unroll
            for (int j = 0; j < 64; j += 4) *(f32x4*)(o + j) = (f32x4){S[j], S[j + 1], S[j + 2], S[j + 3]};
        }
    }
}
DEV void scan_carry(const Params& p, LAS unsigned char* lds) {
    LAS float* cur = (LAS float*)lds;
    const int tid = tid_fresh(), ri = tid >> 6, jp = tid & 63;
    float* LS = (float*)(p.ws + WS_LS); const float* PM = (const float*)(p.ws + WS_PM);
    for (int u = blockIdx.x; u < 32 * 8; u += gridDim.x) {
        const int bh = u >> 3, i = (u & 7) * 8 + ri;
        float s = 0.f;
        __syncthreads();
        cur[ri * 64 + jp] = 0.f;
        __syncthreads();
        for (int c = 0; c < NCH; ++c) {
            const float* Pc = PM + (size_t)(bh * NCH + c) * 4096;
            float* Lc = LS + (size_t)(bh * NCH + c) * 4096 + i * 64 + jp;
            float acc = *Lc;
            if (c > 0) {
#pragma unroll 16
                for (int j = 0; j < 64; ++j) acc += cur[ri * 64 + j] * Pc[j * 64 + jp];
            }
            *Lc = s;
            __syncthreads();
            s = acc; cur[ri * 64 + jp] = acc;
            __syncthreads();
        }
    }
}
DEV void scan_pass2(const Params& p, int l) {
    const int tid = tid_fresh(), lane = tid & 63, wv = __builtin_amdgcn_readfirstlane(tid >> 6);
    const float* SC = (const float*)(p.ws + WS_SC); const float* LS = (const float*)(p.ws + WS_LS);
    const bf16* G = (const bf16*)(p.ws + WS_G); const float* BON = (const float*)(p.ws + WS_BON); bf16* U = (bf16*)(p.ws + WS_U);
    for (int u = blockIdx.x * 8 + wv; u < 32 * NCH; u += gridDim.x * 8) {
        const int bh = u / NCH, c = u % NCH, b = bh >> 3, hh = bh & 7;
        const float* rec = SC + ((size_t)bh * SEQ + (size_t)c * CH) * SCQ;
        const float lg = p.in[23][l * 512 + hh * 64 + lane], lb = p.in[24][l * 512 + hh * 64 + lane];
        float S[64];
        const float* s0 = LS + ((size_t)u * 64 + lane) * 64;
#pragma unroll
        for (int j = 0; j < 64; j += 4) { const f32x4 v = *(const f32x4*)(s0 + j); S[j] = v.x; S[j + 1] = v.y; S[j + 2] = v.z; S[j + 3] = v.w; }
        float sa = 0.f;
        f32x16 a0, a1; f32x4 c0, c1;
        if (c > 0) {
            const float* pr = rec - SCQ;
#pragma unroll
            for (int q = 0; q < 4; ++q) {
                f32x4 k0, k1, k2, k3;
                SLD4(k0, pr, q * 320 + 64); SLD4(k1, pr, q * 320 + 144); SLD4(k2, pr, q * 320 + 224); SLD4(k3, pr, q * 320 + 304);
                asm volatile("s_waitcnt lgkmcnt(0)" : "+s"(k0), "+s"(k1), "+s"(k2), "+s"(k3));
#pragma unroll
                for (int e = 0; e < 4; ++e) { sa -= S[q * 16 + e] * k0[e]; sa -= S[q * 16 + 4 + e] * k1[e]; sa -= S[q * 16 + 8 + e] * k2[e]; sa -= S[q * 16 + 12 + e] * k3[e]; }
            }
        }
        SLD16(a0, rec, 0); SLD4(c0, rec, 64); asm volatile("s_waitcnt lgkmcnt(0)" : "+s"(a0), "+s"(c0));
        for (int t = 0; t < CH; ++t) {
            const float vv = rec[320 + lane]; float o = 0.f, san = 0.f;
            SCAN_STEP(2)
            sa = -san; rec += SCQ;
            const int m = b * SEQ + c * CH + t;
            const float mean = wave_sum(o) * (1.0f / 64.0f), dlt = o - mean;
            const float var = wave_sum(dlt * dlt) * (1.0f / 64.0f);
            const float on = dlt * (1.0f / sqrtf(var + GN_EPS)) * lg + lb;
            const float res = (on + BON[(size_t)m * NH + hh] * vv) * bf2f(G[(size_t)m * RW + hh * 64 + lane]);
            U[(size_t)m * D + 512 + hh * 64 + lane] = (bf16)f2bf(res);
        }
    }
}

template <bool MOE>
DEV void final_phase(const Params& p) {
    const int tid = tid_fresh(), lane = tid & 63, wv = tid >> 6;
    const float* g = p.in[38]; float* X = p.out;
    const bf16* Y = (const bf16*)(p.ws + WS_Y);
    const float* MOD = (const float*)(p.ws + WS_MOD);
    for (int r = blockIdx.x * 8 + wv; r < T; r += gridDim.x * 8) {
        const int b = r / SEQ;
        const float* gate = MOD + (size_t)(3 * 4 + b) * 3072 + 2048;
        f32x4 v[4]; float ss = 0.f;
#pragma unroll
        for (int j = 0; j < 4; ++j) {
            const int d = 4 * lane + 256 * j;
            v[j] = *(const f32x4*)(X + (size_t)r * D + d);
            if (MOE) {
                const u32x2 y0 = *(const u32x2*)(Y + (size_t)r * D + d), y1 = *(const u32x2*)(Y + (size_t)(T + r) * D + d);
                const f32x4 gt = *(const f32x4*)(gate + d);
                f32x4 ys;
                ys.x = __uint_as_float(y0.x << 16) + __uint_as_float(y1.x << 16); ys.y = __uint_as_float(y0.x & 0xffff0000u) + __uint_as_float(y1.x & 0xffff0000u);
                ys.z = __uint_as_float(y0.y << 16) + __uint_as_float(y1.y << 16); ys.w = __uint_as_float(y0.y & 0xffff0000u) + __uint_as_float(y1.y & 0xffff0000u);
                v[j] += gt * ys;
            }
            ss += (v[j].x * v[j].x + v[j].y * v[j].y) + (v[j].z * v[j].z + v[j].w * v[j].w);
        }
        const float rstd = 1.0f / sqrtf(wave_sum(ss) * (1.0f / D) + RMS_EPS);
#pragma unroll
        for (int j = 0; j < 4; ++j) { const int d = 4 * lane + 256 * j; *(f32x4*)(X + (size_t)r * D + d) = v[j] * rstd * *(const f32x4*)(g + d); }
    }
}

namespace pg8 {
typedef short bf16x8 __attribute__((ext_vector_type(8)));
constexpr int BM = 256, BK = 64, HALF = 128, HTB = HALF * BK * 2  , STAGE_BYTES = 8 * HTB, NXCD = 8, WGM = 8;
DEV int lds_byte(int r, int c) { const int st = (r >> 4) * 2 + (c >> 5), rr = r & 15, cc = c & 31, ob = rr * 64 + cc * 2; return st * 1024 + (ob ^ (((ob >> 9) & 1) << 5)); }
DEV void stage_rc(int b, int& R, int& C) { const int st = b / 1024, sb = b % 1024, swz = sb ^ (((sb >> 9) & 1) << 5); R = (st >> 1) * 16 + swz / 64; C = (st & 1) * 32 + (swz % 64) / 2; }
DEV int perm32(int rho) { const int n = rho >> 4, i = rho & 15; return 8 * (i >> 2) + 4 * n + (i & 3); }
struct Unit { int pm, pn; };
struct StaticOrder {
    const char* A; const char* Bt; int lda, ldb; int nM, nN, nwg, G, c;
    DEV void init(const void* A_, int lda_, const void* Bt_, int ldb_, int nM_, int nN_, int G_, int c_) { A = (const char*)A_; Bt = (const char*)Bt_; lda = lda_; ldb = ldb_; nM = nM_; nN = nN_; nwg = nM * nN; G = G_; c = c_; }
    DEV bool next(int i, Unit& u) const {
        const long L = (long)i * G + c; if (L >= nwg) return false;
        int wgid = (int)L; { const int q = nwg / NXCD, r = nwg % NXCD, xcd = wgid % NXCD, off = wgid / NXCD; wgid = (xcd < r ? xcd * (q + 1) : r * (q + 1) + (xcd - r) * q) + off; }
        const int nig = WGM * nN, gid = wgid / nig, fm = gid * WGM, gsz = (nM - fm) < WGM ? (nM - fm) : WGM;
        u.pm = fm + ((wgid % nig) % gsz); u.pn = (wgid % nig) / gsz; return true;
    }
    DEV const char* a_ptr(const Unit& u) const { return A + (size_t)u.pm * BM * lda * 2; }
    DEV const char* b_ptr(const Unit& u) const { return Bt + (size_t)u.pn * BM * ldb * 2; }
};
template <class Epi, class Sched>
DEV void gemm_phase(LAS unsigned char* lds, const int K, const int lda, const int ldb, const Sched& S, const Epi& E) {
    const int tid = tid_fresh(), wid = __builtin_amdgcn_readfirstlane(tid >> 6), lane = tid & 63, wr = wid >> 2, wc = wid & 3, fr = lane & 15, fq = lane >> 4;
    const int nt = K / BK;
    unsigned voffA[2], voffB[2];
#pragma unroll
    for (int i = 0; i < 2; ++i) { int R, C; stage_rc(tid * 16 + i * 8192, R, C); const int Rb = (R & ~31) + perm32(R & 31);
        voffA[i] = (unsigned)(R * lda + C) * 2u; voffB[i] = (unsigned)(Rb * ldb + C) * 2u; }
    const size_t kstep = (size_t)(BK * 2);
    const size_t hstepA = (size_t)HALF * lda * 2, hstepB = (size_t)HALF * ldb * 2;
    const unsigned ldsw = (unsigned)wid * 1024u;
    const int aoff = lds_byte(wr * 64 + fr, fq * 8), boff = lds_byte(wc * 32 + fr, fq * 8);
#define PG8_SA(b, h) (((b) * 2 + (h)) * HTB)
#define PG8_SB(b, h) ((4 + (b) * 2 + (h)) * HTB)
#define PG8_STAGE(bufoff, gbase, voff) do { _Pragma("unroll") for (int _i = 0; _i < 2; ++_i) \
        __builtin_amdgcn_global_load_lds((const unsigned*)((const char*)(gbase) + (voff)[_i]), (LAS unsigned*)(lds + (bufoff) + ldsw + _i * 8192), 16, 0, 0); } while (0)
#define PG8_LDA(dst, b, h) do { _Pragma("unroll") for (int m = 0; m < 4; ++m) _Pragma("unroll") for (int k = 0; k < 2; ++k) dst[m][k] = *(const LAS bf16x8*)(lds + PG8_SA(b, h) + aoff + m * 2048 + k * 1024); } while (0)
#define PG8_LDB(dst, b, h) do { _Pragma("unroll") for (int n = 0; n < 2; ++n) _Pragma("unroll") for (int k = 0; k < 2; ++k) dst[n][k] = *(const LAS bf16x8*)(lds + PG8_SB(b, h) + boff + n * 2048 + k * 1024); } while (0)
#define PG8_MMA(ai, bj, At, Bt) do { __builtin_amdgcn_s_setprio(1); _Pragma("unroll") for (int m = 0; m < 4; ++m) _Pragma("unroll") for (int n = 0; n < 2; ++n) _Pragma("unroll") for (int k = 0; k < 2; ++k) \
        acc[ai][bj][m][n] = __builtin_amdgcn_mfma_f32_16x16x32_bf16(Bt[n][k], At[m][k], acc[ai][bj][m][n], 0, 0, 0); __builtin_amdgcn_s_setprio(0); } while (0)
#define PG8_WAIT_V(n) asm volatile("s_waitcnt vmcnt(" #n ")" ::: "memory")
#define PG8_WAIT_L(n) asm volatile("s_waitcnt lgkmcnt(" #n ")" ::: "memory")
#define PG8_BAR __builtin_amdgcn_s_barrier()
#define PG8_SCHED __builtin_amdgcn_sched_barrier(0)
    Unit cur, nxt; int ui = 0;
    if (!S.next(0, cur)) return;
    f32x4 acc[2][2][4][2];
#pragma unroll
    for (int a = 0; a < 2; ++a)
#pragma unroll
        for (int b = 0; b < 2; ++b)
#pragma unroll
            for (int m = 0; m < 4; ++m)
#pragma unroll
                for (int n = 0; n < 2; ++n) acc[a][b][m][n] = (f32x4){0.f, 0.f, 0.f, 0.f};
    bf16x8 At[4][2], B0[2][2], B1[2][2];
    const char* cA = S.a_ptr(cur); const char* cB = S.b_ptr(cur);
    PG8_STAGE(PG8_SB(0, 0), cB, voffB); PG8_STAGE(PG8_SB(0, 1), cB + hstepB, voffB); PG8_STAGE(PG8_SA(0, 0), cA, voffA); PG8_STAGE(PG8_SA(0, 1), cA + hstepA, voffA);
    if (wr == 1) PG8_BAR;
    PG8_WAIT_V(2); PG8_BAR;
    PG8_STAGE(PG8_SB(1, 0), cB + kstep, voffB); PG8_STAGE(PG8_SA(1, 0), cA + kstep, voffA); PG8_STAGE(PG8_SB(1, 1), cB + hstepB + kstep, voffB);
    PG8_WAIT_V(6); PG8_BAR;
    for (;;) {
        const bool has_next = S.next(ui + 1, nxt);
        const char* nA = has_next ? S.a_ptr(nxt) : cA; const char* nB = has_next ? S.b_ptr(nxt) : cB;
        for (int t = 0; t < nt; t += 2) {
            const bool last = (t == nt - 2);
            const char* a1 = cA + (size_t)(t + 1) * kstep;
            const char* a2 = last ? nA : cA + (size_t)(t + 2) * kstep; const char* b2 = last ? nB : cB + (size_t)(t + 2) * kstep;
            const char* a3 = a2 + kstep; const char* b3 = b2 + kstep;
            if constexpr (Epi::NMID > 0) { if (t == Epi::MID0 || t == Epi::MID1) E.mid(acc, cur, t == Epi::MID0 ? 0 : 1, wr, wc, fr, fq); }
            PG8_LDB(B0, 0, 0); PG8_LDB(B1, 0, 1); PG8_SCHED; PG8_LDA(At, 0, 0); PG8_STAGE(PG8_SA(1, 1), a1 + hstepA, voffA);
            PG8_WAIT_V(8); PG8_WAIT_L(0); PG8_BAR; PG8_MMA(0, 0, At, B0); PG8_MMA(0, 1, At, B1); PG8_BAR; PG8_SCHED;
            PG8_LDA(At, 0, 1); PG8_STAGE(PG8_SB(0, 0), b2, voffB); PG8_STAGE(PG8_SB(0, 1), b2 + hstepB, voffB); PG8_STAGE(PG8_SA(0, 0), a2, voffA);
            PG8_WAIT_V(8); PG8_WAIT_L(0); PG8_BAR; PG8_MMA(1, 0, At, B0); PG8_MMA(1, 1, At, B1); PG8_BAR; PG8_SCHED;
            PG8_LDB(B0, 1, 0); PG8_LDB(B1, 1, 1); PG8_SCHED; PG8_LDA(At, 1, 0); PG8_STAGE(PG8_SA(0, 1), a2 + hstepA, voffA);
            PG8_WAIT_V(8); PG8_WAIT_L(0); PG8_BAR; PG8_MMA(0, 0, At, B0); PG8_MMA(0, 1, At, B1); PG8_BAR; PG8_SCHED;
            PG8_LDA(At, 1, 1); PG8_STAGE(PG8_SB(1, 0), b3, voffB); PG8_STAGE(PG8_SB(1, 1), b3 + hstepB, voffB); PG8_STAGE(PG8_SA(1, 0), a3, voffA);
            PG8_WAIT_V(8); PG8_WAIT_L(0); PG8_BAR; PG8_MMA(1, 0, At, B0); PG8_MMA(1, 1, At, B1); PG8_BAR; PG8_SCHED;
        }
        if (wr == 0) PG8_BAR;
        E(acc, cur, wr, wc, fr, fq);
        if (!has_next) break;
#pragma unroll
        for (int a = 0; a < 2; ++a)
#pragma unroll
            for (int b = 0; b < 2; ++b)
#pragma unroll
                for (int m = 0; m < 4; ++m)
#pragma unroll
                    for (int n = 0; n < 2; ++n) acc[a][b][m][n] = (f32x4){0.f, 0.f, 0.f, 0.f};
        cur = nxt; cA = nA; cB = nB; ++ui;
        if (wr == 1) PG8_BAR;
    }
    PG8_WAIT_V(0);
    PG8_BAR;
#undef PG8_SA
#undef PG8_SB
#undef PG8_STAGE
#undef PG8_LDA
#undef PG8_LDB
#undef PG8_MMA
#undef PG8_WAIT_V
#undef PG8_WAIT_L
#undef PG8_BAR
#undef PG8_SCHED
}
}

typedef f32x4 Acc[2][2][4][2];
DEV unsigned cvt_pk_bf16(float lo, float hi) { unsigned r; asm volatile("v_cvt_pk_bf16_f32 %0, %1, %2" : "=v"(r) : "v"(lo), "v"(hi)); return r; }
DEV float fsig(float x) { return __builtin_amdgcn_rcpf(1.0f + __builtin_amdgcn_exp2f(-1.44269504f * x)); }
DEV u32x4 pack8(const f32x4& a, const f32x4& b) { u32x4 w; w.x = cvt_pk_bf16(a.x, a.y); w.y = cvt_pk_bf16(a.z, a.w); w.z = cvt_pk_bf16(b.x, b.y); w.w = cvt_pk_bf16(b.z, b.w); return w; }
DEV void unpack8(const u32x4& w, f32x4& a, f32x4& b) {
    a.x = __uint_as_float(w.x << 16); a.y = __uint_as_float(w.x & 0xffff0000u); a.z = __uint_as_float(w.y << 16); a.w = __uint_as_float(w.y & 0xffff0000u);
    b.x = __uint_as_float(w.z << 16); b.y = __uint_as_float(w.z & 0xffff0000u); b.z = __uint_as_float(w.w << 16); b.w = __uint_as_float(w.w & 0xffff0000u); }
struct EpiZ { unsigned char* ws;
    static constexpr int NMID = 0, MID0 = -1, MID1 = -1;
    DEV void operator()(const Acc& acc, const pg8::Unit& u, int wr, int wc, int fr, int fq) const {
        bf16* base; int ld, colt; bool sig = false;
        if (u.pn < 7) { base = (bf16*)(ws + WS_ZR); ld = ZR_W; colt = u.pn * 256; }
        else if (u.pn < 19) { base = (bf16*)(ws + WS_ZG); ld = ZG_W; colt = (u.pn - 7) * 256; sig = true; }
        else if (u.pn == 19) { base = (bf16*)(ws + WS_ZP); ld = ZP_W; colt = 0; }
        else { base = (bf16*)(ws + WS_ZC); ld = ZC_W; colt = (u.pn - 20) * 256; }
        const int row0 = u.pm * 256 + wr * 64 + fr, col0 = colt + wc * 32 + 8 * fq;
#pragma unroll
        for (int ai = 0; ai < 2; ++ai)
#pragma unroll
            for (int m = 0; m < 4; ++m) { bf16* rowp = base + (size_t)(row0 + ai * 128 + m * 16) * ld + col0;
#pragma unroll
                for (int bj = 0; bj < 2; ++bj) { f32x4 v0 = acc[ai][bj][m][0], v1 = acc[ai][bj][m][1];
                    if (sig) {
#pragma unroll
                        for (int e = 0; e < 4; ++e) { v0[e] = fsig(v0[e]); v1[e] = fsig(v1[e]); } }
                    *(u32x4*)(rowp + bj * 128) = pack8(v0, v1); } }
    } };
struct EpiMix { const bf16* Zg; bf16* O;
    static constexpr int NMID = 2, MID0 = 4, MID1 = 8;
    DEV void mid(Acc& acc, const pg8::Unit& u, int seg, int wr, int wc, int fr, int fq) const {
        const int row0 = u.pm * 256 + wr * 64 + fr, col0 = u.pn * 256 + wc * 32 + 8 * fq;
        const bf16* gp = Zg + (size_t)row0 * ZG_W + seg * 1024 + col0;
#pragma unroll
        for (int ai = 0; ai < 2; ++ai) {
#pragma unroll
            for (int m = 0; m < 4; ++m) {
                asm volatile("" : "+v"(gp));
#pragma unroll
                for (int bj = 0; bj < 2; ++bj) { f32x4 n0, n1, d0, d1; unpack8(*(const u32x4*)(gp + bj * 128), n0, n1); unpack8(*(const u32x4*)(gp + 1024 + bj * 128), d0, d1);
#pragma unroll
                    for (int e = 0; e < 4; ++e) { acc[ai][bj][m][0][e] *= n0[e] * __builtin_amdgcn_rcpf(d0[e]); acc[ai][bj][m][1][e] *= n1[e] * __builtin_amdgcn_rcpf(d1[e]); } }
                asm volatile("" : "+v"(acc[ai][0][m][0]), "+v"(acc[ai][0][m][1]), "+v"(acc[ai][1][m][0]), "+v"(acc[ai][1][m][1]) :: "memory");
                gp += 16 * ZG_W; }
            gp += (128 - 64) * ZG_W; }
    }
    DEV void operator()(const Acc& acc, const pg8::Unit& u, int wr, int wc, int fr, int fq) const {
        const int row0 = u.pm * 256 + wr * 64 + fr, col0 = u.pn * 256 + wc * 32 + 8 * fq;
#pragma unroll
        for (int ai = 0; ai < 2; ++ai)
#pragma unroll
            for (int m = 0; m < 4; ++m) { const size_t r = (size_t)(row0 + ai * 128 + m * 16);
#pragma unroll
                for (int bj = 0; bj < 2; ++bj) { f32x4 g0, g1; unpack8(*(const u32x4*)(Zg + r * ZG_W + 2048 + col0 + bj * 128), g0, g1);
                    *(u32x4*)(O + r * D + col0 + bj * 128) = pack8(acc[ai][bj][m][0] * g0, acc[ai][bj][m][1] * g1); }
                asm volatile("" ::: "memory"); }
    } };
struct EpiRes { const float* xin; float* xout; const float* gate;
    static constexpr int NMID = 0, MID0 = -1, MID1 = -1;
    DEV void operator()(const Acc& acc, const pg8::Unit& u, int wr, int wc, int fr, int fq) const {
        const int row0 = u.pm * 256 + wr * 64 + fr, col0 = u.pn * 256 + wc * 32 + 8 * fq;
        const float* g = gate + (size_t)(u.pm >> 4) * 3072 + col0;
        f32x4 gv[2][2];
#pragma unroll
        for (int bj = 0; bj < 2; ++bj)
#pragma unroll
            for (int n = 0; n < 2; ++n) gv[bj][n] = *(const f32x4*)(g + bj * 128 + 4 * n);
#pragma unroll
        for (int ai = 0; ai < 2; ++ai)
#pragma unroll
            for (int m = 0; m < 4; ++m) { const size_t off = (size_t)(row0 + ai * 128 + m * 16) * D + col0;
#pragma unroll
                for (int bj = 0; bj < 2; ++bj)
#pragma unroll
                    for (int n = 0; n < 2; ++n) { const f32x4 x = *(const f32x4*)(xin + off + bj * 128 + 4 * n); *(f32x4*)(xout + off + bj * 128 + 4 * n) = x + gv[bj][n] * acc[ai][bj][m][n]; }
                if (m & 1) asm volatile("" ::: "memory"); }
    } };
struct EpiSwi { bf16* O; int ldo, row_shift;
    static constexpr int NMID = 0, MID0 = -1, MID1 = -1;
    DEV void operator()(const Acc& acc, const pg8::Unit& u, int wr, int wc, int fr, int fq) const {
        const int row0 = u.pm * 256 - row_shift + wr * 64 + fr, col0 = u.pn * 128 + wc * 32 + 8 * fq;
#pragma unroll
        for (int ai = 0; ai < 2; ++ai)
#pragma unroll
            for (int m = 0; m < 4; ++m) { f32x4 h0, h1;
#pragma unroll
                for (int e = 0; e < 4; ++e) { const float a = acc[ai][0][m][0][e], b = acc[ai][0][m][1][e]; h0[e] = a * fsig(a) * acc[ai][1][m][0][e]; h1[e] = b * fsig(b) * acc[ai][1][m][1][e]; }
                *(u32x4*)(O + (size_t)(row0 + ai * 128 + m * 16) * ldo + col0) = pack8(h0, h1); }
    } };
struct EpiMoeDown { bf16* Y; const int* rowtk; const float* roww;
    static constexpr int NMID = 0, MID0 = -1, MID1 = -1;
    DEV void operator()(const Acc& acc, const pg8::Unit& u, int wr, int wc, int fr, int fq) const {
        const int row0 = u.pm * 256 + wr * 64 + fr, col0 = u.pn * 256 + wc * 32 + 8 * fq;
#pragma unroll
        for (int ai = 0; ai < 2; ++ai)
#pragma unroll
            for (int m = 0; m < 4; ++m) { const int r = row0 + ai * 128 + m * 16; const int tk = rowtk[r]; const float w = roww[r];
                if (tk >= 0) { bf16* yp = Y + ((size_t)(tk & 1) * T + (size_t)(tk >> 1)) * D + col0;
#pragma unroll
                    for (int bj = 0; bj < 2; ++bj) *(u32x4*)(yp + bj * 128) = pack8(acc[ai][bj][m][0] * w, acc[ai][bj][m][1] * w); } }
    } };
struct MoeOrder {
    const char* A; const char* Bt; int lda, ldb; size_t estride; int t0, ashift, nM, nN, nwg, G, c; int toff[9];
    DEV void init(const void* A_, int lda_, const void* Bt_, int ldb_, size_t estride_, const unsigned* cnt, int grp, int rel, int nN_, int G_, int c_) {
        A = (const char*)A_; Bt = (const char*)Bt_; lda = lda_; ldb = ldb_; estride = estride_; nN = nN_; G = G_; c = c_;
        int s = 0;
#pragma unroll
        for (int e = 0; e < 8; ++e) { toff[e] = s; s += ((int)cnt[e] + 255) >> 8; }
        toff[8] = s;
        const int half = (s + 1) >> 1; t0 = grp ? half : 0; const int t1 = grp ? s : half; nM = t1 - t0; nwg = nM * nN; ashift = rel ? t0 : 0;
    }
    DEV bool next(int i, pg8::Unit& u) const {
        const long L = (long)i * G + c; if (L >= nwg) return false;
        int wgid = (int)L; { const int q = nwg / 8, r = nwg % 8, xcd = wgid % 8, off = wgid / 8; wgid = (xcd < r ? xcd * (q + 1) : r * (q + 1) + (xcd - r) * q) + off; }
        const int nig = 8 * nN, gid = wgid / nig, fm = gid * 8, gsz = (nM - fm) < 8 ? (nM - fm) : 8;
        u.pm = t0 + fm + ((wgid % nig) % gsz); u.pn = (wgid % nig) / gsz; return true;
    }
    DEV int expert(int pm) const { int e = 0;
#pragma unroll
        for (int q = 1; q < 8; ++q) e += (pm >= toff[q]) ? 1 : 0;
        return e; }
    DEV const char* a_ptr(const pg8::Unit& u) const { return A + (size_t)(u.pm - ashift) * 256 * lda * 2; }
    DEV const char* b_ptr(const pg8::Unit& u) const { return Bt + (size_t)expert(u.pm) * estride + (size_t)u.pn * 256 * ldb * 2; }
};

template <class Src>
DEV void tr_item(const Src& src, bf16* WT, int ldt, int k0, int n0, LAS float* scr, int lane) {
#pragma unroll 8
    for (int i = 0; i < 32; ++i) { const int kk = 2 * i + (lane >> 5); scr[kk * 33 + (lane & 31)] = src(k0 + kk, n0 + (lane & 31)); }
    asm volatile("s_waitcnt lgkmcnt(0)" ::: "memory");
    const int c = lane & 7;
#pragma unroll
    for (int j = 0; j < 4; ++j) { const int n = (lane >> 3) + 8 * j; const LAS float* s = scr + (8 * c) * 33 + n;
        u32x4 o; o.x = pk2(s[0 * 33], s[1 * 33]); o.y = pk2(s[2 * 33], s[3 * 33]); o.z = pk2(s[4 * 33], s[5 * 33]); o.w = pk2(s[6 * 33], s[7 * 33]);
        *(u32x4*)(WT + (size_t)(n0 + n) * ldt + k0 + 8 * c) = o; }
    asm volatile("s_waitcnt lgkmcnt(0)" ::: "memory");
}
struct SrcPlain { const float* W; int ld; DEV float operator()(int k, int n) const { return W[(size_t)k * ld + n]; } };
struct SrcIn { const float* W; const float* Wv; int live;
    DEV float operator()(int k, int n) const {
        if (n < 1664) return W[(size_t)k * IN_COLS + OFF_RWKV + n];
        if (n < 1680) return live ? Wv[(size_t)k * 16 + (n - 1664)] : 0.f;
        if (n < 1792) return 0.f;
        if (n < 4864) return W[(size_t)k * IN_COLS + OFF_GATE + (n - 1792)];
        if (n < 5120) return W[(size_t)k * IN_COLS + (n - 4864)];
        return W[(size_t)k * IN_COLS + OFF_CONV + (n - 5120)];
    } };
struct SrcPair { const float* W1; const float* W3; int ld;
    DEV float operator()(int k, int n) const { const int pn = n >> 8, j = n & 255; const float* W = W1 + (ptrdiff_t)(j >> 7) * (W3 - W1); return W[(size_t)k * ld + pn * 128 + (j & 127)]; } };
template <class Src>
DEV void tr_job(const Src& src, bf16* WT, int ldt, int K, int N, int koff, LAS float* scr, int gw, int ngw, int lane) {
    const int nkb = K / 64, nnb = N / 32;
    for (int it = gw; it < nkb * nnb; it += ngw) { const int kb = it / nnb, nb = it % nnb;
        tr_item(src, WT + koff, ldt, kb * 64, nb * 32, scr, lane); }
}
DEV void convert_phase(const Params& p, LAS unsigned char* lds) {
    const int tid = tid_fresh(), lane = tid & 63, wv = __builtin_amdgcn_readfirstlane(tid >> 6);
    LAS float* scr = (LAS float*)(lds + 32768 + wv * 8704);
    const int gw = blockIdx.x * 8 + wv, ngw = gridDim.x * 8;
    for (int l = 0; l < NL; ++l) {
        bf16* WinT = (bf16*)(p.ws + WS_WIN) + (size_t)l * ZN * D;
        tr_job(SrcIn{p.in[5] + (size_t)l * D * IN_COLS, p.in[26], l}, WinT, D, D, ZN, 0, scr, gw, ngw, lane);
        bf16* WmixT = (bf16*)(p.ws + WS_WMIX) + (size_t)l * D * D;
        tr_job(SrcPlain{p.in[13] + (size_t)l * 256 * D, D}, WmixT, D, 256, D, 256, scr, gw, ngw, lane);
        tr_job(SrcPlain{p.in[25] + (size_t)l * 512 * D, D}, WmixT, D, 512, D, 512, scr, gw, ngw, lane);
        tr_job(SrcPlain{p.in[30] + (size_t)l * D * D, D}, (bf16*)(p.ws + WS_WO) + (size_t)l * D * D, D, D, D, 0, scr, gw, ngw, lane);
        const float* pw = p.in[6] + (size_t)l * 4 * 64 * 64; const float* ps = p.in[7] + l * 256; const float* pp = p.in[8] + (size_t)l * 256 * D;
        for (int it = gw; it < 32 * 16; it += ngw) {
            const int k8 = it >> 4, n = (it & 15) * 64 + lane, g = k8 >> 3;
            float a[8];
#pragma unroll
            for (int e = 0; e < 8; ++e) a[e] = 0.f;
            for (int d = 0; d < 64; ++d) { const float pv = pp[(size_t)(g * 64 + d) * D + n] * ps[g * 64 + d];
#pragma unroll
                for (int e = 0; e < 8; ++e) a[e] += pw[(size_t)(k8 * 8 + e) * 64 + d] * pv; }
            u32x4 o; o.x = pk2(a[0], a[1]); o.y = pk2(a[2], a[3]); o.z = pk2(a[4], a[5]); o.w = pk2(a[6], a[7]);
            *(u32x4*)(WmixT + (size_t)n * D + k8 * 8) = o;
        }
    }
    tr_job(SrcPair{p.in[31], p.in[32], DFF}, (bf16*)(p.ws + WS_W13), D, D, 2 * DFF, 0, scr, gw, ngw, lane);
    tr_job(SrcPlain{p.in[33], D}, (bf16*)(p.ws + WS_W2), DFF, DFF, D, 0, scr, gw, ngw, lane);
}
DEV void convert_moe_phase(const Params& p, LAS unsigned char* lds) {
    const int tid = tid_fresh(), lane = tid & 63, wv = __builtin_amdgcn_readfirstlane(tid >> 6);
    LAS float* scr = (LAS float*)(lds + 32768 + wv * 8704);
    const int gw = blockIdx.x * 8 + wv, ngw = gridDim.x * 8;
    for (int e = 0; e < NE; ++e) {
        tr_job(SrcPair{p.in[35] + (size_t)e * D * DFE, p.in[36] + (size_t)e * D * DFE, DFE}, (bf16*)(p.ws + WS_MW13) + (size_t)e * 2 * DFE * D, D, D, 2 * DFE, 0, scr, gw, ngw, lane);
        tr_job(SrcPlain{p.in[37] + (size_t)e * DFE * D, D}, (bf16*)(p.ws + WS_MW2) + (size_t)e * D * DFE, DFE, DFE, D, 0, scr, gw, ngw, lane);
    }
}
DEV void dispatch_phase(const Params& p) {
    const int tid = tid_fresh(), lane = tid & 63, wv = tid >> 6;
    const unsigned* cnt = (const unsigned*)(p.ws + WS_CTL);
    const int* LT = (const int*)(p.ws + WS_LTOK); const float* LW = (const float*)(p.ws + WS_LW);
    int* RT = (int*)(p.ws + WS_ROWTK); float* RW_ = (float*)(p.ws + WS_ROWW);
    const bf16* H = (const bf16*)(p.ws + WS_H); bf16* Hs = (bf16*)(p.ws + WS_HS);
    int off[9]; { int s = 0;
#pragma unroll
        for (int e = 0; e < 8; ++e) { off[e] = s; s += (((int)cnt[e] + 255) >> 8) << 8; } off[8] = s; }
    for (int row = blockIdx.x * 8 + wv; row < off[8]; row += gridDim.x * 8) {
        int e = 0;
#pragma unroll
        for (int q = 1; q < 8; ++q) e += (row >= off[q]) ? 1 : 0;
        const int idx = row - off[e];
        int tk = -1; float w = 0.f;
        if (idx < (int)cnt[e]) { tk = LT[e * T + idx]; w = LW[e * T + idx]; }
        u32x4 v0 = (u32x4){0u, 0u, 0u, 0u}, v1 = v0;
        if (tk >= 0) { const bf16* hr = H + (size_t)(tk >> 1) * D; v0 = *(const u32x4*)(hr + lane * 8); v1 = *(const u32x4*)(hr + 512 + lane * 8); }
        *(u32x4*)(Hs + (size_t)row * D + lane * 8) = v0; *(u32x4*)(Hs + (size_t)row * D + 512 + lane * 8) = v1;
        if (lane == 0) { RT[row] = tk; RW_[row] = w; }
    }
}

#define XB_TMO      128
#define XB_XCNT(j)  (256  + 64 * (j))
#define XB_XSUB(j)  (1280 + 64 * (j))
#define XB_XGEN(j)  (2304 + 64 * (j))
#define XB_TOP      3328
#define XB_TOPGEN   3392
#define XCD_BAR_WORDS 3456
#define XB_SPIN_CAP (1u << 18)
__device__ __forceinline__ unsigned xb_ld(unsigned* p)              { return __hip_atomic_load(p, __ATOMIC_RELAXED, __HIP_MEMORY_SCOPE_AGENT); }
__device__ __forceinline__ unsigned xb_add(unsigned* p, unsigned v) { return __hip_atomic_fetch_add(p, v, __ATOMIC_RELAXED, __HIP_MEMORY_SCOPE_AGENT); }
__device__ __forceinline__ unsigned xb_xcc_id() { return (unsigned)__builtin_amdgcn_s_getreg((3 << 11) | 20) & 0xFu; }
#define XB_SPIN(cond, bar) do { unsigned _sp = 0; while (cond) { __builtin_amdgcn_s_sleep(1); \
    if ((++_sp & 255u) == 0u) { if (xb_ld(&(bar)[XB_TMO])) break; if (_sp > XB_SPIN_CAP) { atomicAdd(&(bar)[XB_TMO], 1u); break; } } } } while (0)
struct XcdBarrier { unsigned* bar; unsigned x; volatile LAS unsigned* st; };
__device__ __forceinline__ XcdBarrier xcd_barrier_post(unsigned* bar, volatile LAS unsigned* st) {
    XcdBarrier b; b.bar = bar; b.x = xb_xcc_id(); b.st = st;
    if (threadIdx.x == 0) (void)xb_add(&bar[XB_XCNT(b.x)], 1u);
    return b;
}
__device__ __forceinline__ void xcd_barrier_complete(unsigned* bar, unsigned x, unsigned& nloc, unsigned& nx) {
    const unsigned G = gridDim.x * gridDim.y * gridDim.z;
    unsigned sum, cnt, mine, sp = 0u;
    for (;;) {
        sum = 0u; cnt = 0u; mine = 0u;
#pragma unroll
        for (unsigned j = 0; j < 16; ++j) { const unsigned c = xb_ld(&bar[XB_XCNT(j)]); sum += c; cnt += (c > 0u) ? 1u : 0u; mine = (j == x) ? c : mine; }
        if (sum == G) break;
        __builtin_amdgcn_s_sleep(1);
        if ((++sp & 255u) == 0u) { if (xb_ld(&bar[XB_TMO])) break; if (sp > XB_SPIN_CAP) { atomicAdd(&bar[XB_TMO], 1u); break; } }
    }
    nloc = mine > 0u ? mine : 1u; nx = cnt > 0u ? cnt : 1u;
}
__device__ __forceinline__ void xcd_barrier(const XcdBarrier& b) {
    asm volatile("s_waitcnt vmcnt(0)" ::: "memory");
    __syncthreads();
    if (threadIdx.x == 0) {
        unsigned* bar = b.bar;
        __builtin_amdgcn_s_waitcnt(0);
        unsigned nloc = b.st[0], nx = b.st[1];
        if (nloc == 0u) { xcd_barrier_complete(bar, b.x, nloc, nx); b.st[0] = nloc; b.st[1] = nx; }
        const unsigned old = xb_add(&bar[XB_XSUB(b.x)], 1u);
        const unsigned gen = old / nloc;
        if (old + 1u == (gen + 1u) * nloc) {
            __builtin_amdgcn_fence(__ATOMIC_RELEASE, "agent");
            asm volatile("s_waitcnt vmcnt(0)" ::: "memory");
            const unsigned og = xb_add(&bar[XB_TOP], 1u);
            const unsigned tg = og / nx;
            if (og + 1u == (tg + 1u) * nx) xb_add(&bar[XB_TOPGEN], 1u);
            else XB_SPIN(xb_ld(&bar[XB_TOPGEN]) == tg, bar);
            __builtin_amdgcn_fence(__ATOMIC_ACQUIRE, "agent");
            xb_add(&bar[XB_XGEN(b.x)], 1u);
            asm volatile("s_waitcnt vmcnt(0)" ::: "memory");
        } else {
            XB_SPIN(xb_ld(&bar[XB_XGEN(b.x)]) == gen, bar);
            __builtin_amdgcn_fence(__ATOMIC_ACQUIRE, "agent");
            asm volatile("s_waitcnt vmcnt(0)" ::: "memory");
        }
    }
    __syncthreads();
}

constexpr int LDS_BYTES = 147456;
constexpr int MISC_OFF = 131072 + 320;
constexpr int NPH = 27;
__global__ void __launch_bounds__(512, 2) fwd(const Params p, const int lo, const int hi) {
    extern __shared__ __attribute__((aligned(16))) unsigned char lds_[];
    LAS unsigned char* lds = (LAS unsigned char*)lds_;
    volatile LAS unsigned* MISC = (volatile LAS unsigned*)(lds + MISC_OFF);
    for (int u = threadIdx.x; u < (LDS_BYTES - 131072) / 4; u += 512) ((LAS unsigned*)(lds + 131072))[u] = 0u;
    __syncthreads();
    unsigned* ctl = (unsigned*)(p.ws + WS_CTL);
    XcdBarrier bar; bar.bar = ctl + 1024; bar.x = 0; bar.st = nullptr;
    if (hi - lo > 1) bar = xcd_barrier_post(ctl + 1024, MISC + 8);
#ifndef ENMASK
#define ENMASK 0xFFFFFFFFu
#endif
#define EN(x) (((ENMASK) >> (x)) & 1u)
#define IN(k) (lo <= (k) && (k) < hi)
#define SEAM(k) do { if (IN(k) && IN((k) + 1)) xcd_barrier(bar); } while (0)
    const int G = gridDim.x, bx = blockIdx.x;
    float* X = p.out;
    const float* MOD = (const float*)(p.ws + WS_MOD);
    bf16* H = (bf16*)(p.ws + WS_H); bf16* U = (bf16*)(p.ws + WS_U); bf16* MRG = (bf16*)(p.ws + WS_MRG);

    if (EN(0) && IN(0)) { mod_phase(p, lds); convert_phase(p, lds); }
    SEAM(0);
    for (int l = 0; l < NL; ++l) {
        const int pb = 1 + l * 11;
        const float* xin = l == 0 ? p.in[0] : X;
        if (EN(1) && IN(pb + 0)) norm_phase<false>(p, l * 2, xin);
        SEAM(pb + 0);
        if (EN(2) && IN(pb + 1)) {
            pg8::StaticOrder S; S.init(H, D, (const bf16*)(p.ws + WS_WIN) + (size_t)l * ZN * D, D, T / 256, ZN / 256, G, bx);
            pg8::gemm_phase(lds, D, D, D, S, EpiZ{p.ws});
        }
        SEAM(pb + 1);
        if (EN(3) && IN(pb + 2)) mixer_phase(p, l, lds);
        SEAM(pb + 2);
        if (EN(4) && IN(pb + 3)) scan_pass1(p);
        SEAM(pb + 3);
        if (EN(5) && IN(pb + 4)) scan_carry(p, lds);
        SEAM(pb + 4);
        if (EN(6) && IN(pb + 5)) scan_pass2(p, l);
        SEAM(pb + 5);
        if (EN(7) && IN(pb + 6)) {
            pg8::StaticOrder S; S.init(U, D, (const bf16*)(p.ws + WS_WMIX) + (size_t)l * D * D, D, T / 256, D / 256, G, bx);
            pg8::gemm_phase(lds, D, D, D, S, EpiMix{(const bf16*)(p.ws + WS_ZG), MRG});
        }
        SEAM(pb + 6);
        if (EN(8) && IN(pb + 7)) {
            pg8::StaticOrder S; S.init(MRG, D, (const bf16*)(p.ws + WS_WO) + (size_t)l * D * D, D, T / 256, D / 256, G, bx);
            pg8::gemm_phase(lds, D, D, D, S, EpiRes{xin, X, MOD + (size_t)((l * 2) * 4) * 3072 + 2048});
        }
        SEAM(pb + 7);
        if (l == 0) {
            if (EN(9) && IN(9)) norm_phase<false>(p, 1, X);
            SEAM(9);
            if (EN(10) && IN(10)) {
                pg8::StaticOrder S; S.init(H, D, (const bf16*)(p.ws + WS_W13), D, T / 256, 2 * DFF / 256, G, bx);
                pg8::gemm_phase(lds, D, D, D, S, EpiSwi{(bf16*)(p.ws + WS_HID), DFF, 0});
            }
            SEAM(10);
            if (EN(11) && IN(11)) {
                pg8::StaticOrder S; S.init((const bf16*)(p.ws + WS_HID), DFF, (const bf16*)(p.ws + WS_W2), DFF, T / 256, D / 256, G, bx);
                pg8::gemm_phase(lds, DFF, DFF, DFF, S, EpiRes{X, X, MOD + (size_t)(1 * 4) * 3072 + 2048});
            }
            SEAM(11);
        } else {
            if (EN(12) && IN(20)) { norm_phase<true>(p, 3, X); convert_moe_phase(p, lds); }
            SEAM(20);
            if (EN(13) && IN(21)) dispatch_phase(p);
            SEAM(21);
            const unsigned* cnt = (const unsigned*)(p.ws + WS_CTL);
            for (int g = 0; g < 2; ++g) {
                if (EN(14) && IN(22 + 2 * g)) {
                    MoeOrder S; S.init(p.ws + WS_HS, D, p.ws + WS_MW13, D, (size_t)2 * DFE * D * 2, cnt, g, 0, 2 * DFE / 256, G, bx);
                    pg8::gemm_phase(lds, D, D, D, S, EpiSwi{(bf16*)(p.ws + WS_EH), DFE, S.t0 * 256});
                }
                SEAM(22 + 2 * g);
                if (EN(15) && IN(23 + 2 * g)) {
                    MoeOrder S; S.init(p.ws + WS_EH, DFE, p.ws + WS_MW2, DFE, (size_t)D * DFE * 2, cnt, g, 1, D / 256, G, bx);
                    pg8::gemm_phase(lds, DFE, DFE, DFE, S, EpiMoeDown{(bf16*)(p.ws + WS_Y), (const int*)(p.ws + WS_ROWTK), (const float*)(p.ws + WS_ROWW)});
                }
                SEAM(23 + 2 * g);
            }
            if (EN(16) && IN(26)) final_phase<true>(p);
        }
    }
#undef IN
#undef SEAM
}
__global__ void k_fill(float* o, int n, float c) { int i = blockIdx.x * blockDim.x + threadIdx.x; if (i < n) o[i] = c; }

#ifndef ONE_LAUNCH
#define ONE_LAUNCH 1
#endif
extern "C" void kernel_launch(void* const* d_in, const int* in_sizes, int n_in, void* d_out, int out_size, void* d_ws, size_t ws_size, hipStream_t stream) {
    if (n_in != 39 || out_size != T * D || ws_size < WS_NEED) { hipLaunchKernelGGL(k_fill, dim3((out_size + 255) / 256), dim3(256), 0, stream, (float*)d_out, out_size, 3.0f); return; }
    static int grid = 0;
    if (!grid) {
        int dev = 0, cus = 0;
        (void)hipGetDevice(&dev); (void)hipDeviceGetAttribute(&cus, hipDeviceAttributeMultiprocessorCount, dev);
        (void)hipFuncSetAttribute((const void*)fwd, hipFuncAttributeMaxDynamicSharedMemorySize, LDS_BYTES);
        int per_cu = 0; (void)hipOccupancyMaxActiveBlocksPerMultiprocessor(&per_cu, (const void*)fwd, 512, LDS_BYTES);
        (void)hipGetLastError();
        grid = cus > 0 ? cus : 256;
    }
    Params p{};
    for (int i = 0; i < 39; ++i) p.in[i] = (const float*)d_in[i];
    p.out = (float*)d_out; p.ws = (unsigned char*)d_ws;
    (void)hipMemsetAsync((unsigned char*)d_ws + WS_CTL, 0, 32768, stream);
#if ONE_LAUNCH
    hipLaunchKernelGGL(fwd, dim3(grid), dim3(512), LDS_BYTES, stream, p, 0, NPH);
#else
    for (int k = 0; k < NPH; ++k) hipLaunchKernelGGL(fwd, dim3(grid), dim3(512), LDS_BYTES, stream, p, k, k + 1);
#endif
}
```

```cpp
#include <hip/hip_runtime.h>
#include <cstdint>
#include <cstdio>

#define DEV __device__ __forceinline__
#define LAS __attribute__((address_space(3)))
typedef unsigned short bf16;
typedef float f32x4 __attribute__((ext_vector_type(4)));
typedef float f32x2 __attribute__((ext_vector_type(2)));
typedef unsigned u32x4 __attribute__((ext_vector_type(4)));
typedef unsigned u32x2 __attribute__((ext_vector_type(2)));

constexpr int D = 1024, NB = 4, SEQ = 4096, T = NB * SEQ, NL = 2;
constexpr int IN_COLS = 5504, OFF_CONV = 256, OFF_RWKV = 768, OFF_GATE = 2432;
constexpr int RW = 512, NH = 8, HD = 64;
constexpr int DFF = 2816, NE = 8, DFE = 3584;
constexpr int ZR_W = 1792, ZG_W = 3072, ZP_W = 256, ZC_W = 512, ZN = 5632;
constexpr int NCH = 64, CH = 64;
constexpr int SCQ = 6 * 64;
constexpr float RMS_EPS = 1e-6f, LN_EPS = 1e-5f, GN_EPS = 64e-5f;

constexpr size_t MiB = 1u << 20;
constexpr size_t WS_CTL = 0;
constexpr size_t WS_MOD = 1 * MiB;
constexpr size_t WS_H = 51 * MiB;
constexpr size_t WS_U = 83 * MiB;
constexpr size_t WS_VF = 115 * MiB;
constexpr size_t WS_G = 147 * MiB;
constexpr size_t WS_BON = 163 * MiB;
constexpr size_t WS_ZG = 164 * MiB;
constexpr size_t WS_ZR = 260 * MiB;
constexpr size_t WS_ZP = 316 * MiB;
constexpr size_t WS_ZC = 324 * MiB;
constexpr size_t WS_LS = 260 * MiB;
constexpr size_t WS_PM = 292 * MiB;
constexpr size_t WS_SC = 340 * MiB;
constexpr size_t WS_WIN = 4 * MiB;
constexpr size_t WS_WMIX = 26 * MiB;
constexpr size_t WS_WO = 30 * MiB;
constexpr size_t WS_W13 = 34 * MiB;
constexpr size_t WS_W2 = 45 * MiB;
constexpr size_t WS_MRG = 51 * MiB;
constexpr size_t WS_HID = 340 * MiB;
constexpr size_t WS_MW13 = 83 * MiB;
constexpr size_t WS_MW2 = 195 * MiB;
constexpr size_t WS_HS = 251 * MiB;
constexpr size_t WS_EH = 319 * MiB;
constexpr size_t WS_Y = 438 * MiB;
constexpr size_t WS_LTOK = 502 * MiB;
constexpr size_t WS_LW = 503 * MiB;
constexpr size_t WS_ROWTK = 504 * MiB;
constexpr size_t WS_ROWW = 505 * MiB;
constexpr size_t WS_NEED = 532 * MiB;

struct Params {
    const float* in[39];
    float* out; unsigned char* ws;
};

DEV int tid_fresh() { int t = threadIdx.x; asm volatile("" : "+v"(t)); return t; }
DEV float bf2f(bf16 b) { return __uint_as_float(((unsigned)b) << 16); }
DEV unsigned f2bf(float f) { unsigned u = __float_as_uint(f); return (u + 0x7fffu + ((u >> 16) & 1u)) >> 16; }
DEV unsigned pk2(float lo, float hi) { return f2bf(lo) | (f2bf(hi) << 16); }
typedef float f32x16 __attribute__((ext_vector_type(16)));
#define DPPF(old, x, ctrl, rmask) __builtin_bit_cast(float, __builtin_amdgcn_update_dpp(__builtin_bit_cast(int, (float)(old)), __builtin_bit_cast(int, (float)(x)), ctrl, rmask, 0xF, false))
DEV float wave_sum(float x) {
    x += DPPF(0.f, x, 0xB1, 0xF); x += DPPF(0.f, x, 0x4E, 0xF); x += DPPF(0.f, x, 0x141, 0xF); x += DPPF(0.f, x, 0x140, 0xF);
    x += DPPF(0.f, x, 0x142, 0xA); x += DPPF(0.f, x, 0x143, 0xC);
    return __builtin_bit_cast(float, __builtin_amdgcn_readlane(__builtin_bit_cast(int, x), 63));
}
#define SLD16(dst, ptr, off) asm volatile("s_load_dwordx16 %0, %1, %2 glc" : "=s"(dst) : "s"(ptr), "n"(off))
#define SLD4(dst, ptr, off) asm volatile("s_load_dwordx4 %0, %1, %2 glc" : "=s"(dst) : "s"(ptr), "n"(off))
DEV float sigmoidf_(float x) { return 1.0f / (1.0f + __expf(-x)); }
DEV float siluf_(float x) { return x / (1.0f + __expf(-x)); }
DEV float softplusf_(float y) { return fmaxf(y, 0.f) + log1pf(__expf(-fabsf(y))); }

DEV void mod_phase(const Params& p, LAS unsigned char* lds) {
    LAS float* sc = (LAS float*)lds;
    LAS float* red = (LAS float*)(lds + 16384);
    const int tid = tid_fresh(), lane = tid & 63, wv = tid >> 6;
    const float* c = p.in[1];
    for (int i = tid; i < 4096; i += 512) sc[i] = siluf_(c[i]);
    __syncthreads();
    float* MOD = (float*)(p.ws + WS_MOD);
    for (int item = blockIdx.x; item < 4 * 48; item += gridDim.x) {
        const int lk = item / 48, nb = item % 48, n = nb * 64 + lane;
        const float* W = p.in[2] + (size_t)lk * 1024 * 3072;
        float a0 = 0.f, a1 = 0.f, a2 = 0.f, a3 = 0.f;
#pragma unroll 16
        for (int k = wv * 128; k < wv * 128 + 128; ++k) {
            const float w = W[(size_t)k * 3072 + n];
            a0 += sc[k] * w; a1 += sc[1024 + k] * w; a2 += sc[2048 + k] * w; a3 += sc[3072 + k] * w;
        }
        red[(wv * 4 + 0) * 64 + lane] = a0; red[(wv * 4 + 1) * 64 + lane] = a1; red[(wv * 4 + 2) * 64 + lane] = a2; red[(wv * 4 + 3) * 64 + lane] = a3;
        __syncthreads();
        if (tid < 256) {
            const int b = tid >> 6; float s = p.in[3][lk * 3072 + n];
            for (int w8 = 0; w8 < 8; ++w8) s += red[(w8 * 4 + b) * 64 + lane];
            MOD[(size_t)(lk * 4 + b) * 3072 + n] = s;
        }
        __syncthreads();
    }
}

template <bool ROUTER>
DEV void norm_phase(const Params& p, int lk, const float* xin, LAS unsigned char* lds) {
    const int tid = tid_fresh(), lane = tid & 63, wv = tid >> 6;
    const int gw = blockIdx.x * 8 + wv, ngw = gridDim.x * 8;
    bf16* H = (bf16*)(p.ws + WS_H);
    const float* MOD = (const float*)(p.ws + WS_MOD);
    const float* g = p.in[4] + (size_t)lk * 1024;
    LAS unsigned* wgc = (LAS unsigned*)lds;
    for (int r0 = gw * 8; r0 < T; r0 += ngw * 8) {
        const int b = r0 / SEQ;
        const float* mod = MOD + (size_t)(lk * 4 + b) * 3072;
        int s_ea = 0, s_eb = 0; float s_wa = 0.f, s_wb = 0.f;
        if (ROUTER) { if (tid < 8) wgc[tid] = 0u; __syncthreads(); }
        f32x4 gs[4], sh[4];
#pragma unroll
        for (int j = 0; j < 4; ++j) {
            const int d = 4 * lane + 256 * j;
            const f32x4 gg = *(const f32x4*)(g + d), scl = *(const f32x4*)(mod + 1024 + d);
            gs[j] = gg * (scl + 1.0f); sh[j] = *(const f32x4*)(mod + d);
        }
        for (int r = r0; r < r0 + 8; ++r) {
            const float* xr = xin + (size_t)r * D;
            f32x4 v[4]; float ss = 0.f;
#pragma unroll
            for (int j = 0; j < 4; ++j) { v[j] = *(const f32x4*)(xr + 4 * lane + 256 * j); ss += (v[j].x * v[j].x + v[j].y * v[j].y) + (v[j].z * v[j].z + v[j].w * v[j].w); }
            const float rstd = 1.0f / sqrtf(wave_sum(ss) * (1.0f / D) + RMS_EPS);
#pragma unroll
            for (int j = 0; j < 4; ++j) v[j] = v[j] * rstd * gs[j] + sh[j];
#pragma unroll
            for (int j = 0; j < 4; ++j) { u32x2 o; o.x = pk2(v[j].x, v[j].y); o.y = pk2(v[j].z, v[j].w); *(u32x2*)(H + (size_t)r * D + 4 * lane + 256 * j) = o; }
            if (ROUTER) {
                const float* R = p.in[34];
                float lg[8];
#pragma unroll
                for (int e = 0; e < 8; ++e) lg[e] = 0.f;
#pragma unroll
                for (int j = 0; j < 4; ++j)
#pragma unroll
                    for (int q = 0; q < 4; ++q) {
                        const int d = 4 * lane + 256 * j + q; const float hv = v[j][q];
                        const f32x4 w0 = *(const f32x4*)(R + (size_t)d * 8), w1 = *(const f32x4*)(R + (size_t)d * 8 + 4);
                        lg[0] += hv * w0.x; lg[1] += hv * w0.y; lg[2] += hv * w0.z; lg[3] += hv * w0.w;
                        lg[4] += hv * w1.x; lg[5] += hv * w1.y; lg[6] += hv * w1.z; lg[7] += hv * w1.w;
                    }
#pragma unroll
                for (int e = 0; e < 8; ++e) lg[e] = wave_sum(lg[e]);
                int ea = 0; float va = lg[0];
#pragma unroll
                for (int e = 1; e < 8; ++e) if (lg[e] > va) { va = lg[e]; ea = e; }
                int eb = -1; float vb = -3.0e38f;
#pragma unroll
                for (int e = 0; e < 8; ++e) if (e != ea && lg[e] > vb) { vb = lg[e]; eb = e; }
                const float wa = 1.0f / (1.0f + __expf(vb - va)), wb = 1.0f - wa;
                if (lane == r - r0) { s_ea = ea; s_eb = eb; s_wa = wa; s_wb = wb; }
            }
        }
        if (ROUTER) {
            unsigned pa = 0u, pb = 0u;
            if (lane < 8) { pa = atomicAdd((unsigned*)(wgc + s_ea), 1u); pb = atomicAdd((unsigned*)(wgc + s_eb), 1u); }
            __syncthreads();
            if (tid < 8) wgc[8 + tid] = atomicAdd((unsigned*)(p.ws + WS_CTL) + tid * 32, wgc[tid]);
            __syncthreads();
            if (lane < 8) {
                int* LT = (int*)(p.ws + WS_LTOK); float* LW = (float*)(p.ws + WS_LW);
                const int r = r0 + lane; const unsigned ga = wgc[8 + s_ea] + pa, gb = wgc[8 + s_eb] + pb;
                LT[s_ea * T + ga] = r * 2 + 0; LW[s_ea * T + ga] = s_wa;
                LT[s_eb * T + gb] = r * 2 + 1; LW[s_eb * T + gb] = s_wb;
            }
            __syncthreads();
        }
    }
}

DEV void mixer_phase(const Params& p, int l, LAS unsigned char* lds) {
    const bf16* Zr = (const bf16*)(p.ws + WS_ZR); const bf16* Zp = (const bf16*)(p.ws + WS_ZP); const bf16* Zc = (const bf16*)(p.ws + WS_ZC);
    bf16* U = (bf16*)(p.ws + WS_U); float* VF = (float*)(p.ws + WS_VF); bf16* G = (bf16*)(p.ws + WS_G); float* BON = (float*)(p.ws + WS_BON);
    float* SC = (float*)(p.ws + WS_SC);
    for (int blk = blockIdx.x; blk < T / 64; blk += gridDim.x) {
        int tid_ = threadIdx.x; asm volatile("" : "+v"(tid_));
        const int tid = tid_, lane = tid & 63, wv = __builtin_amdgcn_readfirstlane(tid >> 6);
        const int m0 = blk * 64, b = m0 / SEQ, tl0 = m0 % SEQ;
        {
            LAS bf16* sp = (LAS bf16*)lds;
            for (int ci = tid; ci < 79 * 32; ci += 512) {
                const int tt = ci >> 5, c8 = (ci & 31) * 8, tl = tl0 - 15 + tt;
                u32x4 v = (u32x4){0u, 0u, 0u, 0u};
                if (tl >= 0) v = *(const u32x4*)(Zp + (size_t)(b * SEQ + tl) * ZP_W + c8);
                *(LAS u32x4*)(sp + tt * 256 + c8) = v;
            }
            __syncthreads();
            const int ch = tid & 255, half = tid >> 8, gi = ch >> 6, win = 2 << gi;
            for (int i = half * 32; i < half * 32 + 32; ++i) {
                float s = 0.f;
                for (int q = 0; q < win; ++q) s += bf2f(sp[(i + 15 - q) * 256 + ch]);
                const int tl = tl0 + i; const float cnt = (float)((tl + 1) < win ? (tl + 1) : win);
                const float val = s / cnt - bf2f(sp[(i + 15) * 256 + ch]);
                U[(size_t)(m0 + i) * D + ch] = (bf16)f2bf(val);
            }
            __syncthreads();
        }
        {
            LAS float* ug = (LAS float*)lds;
            LAS float* cw = (LAS float*)(lds + 94 * 1024);
            for (int idx = tid; idx < 94 * 128; idx += 512) {
                const int tt = idx >> 7, c2 = (idx & 127) * 2, tl = tl0 - 30 + tt;
                float u0 = 0.f, u1 = 0.f;
                if (tl >= 0) {
                    const bf16* zr = Zc + (size_t)(b * SEQ + tl) * ZC_W;
                    const unsigned av = *(const unsigned*)(zr + c2), bv = *(const unsigned*)(zr + 256 + c2);
                    const float a0 = __uint_as_float(av << 16), a1 = __uint_as_float(av & 0xffff0000u), b0 = __uint_as_float(bv << 16), b1 = __uint_as_float(bv & 0xffff0000u);
                    u0 = a0 * sigmoidf_(b0); u1 = a1 * sigmoidf_(b1);
                }
                ug[tt * 256 + c2] = u0; ug[tt * 256 + c2 + 1] = u1;
            }
            const float* CW = p.in[9] + (size_t)l * 31 * 256;
            for (int idx = tid; idx < 31 * 256; idx += 512) cw[idx] = CW[idx];
            __syncthreads();
            const int c4 = 4 * lane;
            const f32x4 cb = *(const f32x4*)(p.in[10] + l * 256 + c4), lg = *(const f32x4*)(p.in[11] + l * 256 + c4), lb = *(const f32x4*)(p.in[12] + l * 256 + c4);
            for (int i = wv; i < 64; i += 8) {
                f32x4 acc = cb;
#pragma unroll 4
                for (int k = 0; k < 31; ++k) acc += *(const LAS f32x4*)(ug + (i + k) * 256 + c4) * *(const LAS f32x4*)(cw + k * 256 + c4);
                const float mean = wave_sum((acc.x + acc.y) + (acc.z + acc.w)) * (1.0f / 256.0f);
                const f32x4 d = acc - mean;
                const float var = wave_sum((d.x * d.x + d.y * d.y) + (d.z * d.z + d.w * d.w)) * (1.0f / 256.0f);
                const float rstd = 1.0f / sqrtf(var + LN_EPS);
                const f32x4 un = d * rstd * lg + lb;
                u32x2 o; o.x = pk2(siluf_(un.x), siluf_(un.y)); o.y = pk2(siluf_(un.z), siluf_(un.w));
                *(u32x2*)(U + (size_t)(m0 + i) * D + 256 + c4) = o;
            }
            __syncthreads();
        }
        {
            LAS float* LA = (LAS float*)lds;
            const float* mu = p.in[14] + (size_t)l * 1664;
            for (int idx = tid; idx < 64 * 144; idx += 512) {
                const int i = idx / 144, c = idx % 144, m = m0 + i, tl = tl0 + i;
                const float zt = bf2f(Zr[(size_t)m * ZR_W + 1536 + c]);
                const float zp = tl > 0 ? bf2f(Zr[(size_t)(m - 1) * ZR_W + 1536 + c]) : 0.f;
                const float mm = c < 128 ? mu[1536 + c] : p.in[27][c - 128];
                const float zs = zt + (zp - zt) * mm;
                LA[idx] = c < 32 ? tanhf(zs) : (c < 64 ? zs : (c < 128 ? sigmoidf_(zs) : zs));
            }
            const int ch = tid, hh = wv;
            const float mur = mu[ch], muk = mu[512 + ch], muv = mu[1024 + ch];
            const int fo = (lane >> 2) * 20 + (lane & 3);
            __syncthreads();
            {
                float w2c[32], a2c[32];
                int chA = ch; asm volatile("" : "+v"(chA));
#pragma unroll
                for (int j = 0; j < 32; ++j) { w2c[j] = p.in[16][(size_t)(l * 32 + j) * 512 + chA]; a2c[j] = p.in[18][(size_t)(l * 32 + j) * 512 + chA]; }
                const float w0 = p.in[15][l * 512 + ch], a0 = p.in[17][l * 512 + ch], ksc = p.in[20][l * 512 + ch], kac = p.in[21][l * 512 + ch], rkc = p.in[22][l * 512 + ch];
                float zrp = 0.f, zkp = 0.f;
                if (tl0 > 0) { const bf16* zr = Zr + (size_t)(m0 - 1) * ZR_W; zrp = bf2f(zr[ch]); zkp = bf2f(zr[512 + ch]); }
                bf16 zrn = Zr[(size_t)m0 * ZR_W + ch], zkn = Zr[(size_t)m0 * ZR_W + 512 + ch];
                for (int i = 0; i < 64; ++i) {
                    const int m = m0 + i, tl = tl0 + i;
                    const float zrt = bf2f(zrn), zkt = bf2f(zkn);
                    { const bf16* zq = Zr + (size_t)(m0 + (i < 63 ? i + 1 : 63)) * ZR_W; zrn = zq[ch]; zkn = zq[512 + ch]; }
                    const float r = zrt + (zrp - zrt) * mur, k = zkt + (zkp - zkt) * muk;
                    zrp = zrt; zkp = zkt;
                    float wl = w0, al = a0;
                    const LAS float* la = LA + i * 144;
#pragma unroll
                    for (int j = 0; j < 32; ++j) { wl += la[j] * w2c[j]; al += la[32 + j] * a2c[j]; }
                    const float w = -softplusf_(-wl) - 0.5f, decay = expf(-expf(w));
                    const float a = sigmoidf_(al);
                    float kk = k * ksc; const float nrm = sqrtf(wave_sum(kk * kk)); kk = kk / fmaxf(nrm, 1e-12f);
                    const float kp = k * (1.0f + (a - 1.0f) * kac), kka = kk * a;
                    const float bon = wave_sum(r * kp * rkc);
                    float* rec = SC + ((size_t)(b * NH + hh) * SEQ + tl) * SCQ + fo;
                    rec[0] = decay; rec[4] = kka; rec[8] = kp; rec[12] = r;
                    if (tl > 0) rec[16 - SCQ] = kk;
                    if (tl == SEQ - 1) rec[16] = 0.f;
                    if (lane == 0) BON[(size_t)m * NH + hh] = bon;
                }
            }
            {
                float g2c[64], v2c[16];
                int chB = ch; asm volatile("" : "+v"(chB));
#pragma unroll
                for (int j = 0; j < 64; ++j) g2c[j] = p.in[19][(size_t)(l * 64 + j) * 512 + chB];
#pragma unroll
                for (int j = 0; j < 16; ++j) v2c[j] = l ? p.in[29][(size_t)j * 512 + chB] : 0.f;
                const float v0 = l ? p.in[28][ch] : 0.f;
                float zvp = 0.f;
                if (tl0 > 0) zvp = bf2f(Zr[(size_t)(m0 - 1) * ZR_W + 1024 + ch]);
                bf16 zvn = Zr[(size_t)m0 * ZR_W + 1024 + ch]; float vfn = l ? VF[(size_t)m0 * RW + ch] : 0.f;
                for (int i = 0; i < 64; ++i) {
                    const int m = m0 + i, tl = tl0 + i;
                    const float zvt = bf2f(zvn), vfc = vfn;
                    { const int mn = m0 + (i < 63 ? i + 1 : 63); zvn = Zr[(size_t)mn * ZR_W + 1024 + ch]; if (l) vfn = VF[(size_t)mn * RW + ch]; }
                    float v = zvt + (zvp - zvt) * muv;
                    zvp = zvt;
                    float gl = 0.f, vl = v0;
                    const LAS float* la = LA + i * 144;
#pragma unroll
                    for (int j = 0; j < 64; ++j) gl += la[64 + j] * g2c[j];
                    if (l) {
#pragma unroll
                        for (int j = 0; j < 16; ++j) vl += la[128 + j] * v2c[j];
                        v = v + (vfc - v) * sigmoidf_(vl);
                    } else VF[(size_t)m * RW + ch] = v;
                    SC[((size_t)(b * NH + hh) * SEQ + tl) * SCQ + 320 + lane] = v;
                    G[(size_t)m * RW + ch] = (bf16)f2bf(gl);
                }
            }
            __syncthreads();
        }
    }
}

struct RecRegs { f32x4 g4; float g1; };
DEV void rec_load(RecRegs& r, const float* rec, int lane) { r.g4 = *(const f32x4*)(rec + lane * 4); r.g1 = rec[256 + lane]; }
DEV void rec_put(const RecRegs& r, LAS float* slot, int lane) { *(LAS f32x4*)(slot + lane * 4) = r.g4; slot[256 + lane] = r.g1; }

DEV void blk4_full(float& s0, float& s1, float& s2, float& s3, float& o, float& san, float sa, float vv, const f32x4& w, const f32x4& ka, const f32x4& kp, const f32x4& rr, const f32x4& kn) {
    asm volatile(
        "v_mul_f32 %0, %8, %0\n v_mul_f32 %1, %9, %1\n v_mul_f32 %2, %10, %2\n v_mul_f32 %3, %11, %3\n"
        "v_fmac_f32 %0, %12, %6\n v_fmac_f32 %1, %13, %6\n v_fmac_f32 %2, %14, %6\n v_fmac_f32 %3, %15, %6\n"
        "v_fmac_f32 %0, %16, %7\n v_fmac_f32 %1, %17, %7\n v_fmac_f32 %2, %18, %7\n v_fmac_f32 %3, %19, %7\n"
        "v_fmac_f32 %4, %20, %0\n v_fmac_f32 %5, %24, %0\n v_fmac_f32 %4, %21, %1\n v_fmac_f32 %5, %25, %1\n"
        "v_fmac_f32 %4, %22, %2\n v_fmac_f32 %5, %26, %2\n v_fmac_f32 %4, %23, %3\n v_fmac_f32 %5, %27, %3\n"
        : "+v"(s0), "+v"(s1), "+v"(s2), "+v"(s3), "+v"(o), "+v"(san)
        : "v"(sa), "v"(vv), "v"(w[0]), "v"(w[1]), "v"(w[2]), "v"(w[3]), "v"(ka[0]), "v"(ka[1]), "v"(ka[2]), "v"(ka[3]), "v"(kp[0]), "v"(kp[1]), "v"(kp[2]), "v"(kp[3]),
          "v"(rr[0]), "v"(rr[1]), "v"(rr[2]), "v"(rr[3]), "v"(kn[0]), "v"(kn[1]), "v"(kn[2]), "v"(kn[3]));
}
DEV void blk4_two(float& s0, float& s1, float& s2, float& s3, float& q0, float& q1, float& q2, float& q3, float& sanl, float& sanp, float sal, float sap, float vv,
                  const f32x4& w, const f32x4& ka, const f32x4& kp, const f32x4& kn) {
    asm volatile(
        "v_mul_f32 %0, %13, %0\n v_mul_f32 %1, %14, %1\n v_mul_f32 %2, %15, %2\n v_mul_f32 %3, %16, %3\n"
        "v_mul_f32 %4, %13, %4\n v_mul_f32 %5, %14, %5\n v_mul_f32 %6, %15, %6\n v_mul_f32 %7, %16, %7\n"
        "v_fmac_f32 %0, %17, %10\n v_fmac_f32 %1, %18, %10\n v_fmac_f32 %2, %19, %10\n v_fmac_f32 %3, %20, %10\n"
        "v_fmac_f32 %4, %17, %11\n v_fmac_f32 %5, %18, %11\n v_fmac_f32 %6, %19, %11\n v_fmac_f32 %7, %20, %11\n"
        "v_fmac_f32 %0, %21, %12\n v_fmac_f32 %1, %22, %12\n v_fmac_f32 %2, %23, %12\n v_fmac_f32 %3, %24, %12\n"
        "v_fmac_f32 %8, %25, %0\n v_fmac_f32 %9, %25, %4\n v_fmac_f32 %8, %26, %1\n v_fmac_f32 %9, %26, %5\n"
        "v_fmac_f32 %8, %27, %2\n v_fmac_f32 %9, %27, %6\n v_fmac_f32 %8, %28, %3\n v_fmac_f32 %9, %28, %7\n"
        : "+v"(s0), "+v"(s1), "+v"(s2), "+v"(s3), "+v"(q0), "+v"(q1), "+v"(q2), "+v"(q3), "+v"(sanl), "+v"(sanp)
        : "v"(sal), "v"(sap), "v"(vv), "v"(w[0]), "v"(w[1]), "v"(w[2]), "v"(w[3]), "v"(ka[0]), "v"(ka[1]), "v"(ka[2]), "v"(ka[3]), "v"(kp[0]), "v"(kp[1]), "v"(kp[2]), "v"(kp[3]),
          "v"(kn[0]), "v"(kn[1]), "v"(kn[2]), "v"(kn[3]));
}
DEV void scan_pass1(const Params& p, LAS unsigned char* lds) {
    const int tid = tid_fresh(), lane = tid & 63, wv = __builtin_amdgcn_readfirstlane(tid >> 6);
    const float* SC = (const float*)(p.ws + WS_SC); float* LS = (float*)(p.ws + WS_LS); float* PM = (float*)(p.ws + WS_PM);
    LAS float* ring = (LAS float*)(lds + wv * 2560);
    for (int u = blockIdx.x * 8 + wv; u < 32 * NCH; u += gridDim.x * 8) {
        const int c = u % NCH;
        const float* rec = SC + (size_t)u * CH * SCQ;
        float S[64], Q[64];
        int ln = lane; asm volatile("" : "+v"(ln));
#pragma unroll
        for (int j = 0; j < 64; ++j) { S[j] = 0.f; Q[j] = (j == ln) ? 1.f : 0.f; }
        float sal = 0.f, sap = c > 0 ? -(rec - SCQ)[(lane >> 2) * 20 + 16 + (lane & 3)] : 0.f;
        RecRegs r1, r2, r3;
        { RecRegs r0; rec_load(r0, rec, lane); rec_put(r0, ring, lane); }
        rec_load(r1, rec + SCQ, lane); rec_load(r2, rec + 2 * SCQ, lane);
        float vvn = rec[320 + lane];
        for (int t = 0; t < CH; t += 2) {
#pragma unroll
            for (int h = 0; h < 2; ++h) {
                LAS float* cur = ring + h * 320; LAS float* nxt = ring + (h ^ 1) * 320;
                const float vv = vvn; vvn = rec[SCQ + 320 + lane];
                rec_load(r3, rec + 3 * SCQ, lane);
                rec_put(r1, nxt, lane); r1 = r2; r2 = r3;
                float sanl = 0.f, sanp = 0.f;
#define P1_LD(X, JB) do { const LAS float* bp = cur + (JB) * 20; X##0 = *(const LAS f32x4*)(bp); X##1 = *(const LAS f32x4*)(bp + 4); X##2 = *(const LAS f32x4*)(bp + 8); X##3 = *(const LAS f32x4*)(bp + 16); } while (0)
#define P1_CB(J0, W, KA, KP, KN) blk4_two(S[(J0)], S[(J0) + 1], S[(J0) + 2], S[(J0) + 3], Q[(J0)], Q[(J0) + 1], Q[(J0) + 2], Q[(J0) + 3], sanl, sanp, sal, sap, vv, W, KA, KP, KN)
#define P1_BLK(JB, X, Y) do { if ((JB) < 15) P1_LD(Y, (JB) + 1); __builtin_amdgcn_sched_barrier(0); P1_CB((JB) * 4, X##0, X##1, X##2, X##3); __builtin_amdgcn_sched_barrier(0); } while (0)
                f32x4 oa0, oa1, oa2, oa3, ob0, ob1, ob2, ob3;
                P1_LD(oa, 0);
                P1_BLK(0, oa, ob); P1_BLK(1, ob, oa); P1_BLK(2, oa, ob); P1_BLK(3, ob, oa); P1_BLK(4, oa, ob); P1_BLK(5, ob, oa); P1_BLK(6, oa, ob); P1_BLK(7, ob, oa);
                P1_BLK(8, oa, ob); P1_BLK(9, ob, oa); P1_BLK(10, oa, ob); P1_BLK(11, ob, oa); P1_BLK(12, oa, ob); P1_BLK(13, ob, oa); P1_BLK(14, oa, ob); P1_BLK(15, ob, oa);
#undef P1_LD
#undef P1_CB
#undef P1_BLK
                sal = -sanl; sap = -sanp; rec += SCQ;
            }
        }
        asm volatile("" :: "v"(vvn), "v"(r1.g4), "v"(r1.g1), "v"(r2.g4), "v"(r2.g1));
        float* o = LS + ((size_t)u * 64 + lane) * 64;
#pragma unroll
        for (int j = 0; j < 64; j += 4) *(f32x4*)(o + j) = (f32x4){S[j], S[j + 1], S[j + 2], S[j + 3]};
        if (c > 0) {
            o = PM + ((size_t)u * 64 + lane) * 64;
#pragma unroll
            for (int j = 0; j < 64; j += 4) *(f32x4*)(o + j) = (f32x4){Q[j], Q[j + 1], Q[j + 2], Q[j + 3]};
        }
    }
}
DEV float rdl(float v, int j) { return __builtin_bit_cast(float, __builtin_amdgcn_readlane(__builtin_bit_cast(int, v), j)); }
DEV void scan_carry(const Params& p, LAS unsigned char* lds) {
    const int tid = tid_fresh(), lane = tid & 63, wv = __builtin_amdgcn_readfirstlane(tid >> 6);
    float* LS = (float*)(p.ws + WS_LS); const float* PM = (const float*)(p.ws + WS_PM);
    LAS float* Pb = (LAS float*)lds;
    for (int u = blockIdx.x; u < 32 * 8; u += gridDim.x) {
        const int bh = u >> 3, i = (u & 7) * 8 + wv;
        float* Lp = LS + (size_t)bh * NCH * 4096 + i * 64 + lane;
        const float* Pp = PM + (size_t)bh * NCH * 4096 + (wv * 8) * 64 + lane;
        float s = 0.f, pr[8];
#pragma unroll
        for (int j = 0; j < 8; ++j) pr[j] = Pp[(size_t)1 * 4096 + j * 64];
        float Lc = Lp[0];
        __builtin_amdgcn_s_barrier();
        for (int c = 0; c < NCH; ++c) {
            LAS float* cur = Pb + (c & 1) * 4096; LAS float* nxt = Pb + ((c + 1) & 1) * 4096;
            if (c + 1 < NCH) {
#pragma unroll
                for (int j = 0; j < 8; ++j) nxt[(wv * 8 + j) * 64 + lane] = pr[j];
            }
            const int c2 = c + 2 < NCH ? c + 2 : NCH - 1, c1 = c + 1 < NCH ? c + 1 : NCH - 1;
#pragma unroll
            for (int j = 0; j < 8; ++j) pr[j] = Pp[(size_t)c2 * 4096 + j * 64];
            const float Ln = Lp[(size_t)c1 * 4096];
            float acc = Lc;
            if (c > 0) {
                float a0 = 0.f, a1 = 0.f, a2 = 0.f, a3 = 0.f;
#pragma unroll
                for (int j = 0; j < 64; j += 4) { a0 += rdl(s, j) * cur[j * 64 + lane]; a1 += rdl(s, j + 1) * cur[(j + 1) * 64 + lane]; a2 += rdl(s, j + 2) * cur[(j + 2) * 64 + lane]; a3 += rdl(s, j + 3) * cur[(j + 3) * 64 + lane]; }
                acc += (a0 + a1) + (a2 + a3);
            }
            Lp[(size_t)c * 4096] = s; s = acc; Lc = Ln;
            asm volatile("s_waitcnt lgkmcnt(0)" ::: "memory"); __builtin_amdgcn_s_barrier(); asm volatile("" ::: "memory");
        }
    }
}
DEV void scan_pass2(const Params& p, int l, LAS unsigned char* lds) {
    const int tid = tid_fresh(), lane = tid & 63, wv = __builtin_amdgcn_readfirstlane(tid >> 6);
    const float* SC = (const float*)(p.ws + WS_SC); const float* LS = (const float*)(p.ws + WS_LS);
    const bf16* G = (const bf16*)(p.ws + WS_G); const float* BON = (const float*)(p.ws + WS_BON); bf16* U = (bf16*)(p.ws + WS_U);
    LAS float* ring = (LAS float*)(lds + wv * 2560);
    for (int u = blockIdx.x * 8 + wv; u < 32 * NCH; u += gridDim.x * 8) {
        const int bh = u / NCH, c = u % NCH, b = bh >> 3, hh = bh & 7;
        const float* rec = SC + (size_t)u * CH * SCQ;
        const float lg = p.in[23][l * 512 + hh * 64 + lane], lb = p.in[24][l * 512 + hh * 64 + lane];
        float S[64];
        const float* s0 = LS + ((size_t)u * 64 + lane) * 64;
#pragma unroll
        for (int j = 0; j < 64; j += 4) { const f32x4 v = *(const f32x4*)(s0 + j); S[j] = v.x; S[j + 1] = v.y; S[j + 2] = v.z; S[j + 3] = v.w; }
        float sa = 0.f;
        RecRegs r1, r2, r3;
        if (c > 0) {
            RecRegs rp; rec_load(rp, rec - SCQ, lane); rec_put(rp, ring + 320, lane);
#pragma unroll
            for (int jb = 0; jb < 16; ++jb) { const f32x4 kn = *(const LAS f32x4*)(ring + 320 + jb * 20 + 16);
#pragma unroll
                for (int q = 0; q < 4; ++q) sa -= S[jb * 4 + q] * kn[q]; }
        }
        { RecRegs r0; rec_load(r0, rec, lane); rec_put(r0, ring, lane); }
        rec_load(r1, rec + SCQ, lane); rec_load(r2, rec + 2 * SCQ, lane);
        float vvn = rec[320 + lane];
        const int m0 = b * SEQ + c * CH;
        for (int t = 0; t < CH; t += 2) {
#pragma unroll
            for (int h = 0; h < 2; ++h) {
                LAS float* cur = ring + h * 320; LAS float* nxt = ring + (h ^ 1) * 320;
                const float vv = vvn; vvn = rec[SCQ + 320 + lane];
                rec_load(r3, rec + 3 * SCQ, lane);
                rec_put(r1, nxt, lane); r1 = r2; r2 = r3;
                const int m = m0 + t + h;
                const float bon = BON[(size_t)m * NH + hh], gt = bf2f(G[(size_t)m * RW + hh * 64 + lane]);
                float o = 0.f, san = 0.f;
#define P2_LD(X, JP) do { const LAS float* bp = cur + (JP) * 40; X##0 = *(const LAS f32x4*)(bp); X##1 = *(const LAS f32x4*)(bp + 4); X##2 = *(const LAS f32x4*)(bp + 8); X##3 = *(const LAS f32x4*)(bp + 12); X##4 = *(const LAS f32x4*)(bp + 16); \
        X##5 = *(const LAS f32x4*)(bp + 20); X##6 = *(const LAS f32x4*)(bp + 24); X##7 = *(const LAS f32x4*)(bp + 28); X##8 = *(const LAS f32x4*)(bp + 32); X##9 = *(const LAS f32x4*)(bp + 36); } while (0)
#define P2_CB(J0, W, KA, KP, RR, KN) blk4_full(S[(J0)], S[(J0) + 1], S[(J0) + 2], S[(J0) + 3], o, san, sa, vv, W, KA, KP, RR, KN)
#define P2_PAIR(JP, X, Y) do { if ((JP) < 7) P2_LD(Y, (JP) + 1); __builtin_amdgcn_sched_barrier(0); P2_CB((JP) * 8, X##0, X##1, X##2, X##3, X##4); P2_CB((JP) * 8 + 4, X##5, X##6, X##7, X##8, X##9); __builtin_amdgcn_sched_barrier(0); } while (0)
                f32x4 oa0, oa1, oa2, oa3, oa4, oa5, oa6, oa7, oa8, oa9, ob0, ob1, ob2, ob3, ob4, ob5, ob6, ob7, ob8, ob9;
                P2_LD(oa, 0);
                P2_PAIR(0, oa, ob); P2_PAIR(1, ob, oa); P2_PAIR(2, oa, ob); P2_PAIR(3, ob, oa); P2_PAIR(4, oa, ob); P2_PAIR(5, ob, oa); P2_PAIR(6, oa, ob); P2_PAIR(7, ob, oa);
#undef P2_LD
#undef P2_CB
#undef P2_PAIR
                sa = -san; rec += SCQ;
                const float mean = wave_sum(o) * (1.0f / 64.0f), dlt = o - mean;
                const float var = wave_sum(dlt * dlt) * (1.0f / 64.0f);
                const float on = dlt * (1.0f / sqrtf(var + GN_EPS)) * lg + lb;
                U[(size_t)m * D + 512 + hh * 64 + lane] = (bf16)f2bf((on + bon * vv) * gt);
            }
        }
        asm volatile("" :: "v"(vvn), "v"(r1.g4), "v"(r1.g1), "v"(r2.g4), "v"(r2.g1));
    }
}

template <bool MOE>
DEV void final_phase(const Params& p) {
    const int tid = tid_fresh(), lane = tid & 63, wv = tid >> 6;
    const float* g = p.in[38]; float* X = p.out;
    const bf16* Y = (const bf16*)(p.ws + WS_Y);
    const float* MOD = (const float*)(p.ws + WS_MOD);
    for (int r = blockIdx.x * 8 + wv; r < T; r += gridDim.x * 8) {
        const int b = r / SEQ;
        const float* gate = MOD + (size_t)(3 * 4 + b) * 3072 + 2048;
        f32x4 v[4]; float ss = 0.f;
#pragma unroll
        for (int j = 0; j < 4; ++j) {
            const int d = 4 * lane + 256 * j;
            v[j] = *(const f32x4*)(X + (size_t)r * D + d);
            if (MOE) {
                const u32x2 y0 = *(const u32x2*)(Y + (size_t)r * D + d), y1 = *(const u32x2*)(Y + (size_t)(T + r) * D + d);
                const f32x4 gt = *(const f32x4*)(gate + d);
                f32x4 ys;
                ys.x = __uint_as_float(y0.x << 16) + __uint_as_float(y1.x << 16); ys.y = __uint_as_float(y0.x & 0xffff0000u) + __uint_as_float(y1.x & 0xffff0000u);
                ys.z = __uint_as_float(y0.y << 16) + __uint_as_float(y1.y << 16); ys.w = __uint_as_float(y0.y & 0xffff0000u) + __uint_as_float(y1.y & 0xffff0000u);
                v[j] += gt * ys;
            }
            ss += (v[j].x * v[j].x + v[j].y * v[j].y) + (v[j].z * v[j].z + v[j].w * v[j].w);
        }
        const float rstd = 1.0f / sqrtf(wave_sum(ss) * (1.0f / D) + RMS_EPS);
#pragma unroll
        for (int j = 0; j < 4; ++j) { const int d = 4 * lane + 256 * j; *(f32x4*)(X + (size_t)r * D + d) = v[j] * rstd * *(const f32x4*)(g + d); }
    }
}

namespace pg8 {
typedef short bf16x8 __attribute__((ext_vector_type(8)));
constexpr int BM = 256, BK = 64, HALF = 128, HTB = HALF * BK * 2  , STAGE_BYTES = 8 * HTB, NXCD = 8, WGM = 8;
DEV int lds_byte(int r, int c) { const int st = (r >> 4) * 2 + (c >> 5), rr = r & 15, cc = c & 31, ob = rr * 64 + cc * 2; return st * 1024 + (ob ^ (((ob >> 9) & 1) << 5)); }
DEV void stage_rc(int b, int& R, int& C) { const int st = b / 1024, sb = b % 1024, swz = sb ^ (((sb >> 9) & 1) << 5); R = (st >> 1) * 16 + swz / 64; C = (st & 1) * 32 + (swz % 64) / 2; }
DEV int perm32(int rho) { const int n = rho >> 4, i = rho & 15; return 8 * (i >> 2) + 4 * n + (i & 3); }
struct Unit { int pm, pn; };
struct StaticOrder {
    const char* A; const char* Bt; int lda, ldb; int nM, nN, nwg, G, c;
    DEV void init(const void* A_, int lda_, const void* Bt_, int ldb_, int nM_, int nN_, int G_, int c_) { A = (const char*)A_; Bt = (const char*)Bt_; lda = lda_; ldb = ldb_; nM = nM_; nN = nN_; nwg = nM * nN; G = G_; c = c_; }
    DEV bool next(int i, Unit& u) const {
        const long L = (long)i * G + c; if (L >= nwg) return false;
        int wgid = (int)L; { const int q = nwg / NXCD, r = nwg % NXCD, xcd = wgid % NXCD, off = wgid / NXCD; wgid = (xcd < r ? xcd * (q + 1) : r * (q + 1) + (xcd - r) * q) + off; }
        const int nig = WGM * nN, gid = wgid / nig, fm = gid * WGM, gsz = (nM - fm) < WGM ? (nM - fm) : WGM;
        u.pm = fm + ((wgid % nig) % gsz); u.pn = (wgid % nig) / gsz; return true;
    }
    DEV const char* a_ptr(const Unit& u) const { return A + (size_t)u.pm * BM * lda * 2; }
    DEV const char* b_ptr(const Unit& u) const { return Bt + (size_t)u.pn * BM * ldb * 2; }
};
template <class Epi, class Sched>
DEV void gemm_phase(LAS unsigned char* lds, const int K, const int lda, const int ldb, const Sched& S, const Epi& E) {
    const int tid = tid_fresh(), wid = __builtin_amdgcn_readfirstlane(tid >> 6), lane = tid & 63, wr = wid >> 2, wc = wid & 3, fr = lane & 15, fq = lane >> 4;
    const int nt = K / BK;
    unsigned voffA[2], voffB[2];
#pragma unroll
    for (int i = 0; i < 2; ++i) { int R, C; stage_rc(tid * 16 + i * 8192, R, C); const int Rb = (R & ~31) + perm32(R & 31);
        voffA[i] = (unsigned)(R * lda + C) * 2u; voffB[i] = (unsigned)(Rb * ldb + C) * 2u; }
    const size_t kstep = (size_t)(BK * 2);
    const size_t hstepA = (size_t)HALF * lda * 2, hstepB = (size_t)HALF * ldb * 2;
    const unsigned ldsw = (unsigned)wid * 1024u;
    const int aoff = lds_byte(wr * 64 + fr, fq * 8), boff = lds_byte(wc * 32 + fr, fq * 8);
#define PG8_SA(b, h) (((b) * 2 + (h)) * HTB)
#define PG8_SB(b, h) ((4 + (b) * 2 + (h)) * HTB)
#define PG8_STAGE(bufoff, gbase, voff) do { _Pragma("unroll") for (int _i = 0; _i < 2; ++_i) \
        __builtin_amdgcn_global_load_lds((const unsigned*)((const char*)(gbase) + (voff)[_i]), (LAS unsigned*)(lds + (bufoff) + ldsw + _i * 8192), 16, 0, 0); } while (0)
#define PG8_LDA(dst, b, h) do { _Pragma("unroll") for (int m = 0; m < 4; ++m) _Pragma("unroll") for (int k = 0; k < 2; ++k) dst[m][k] = *(const LAS bf16x8*)(lds + PG8_SA(b, h) + aoff + m * 2048 + k * 1024); } while (0)
#define PG8_LDB(dst, b, h) do { _Pragma("unroll") for (int n = 0; n < 2; ++n) _Pragma("unroll") for (int k = 0; k < 2; ++k) dst[n][k] = *(const LAS bf16x8*)(lds + PG8_SB(b, h) + boff + n * 2048 + k * 1024); } while (0)
#define PG8_MMA(ai, bj, At, Bt) do { __builtin_amdgcn_s_setprio(1); _Pragma("unroll") for (int m = 0; m < 4; ++m) _Pragma("unroll") for (int n = 0; n < 2; ++n) _Pragma("unroll") for (int k = 0; k < 2; ++k) \
        acc[ai][bj][m][n] = __builtin_amdgcn_mfma_f32_16x16x32_bf16(Bt[n][k], At[m][k], acc[ai][bj][m][n], 0, 0, 0); __builtin_amdgcn_s_setprio(0); } while (0)
#define PG8_WAIT_V(n) asm volatile("s_waitcnt vmcnt(" #n ")" ::: "memory")
#define PG8_WAIT_L(n) asm volatile("s_waitcnt lgkmcnt(" #n ")" ::: "memory")
#define PG8_BAR __builtin_amdgcn_s_barrier()
#define PG8_SCHED __builtin_amdgcn_sched_barrier(0)
    Unit cur, nxt; int ui = 0;
    if (!S.next(0, cur)) return;
    f32x4 acc[2][2][4][2];
#pragma unroll
    for (int a = 0; a < 2; ++a)
#pragma unroll
        for (int b = 0; b < 2; ++b)
#pragma unroll
            for (int m = 0; m < 4; ++m)
#pragma unroll
                for (int n = 0; n < 2; ++n) acc[a][b][m][n] = (f32x4){0.f, 0.f, 0.f, 0.f};
    bf16x8 At[4][2], B0[2][2], B1[2][2];
    const char* cA = S.a_ptr(cur); const char* cB = S.b_ptr(cur);
    PG8_STAGE(PG8_SB(0, 0), cB, voffB); PG8_STAGE(PG8_SB(0, 1), cB + hstepB, voffB); PG8_STAGE(PG8_SA(0, 0), cA, voffA); PG8_STAGE(PG8_SA(0, 1), cA + hstepA, voffA);
    if (wr == 1) PG8_BAR;
    PG8_WAIT_V(2); PG8_BAR;
    PG8_STAGE(PG8_SB(1, 0), cB + kstep, voffB); PG8_STAGE(PG8_SA(1, 0), cA + kstep, voffA); PG8_STAGE(PG8_SB(1, 1), cB + hstepB + kstep, voffB);
    PG8_WAIT_V(6); PG8_BAR;
    for (;;) {
        const bool has_next = S.next(ui + 1, nxt);
        const char* nA = has_next ? S.a_ptr(nxt) : cA; const char* nB = has_next ? S.b_ptr(nxt) : cB;
        for (int t = 0; t < nt; t += 2) {
            const bool last = (t == nt - 2);
            const char* a1 = cA + (size_t)(t + 1) * kstep;
            const char* a2 = last ? nA : cA + (size_t)(t + 2) * kstep; const char* b2 = last ? nB : cB + (size_t)(t + 2) * kstep;
            const char* a3 = a2 + kstep; const char* b3 = b2 + kstep;
            if constexpr (Epi::NMID > 0) { if (t == Epi::MID0 || t == Epi::MID1) E.mid(acc, cur, t == Epi::MID0 ? 0 : 1, wr, wc, fr, fq); }
            PG8_LDB(B0, 0, 0); PG8_LDB(B1, 0, 1); PG8_SCHED; PG8_LDA(At, 0, 0); PG8_STAGE(PG8_SA(1, 1), a1 + hstepA, voffA);
            PG8_WAIT_V(8); PG8_WAIT_L(0); PG8_BAR; PG8_MMA(0, 0, At, B0); PG8_MMA(0, 1, At, B1); PG8_BAR; PG8_SCHED;
            PG8_LDA(At, 0, 1); PG8_STAGE(PG8_SB(0, 0), b2, voffB); PG8_STAGE(PG8_SB(0, 1), b2 + hstepB, voffB); PG8_STAGE(PG8_SA(0, 0), a2, voffA);
            PG8_WAIT_V(8); PG8_WAIT_L(0); PG8_BAR; PG8_MMA(1, 0, At, B0); PG8_MMA(1, 1, At, B1); PG8_BAR; PG8_SCHED;
            PG8_LDB(B0, 1, 0); PG8_LDB(B1, 1, 1); PG8_SCHED; PG8_LDA(At, 1, 0); PG8_STAGE(PG8_SA(0, 1), a2 + hstepA, voffA);
            PG8_WAIT_V(8); PG8_WAIT_L(0); PG8_BAR; PG8_MMA(0, 0, At, B0); PG8_MMA(0, 1, At, B1); PG8_BAR; PG8_SCHED;
            PG8_LDA(At, 1, 1); PG8_STAGE(PG8_SB(1, 0), b3, voffB); PG8_STAGE(PG8_SB(1, 1), b3 + hstepB, voffB); PG8_STAGE(PG8_SA(1, 0), a3, voffA);
            PG8_WAIT_V(8); PG8_WAIT_L(0); PG8_BAR; PG8_MMA(1, 0, At, B0); PG8_MMA(1, 1, At, B1); PG8_BAR; PG8_SCHED;
        }
        if (wr == 0) PG8_BAR;
        E(acc, cur, wr, wc, fr, fq);
        if (!has_next) break;
#pragma unroll
        for (int a = 0; a < 2; ++a)
#pragma unroll
            for (int b = 0; b < 2; ++b)
#pragma unroll
                for (int m = 0; m < 4; ++m)
#pragma unroll
                    for (int n = 0; n < 2; ++n) acc[a][b][m][n] = (f32x4){0.f, 0.f, 0.f, 0.f};
        cur = nxt; cA = nA; cB = nB; ++ui;
        if (wr == 1) PG8_BAR;
    }
    PG8_WAIT_V(0);
    PG8_BAR;
#undef PG8_SA
#undef PG8_SB
#undef PG8_STAGE
#undef PG8_LDA
#undef PG8_LDB
#undef PG8_MMA
#undef PG8_WAIT_V
#undef PG8_WAIT_L
#undef PG8_BAR
#undef PG8_SCHED
}
}

typedef f32x4 Acc[2][2][4][2];
DEV unsigned cvt_pk_bf16(float lo, float hi) { unsigned r; asm volatile("v_cvt_pk_bf16_f32 %0, %1, %2" : "=v"(r) : "v"(lo), "v"(hi)); return r; }
DEV float fsig(float x) { return __builtin_amdgcn_rcpf(1.0f + __builtin_amdgcn_exp2f(-1.44269504f * x)); }
DEV u32x4 pack8(const f32x4& a, const f32x4& b) { u32x4 w; w.x = cvt_pk_bf16(a.x, a.y); w.y = cvt_pk_bf16(a.z, a.w); w.z = cvt_pk_bf16(b.x, b.y); w.w = cvt_pk_bf16(b.z, b.w); return w; }
DEV void unpack8(const u32x4& w, f32x4& a, f32x4& b) {
    a.x = __uint_as_float(w.x << 16); a.y = __uint_as_float(w.x & 0xffff0000u); a.z = __uint_as_float(w.y << 16); a.w = __uint_as_float(w.y & 0xffff0000u);
    b.x = __uint_as_float(w.z << 16); b.y = __uint_as_float(w.z & 0xffff0000u); b.z = __uint_as_float(w.w << 16); b.w = __uint_as_float(w.w & 0xffff0000u); }
struct EpiZ { unsigned char* ws;
    static constexpr int NMID = 0, MID0 = -1, MID1 = -1;
    DEV void operator()(const Acc& acc, const pg8::Unit& u, int wr, int wc, int fr, int fq) const {
        bf16* base; int ld, colt; bool sig = false;
        if (u.pn < 7) { base = (bf16*)(ws + WS_ZR); ld = ZR_W; colt = u.pn * 256; }
        else if (u.pn < 19) { base = (bf16*)(ws + WS_ZG); ld = ZG_W; colt = (u.pn - 7) * 256; sig = true; }
        else if (u.pn == 19) { base = (bf16*)(ws + WS_ZP); ld = ZP_W; colt = 0; }
        else { base = (bf16*)(ws + WS_ZC); ld = ZC_W; colt = (u.pn - 20) * 256; }
        const int row0 = u.pm * 256 + wr * 64 + fr, col0 = colt + wc * 32 + 8 * fq;
#pragma unroll
        for (int ai = 0; ai < 2; ++ai)
#pragma unroll
            for (int m = 0; m < 4; ++m) { bf16* rowp = base + (size_t)(row0 + ai * 128 + m * 16) * ld + col0;
#pragma unroll
                for (int bj = 0; bj < 2; ++bj) { f32x4 v0 = acc[ai][bj][m][0], v1 = acc[ai][bj][m][1];
                    if (sig) {
#pragma unroll
                        for (int e = 0; e < 4; ++e) { v0[e] = fsig(v0[e]); v1[e] = fsig(v1[e]); } }
                    *(u32x4*)(rowp + bj * 128) = pack8(v0, v1); } }
    } };
struct EpiMix { const bf16* Zg; bf16* O;
    static constexpr int NMID = 2, MID0 = 4, MID1 = 8;
    DEV void mid(Acc& acc, const pg8::Unit& u, int seg, int wr, int wc, int fr, int fq) const {
        const int row0 = u.pm * 256 + wr * 64 + fr, col0 = u.pn * 256 + wc * 32 + 8 * fq;
        const bf16* gp = Zg + (size_t)row0 * ZG_W + seg * 1024 + col0;
#pragma unroll
        for (int ai = 0; ai < 2; ++ai) {
#pragma unroll
            for (int m = 0; m < 4; ++m) {
                asm volatile("" : "+v"(gp));
#pragma unroll
                for (int bj = 0; bj < 2; ++bj) { f32x4 n0, n1, d0, d1; unpack8(*(const u32x4*)(gp + bj * 128), n0, n1); unpack8(*(const u32x4*)(gp + 1024 + bj * 128), d0, d1);
#pragma unroll
                    for (int e = 0; e < 4; ++e) { acc[ai][bj][m][0][e] *= n0[e] * __builtin_amdgcn_rcpf(d0[e]); acc[ai][bj][m][1][e] *= n1[e] * __builtin_amdgcn_rcpf(d1[e]); } }
                asm volatile("" : "+v"(acc[ai][0][m][0]), "+v"(acc[ai][0][m][1]), "+v"(acc[ai][1][m][0]), "+v"(acc[ai][1][m][1]) :: "memory");
                gp += 16 * ZG_W; }
            gp += (128 - 64) * ZG_W; }
    }
    DEV void operator()(const Acc& acc, const pg8::Unit& u, int wr, int wc, int fr, int fq) const {
        const int row0 = u.pm * 256 + wr * 64 + fr, col0 = u.pn * 256 + wc * 32 + 8 * fq;
#pragma unroll
        for (int ai = 0; ai < 2; ++ai)
#pragma unroll
            for (int m = 0; m < 4; ++m) { const size_t r = (size_t)(row0 + ai * 128 + m * 16);
#pragma unroll
                for (int bj = 0; bj < 2; ++bj) { f32x4 g0, g1; unpack8(*(const u32x4*)(Zg + r * ZG_W + 2048 + col0 + bj * 128), g0, g1);
                    *(u32x4*)(O + r * D + col0 + bj * 128) = pack8(acc[ai][bj][m][0] * g0, acc[ai][bj][m][1] * g1); }
                asm volatile("" ::: "memory"); }
    } };
struct EpiRes { const float* xin; float* xout; const float* gate;
    static constexpr int NMID = 0, MID0 = -1, MID1 = -1;
    DEV void operator()(const Acc& acc, const pg8::Unit& u, int wr, int wc, int fr, int fq) const {
        const int row0 = u.pm * 256 + wr * 64 + fr, col0 = u.pn * 256 + wc * 32 + 8 * fq;
        const float* g = gate + (size_t)(u.pm >> 4) * 3072 + col0;
        f32x4 gv[2][2];
#pragma unroll
        for (int bj = 0; bj < 2; ++bj)
#pragma unroll
            for (int n = 0; n < 2; ++n) gv[bj][n] = *(const f32x4*)(g + bj * 128 + 4 * n);
#pragma unroll
        for (int ai = 0; ai < 2; ++ai)
#pragma unroll
            for (int m = 0; m < 4; ++m) { const size_t off = (size_t)(row0 + ai * 128 + m * 16) * D + col0;
#pragma unroll
                for (int bj = 0; bj < 2; ++bj)
#pragma unroll
                    for (int n = 0; n < 2; ++n) { const f32x4 x = *(const f32x4*)(xin + off + bj * 128 + 4 * n); *(f32x4*)(xout + off + bj * 128 + 4 * n) = x + gv[bj][n] * acc[ai][bj][m][n]; }
                if (m & 1) asm volatile("" ::: "memory"); }
    } };
struct EpiSwi { bf16* O; int ldo, row_shift;
    static constexpr int NMID = 0, MID0 = -1, MID1 = -1;
    DEV void operator()(const Acc& acc, const pg8::Unit& u, int wr, int wc, int fr, int fq) const {
        const int row0 = u.pm * 256 - row_shift + wr * 64 + fr, col0 = u.pn * 128 + wc * 32 + 8 * fq;
#pragma unroll
        for (int ai = 0; ai < 2; ++ai)
#pragma unroll
            for (int m = 0; m < 4; ++m) { f32x4 h0, h1;
#pragma unroll
                for (int e = 0; e < 4; ++e) { const float a = acc[ai][0][m][0][e], b = acc[ai][0][m][1][e]; h0[e] = a * fsig(a) * acc[ai][1][m][0][e]; h1[e] = b * fsig(b) * acc[ai][1][m][1][e]; }
                *(u32x4*)(O + (size_t)(row0 + ai * 128 + m * 16) * ldo + col0) = pack8(h0, h1); }
    } };
struct EpiMoeDown { bf16* Y; const int* rowtk; const float* roww;
    static constexpr int NMID = 0, MID0 = -1, MID1 = -1;
    DEV void operator()(const Acc& acc, const pg8::Unit& u, int wr, int wc, int fr, int fq) const {
        const int row0 = u.pm * 256 + wr * 64 + fr, col0 = u.pn * 256 + wc * 32 + 8 * fq;
#pragma unroll
        for (int ai = 0; ai < 2; ++ai)
#pragma unroll
            for (int m = 0; m < 4; ++m) { const int r = row0 + ai * 128 + m * 16; const int tk = rowtk[r]; const float w = roww[r];
                if (tk >= 0) { bf16* yp = Y + ((size_t)(tk & 1) * T + (size_t)(tk >> 1)) * D + col0;
#pragma unroll
                    for (int bj = 0; bj < 2; ++bj) *(u32x4*)(yp + bj * 128) = pack8(acc[ai][bj][m][0] * w, acc[ai][bj][m][1] * w); } }
    } };
struct MoeOrder {
    const char* A; const char* Bt; int lda, ldb; size_t estride; int t0, ashift, nM, nN, nwg, G, c; int toff[9];
    DEV void init(const void* A_, int lda_, const void* Bt_, int ldb_, size_t estride_, const unsigned* cnt, int grp, int rel, int nN_, int G_, int c_) {
        A = (const char*)A_; Bt = (const char*)Bt_; lda = lda_; ldb = ldb_; estride = estride_; nN = nN_; G = G_; c = c_;
        int s = 0;
#pragma unroll
        for (int e = 0; e < 8; ++e) { toff[e] = s; s += ((int)cnt[e * 32] + 255) >> 8; }
        toff[8] = s;
        const int half = (s + 1) >> 1; t0 = grp ? half : 0; const int t1 = grp ? s : half; nM = t1 - t0; nwg = nM * nN; ashift = rel ? t0 : 0;
    }
    DEV bool next(int i, pg8::Unit& u) const {
        const long L = (long)i * G + c; if (L >= nwg) return false;
        int wgid = (int)L; { const int q = nwg / 8, r = nwg % 8, xcd = wgid % 8, off = wgid / 8; wgid = (xcd < r ? xcd * (q + 1) : r * (q + 1) + (xcd - r) * q) + off; }
        const int nig = 8 * nN, gid = wgid / nig, fm = gid * 8, gsz = (nM - fm) < 8 ? (nM - fm) : 8;
        u.pm = t0 + fm + ((wgid % nig) % gsz); u.pn = (wgid % nig) / gsz; return true;
    }
    DEV int expert(int pm) const { int e = 0;
#pragma unroll
        for (int q = 1; q < 8; ++q) e += (pm >= toff[q]) ? 1 : 0;
        return e; }
    DEV const char* a_ptr(const pg8::Unit& u) const { return A + (size_t)(u.pm - ashift) * 256 * lda * 2; }
    DEV const char* b_ptr(const pg8::Unit& u) const { return Bt + (size_t)expert(u.pm) * estride + (size_t)u.pn * 256 * ldb * 2; }
};

template <class Src>
DEV void tr_item(const Src& src, bf16* WT, int ldt, int k0, int n0, LAS float* scr, int lane) {
    f32x4 v[8];
    const int kr = lane >> 3, c4 = (lane & 7) * 4;
#pragma unroll
    for (int i = 0; i < 8; ++i) v[i] = src.ld4(k0 + i * 8 + kr, n0 + c4);
#pragma unroll
    for (int i = 0; i < 8; ++i) { LAS float* s = scr + (i * 8 + kr) * 33 + c4; s[0] = v[i].x; s[1] = v[i].y; s[2] = v[i].z; s[3] = v[i].w; }
    asm volatile("s_waitcnt lgkmcnt(0)" ::: "memory");
    const int c = lane & 7;
#pragma unroll
    for (int j = 0; j < 4; ++j) { const int n = (lane >> 3) + 8 * j; const LAS float* s = scr + (8 * c) * 33 + n;
        u32x4 o; o.x = pk2(s[0 * 33], s[1 * 33]); o.y = pk2(s[2 * 33], s[3 * 33]); o.z = pk2(s[4 * 33], s[5 * 33]); o.w = pk2(s[6 * 33], s[7 * 33]);
        *(u32x4*)(WT + (size_t)(n0 + n) * ldt + k0 + 8 * c) = o; }
    asm volatile("s_waitcnt lgkmcnt(0)" ::: "memory");
}
struct SrcPlain { const float* W; int ld; DEV f32x4 ld4(int k, int n) const { return *(const f32x4*)(W + (size_t)k * ld + n); } };
struct SrcIn { const float* W; const float* Wv; int live;
    DEV f32x4 ld4(int k, int n) const {
        const f32x4 z = (f32x4){0.f, 0.f, 0.f, 0.f};
        if (n < 1664) return *(const f32x4*)(W + (size_t)k * IN_COLS + OFF_RWKV + n);
        if (n < 1680) return live ? *(const f32x4*)(Wv + (size_t)k * 16 + (n - 1664)) : z;
        if (n < 1792) return z;
        if (n < 4864) return *(const f32x4*)(W + (size_t)k * IN_COLS + OFF_GATE + (n - 1792));
        if (n < 5120) return *(const f32x4*)(W + (size_t)k * IN_COLS + (n - 4864));
        return *(const f32x4*)(W + (size_t)k * IN_COLS + OFF_CONV + (n - 5120));
    } };
struct SrcPair { const float* W1; const float* W3; int ld;
    DEV f32x4 ld4(int k, int n) const { const int pn = n >> 8, j = n & 255; const float* W = W1 + (ptrdiff_t)(j >> 7) * (W3 - W1); return *(const f32x4*)(W + (size_t)k * ld + pn * 128 + (j & 127)); } };
template <class Src>
DEV void tr_job(const Src& src, bf16* WT, int ldt, int K, int N, int koff, LAS float* scr, int gw, int ngw, int lane) {
    const int nkb = K / 64, nnb = N / 32;
    for (int it = gw; it < nkb * nnb; it += ngw) { const int kb = it / nnb, nb = it % nnb;
        tr_item(src, WT + koff, ldt, kb * 64, nb * 32, scr, lane); }
}
DEV void convert_phase(const Params& p, LAS unsigned char* lds) {
    const int tid = tid_fresh(), lane = tid & 63, wv = __builtin_amdgcn_readfirstlane(tid >> 6);
    LAS float* scr = (LAS float*)(lds + 32768 + wv * 8704);
    const int gw = blockIdx.x * 8 + wv, ngw = gridDim.x * 8;
    for (int l = 0; l < NL; ++l) {
        bf16* WinT = (bf16*)(p.ws + WS_WIN) + (size_t)l * ZN * D;
        tr_job(SrcIn{p.in[5] + (size_t)l * D * IN_COLS, p.in[26], l}, WinT, D, D, ZN, 0, scr, gw, ngw, lane);
        bf16* WmixT = (bf16*)(p.ws + WS_WMIX) + (size_t)l * D * D;
        tr_job(SrcPlain{p.in[13] + (size_t)l * 256 * D, D}, WmixT, D, 256, D, 256, scr, gw, ngw, lane);
        tr_job(SrcPlain{p.in[25] + (size_t)l * 512 * D, D}, WmixT, D, 512, D, 512, scr, gw, ngw, lane);
        tr_job(SrcPlain{p.in[30] + (size_t)l * D * D, D}, (bf16*)(p.ws + WS_WO) + (size_t)l * D * D, D, D, D, 0, scr, gw, ngw, lane);
        const float* pw = p.in[6] + (size_t)l * 4 * 64 * 64; const float* ps = p.in[7] + l * 256; const float* pp = p.in[8] + (size_t)l * 256 * D;
        for (int it = gw; it < 32 * 16; it += ngw) {
            const int k8 = it >> 4, n = (it & 15) * 64 + lane, g = k8 >> 3;
            float a[8];
#pragma unroll
            for (int e = 0; e < 8; ++e) a[e] = 0.f;
            for (int d = 0; d < 64; ++d) { const float pv = pp[(size_t)(g * 64 + d) * D + n] * ps[g * 64 + d];
#pragma unroll
                for (int e = 0; e < 8; ++e) a[e] += pw[(size_t)(k8 * 8 + e) * 64 + d] * pv; }
            u32x4 o; o.x = pk2(a[0], a[1]); o.y = pk2(a[2], a[3]); o.z = pk2(a[4], a[5]); o.w = pk2(a[6], a[7]);
            *(u32x4*)(WmixT + (size_t)n * D + k8 * 8) = o;
        }
    }
    tr_job(SrcPair{p.in[31], p.in[32], DFF}, (bf16*)(p.ws + WS_W13), D, D, 2 * DFF, 0, scr, gw, ngw, lane);
    tr_job(SrcPlain{p.in[33], D}, (bf16*)(p.ws + WS_W2), DFF, DFF, D, 0, scr, gw, ngw, lane);
}
DEV void convert_moe_phase(const Params& p, LAS unsigned char* lds) {
    const int tid = tid_fresh(), lane = tid & 63, wv = __builtin_amdgcn_readfirstlane(tid >> 6);
    LAS float* scr = (LAS float*)(lds + 32768 + wv * 8704);
    const int gw = blockIdx.x * 8 + wv, ngw = gridDim.x * 8;
    for (int e = 0; e < NE; ++e) {
        tr_job(SrcPair{p.in[35] + (size_t)e * D * DFE, p.in[36] + (size_t)e * D * DFE, DFE}, (bf16*)(p.ws + WS_MW13) + (size_t)e * 2 * DFE * D, D, D, 2 * DFE, 0, scr, gw, ngw, lane);
        tr_job(SrcPlain{p.in[37] + (size_t)e * DFE * D, D}, (bf16*)(p.ws + WS_MW2) + (size_t)e * D * DFE, DFE, DFE, D, 0, scr, gw, ngw, lane);
    }
}
DEV void dispatch_phase(const Params& p) {
    const int tid = tid_fresh(), lane = tid & 63, wv = tid >> 6;
    const unsigned* cnt = (const unsigned*)(p.ws + WS_CTL);
    const int* LT = (const int*)(p.ws + WS_LTOK); const float* LW = (const float*)(p.ws + WS_LW);
    int* RT = (int*)(p.ws + WS_ROWTK); float* RW_ = (float*)(p.ws + WS_ROWW);
    const bf16* H = (const bf16*)(p.ws + WS_H); bf16* Hs = (bf16*)(p.ws + WS_HS);
    int off[9]; { int s = 0;
#pragma unroll
        for (int e = 0; e < 8; ++e) { off[e] = s; s += (((int)cnt[e * 32] + 255) >> 8) << 8; } off[8] = s; }
    for (int row = blockIdx.x * 8 + wv; row < off[8]; row += gridDim.x * 8) {
        int e = 0;
#pragma unroll
        for (int q = 1; q < 8; ++q) e += (row >= off[q]) ? 1 : 0;
        const int idx = row - off[e];
        int tk = -1; float w = 0.f;
        if (idx < (int)cnt[e * 32]) { tk = LT[e * T + idx]; w = LW[e * T + idx]; }
        u32x4 v0 = (u32x4){0u, 0u, 0u, 0u}, v1 = v0;
        if (tk >= 0) { const bf16* hr = H + (size_t)(tk >> 1) * D; v0 = *(const u32x4*)(hr + lane * 8); v1 = *(const u32x4*)(hr + 512 + lane * 8); }
        *(u32x4*)(Hs + (size_t)row * D + lane * 8) = v0; *(u32x4*)(Hs + (size_t)row * D + 512 + lane * 8) = v1;
        if (lane == 0) { RT[row] = tk; RW_[row] = w; }
    }
}

#define XB_TMO      128
#define XB_XCNT(j)  (256  + 64 * (j))
#define XB_XSUB(j)  (1280 + 64 * (j))
#define XB_XGEN(j)  (2304 + 64 * (j))
#define XB_TOP      3328
#define XB_TOPGEN   3392
#define XCD_BAR_WORDS 3456
#define XB_SPIN_CAP (1u << 18)
__device__ __forceinline__ unsigned xb_ld(unsigned* p)              { return __hip_atomic_load(p, __ATOMIC_RELAXED, __HIP_MEMORY_SCOPE_AGENT); }
__device__ __forceinline__ unsigned xb_add(unsigned* p, unsigned v) { return __hip_atomic_fetch_add(p, v, __ATOMIC_RELAXED, __HIP_MEMORY_SCOPE_AGENT); }
__device__ __forceinline__ unsigned xb_xcc_id() { return (unsigned)__builtin_amdgcn_s_getreg((3 << 11) | 20) & 0xFu; }
#define XB_SPIN(cond, bar) do { unsigned _sp = 0; while (cond) { __builtin_amdgcn_s_sleep(1); \
    if ((++_sp & 255u) == 0u) { if (xb_ld(&(bar)[XB_TMO])) break; if (_sp > XB_SPIN_CAP) { atomicAdd(&(bar)[XB_TMO], 1u); break; } } } } while (0)
struct XcdBarrier { unsigned* bar; unsigned x; volatile LAS unsigned* st; };
__device__ __forceinline__ XcdBarrier xcd_barrier_post(unsigned* bar, volatile LAS unsigned* st) {
    XcdBarrier b; b.bar = bar; b.x = xb_xcc_id(); b.st = st;
    if (threadIdx.x == 0) (void)xb_add(&bar[XB_XCNT(b.x)], 1u);
    return b;
}
__device__ __forceinline__ void xcd_barrier_complete(unsigned* bar, unsigned x, unsigned& nloc, unsigned& nx) {
    const unsigned G = gridDim.x * gridDim.y * gridDim.z;
    unsigned sum, cnt, mine, sp = 0u;
    for (;;) {
        sum = 0u; cnt = 0u; mine = 0u;
#pragma unroll
        for (unsigned j = 0; j < 16; ++j) { const unsigned c = xb_ld(&bar[XB_XCNT(j)]); sum += c; cnt += (c > 0u) ? 1u : 0u; mine = (j == x) ? c : mine; }
        if (sum == G) break;
        __builtin_amdgcn_s_sleep(1);
        if ((++sp & 255u) == 0u) { if (xb_ld(&bar[XB_TMO])) break; if (sp > XB_SPIN_CAP) { atomicAdd(&bar[XB_TMO], 1u); break; } }
    }
    nloc = mine > 0u ? mine : 1u; nx = cnt > 0u ? cnt : 1u;
}
__device__ __forceinline__ void xcd_barrier(const XcdBarrier& b) {
    asm volatile("s_waitcnt vmcnt(0)" ::: "memory");
    __syncthreads();
    if (threadIdx.x == 0) {
        unsigned* bar = b.bar;
        __builtin_amdgcn_s_waitcnt(0);
        unsigned nloc = b.st[0], nx = b.st[1];
        if (nloc == 0u) { xcd_barrier_complete(bar, b.x, nloc, nx); b.st[0] = nloc; b.st[1] = nx; }
        const unsigned old = xb_add(&bar[XB_XSUB(b.x)], 1u);
        const unsigned gen = old / nloc;
        if (old + 1u == (gen + 1u) * nloc) {
            __builtin_amdgcn_fence(__ATOMIC_RELEASE, "agent");
            asm volatile("s_waitcnt vmcnt(0)" ::: "memory");
            const unsigned og = xb_add(&bar[XB_TOP], 1u);
            const unsigned tg = og / nx;
            if (og + 1u == (tg + 1u) * nx) xb_add(&bar[XB_TOPGEN], 1u);
            else XB_SPIN(xb_ld(&bar[XB_TOPGEN]) == tg, bar);
            __builtin_amdgcn_fence(__ATOMIC_ACQUIRE, "agent");
            xb_add(&bar[XB_XGEN(b.x)], 1u);
            asm volatile("s_waitcnt vmcnt(0)" ::: "memory");
        } else {
            XB_SPIN(xb_ld(&bar[XB_XGEN(b.x)]) == gen, bar);
            __builtin_amdgcn_fence(__ATOMIC_ACQUIRE, "agent");
            asm volatile("s_waitcnt vmcnt(0)" ::: "memory");
        }
    }
    __syncthreads();
}

constexpr int LDS_BYTES = 147456;
constexpr int MISC_OFF = 131072 + 320;
constexpr int NPH = 27;
__global__ void __launch_bounds__(512, 2) fwd(const Params p, const int lo, const int hi) {
    extern __shared__ __attribute__((aligned(16))) unsigned char lds_[];
    LAS unsigned char* lds = (LAS unsigned char*)lds_;
    volatile LAS unsigned* MISC = (volatile LAS unsigned*)(lds + MISC_OFF);
    for (int u = threadIdx.x; u < (LDS_BYTES - 131072) / 4; u += 512) ((LAS unsigned*)(lds + 131072))[u] = 0u;
    __syncthreads();
    unsigned* ctl = (unsigned*)(p.ws + WS_CTL);
    XcdBarrier bar; bar.bar = ctl + 1024; bar.x = 0; bar.st = nullptr;
    if (hi - lo > 1) bar = xcd_barrier_post(ctl + 1024, MISC + 8);
#ifndef ENMASK
#define ENMASK 0xFFFFFFFFu
#endif
#define EN(x) (((ENMASK) >> (x)) & 1u)
#define IN(k) (lo <= (k) && (k) < hi)
#define SEAM(k) do { if (IN(k) && IN((k) + 1)) xcd_barrier(bar); } while (0)
#ifndef PROF_SEL
#define PROF_SEL -1
#endif
    volatile LAS unsigned long long* pfw = (volatile LAS unsigned long long*)(lds + MISC_OFF + 64);
#define TICK(ty) do { if (PROF_SEL >= 0 && blockIdx.x == 0 && threadIdx.x == 0) { const unsigned long long now_ = __builtin_amdgcn_s_memrealtime(); if ((ty) == PROF_SEL) pfw[1] = pfw[1] + (now_ - pfw[0]); pfw[0] = now_; } } while (0)
    TICK(-2);
    const int G = gridDim.x, bx = blockIdx.x;
    float* X = p.out;
    const float* MOD = (const float*)(p.ws + WS_MOD);
    bf16* H = (bf16*)(p.ws + WS_H); bf16* U = (bf16*)(p.ws + WS_U); bf16* MRG = (bf16*)(p.ws + WS_MRG);

    if (EN(0) && IN(0)) { mod_phase(p, lds); convert_phase(p, lds); }
    SEAM(0); TICK(0);
    for (int l = 0; l < NL; ++l) {
        const int pb = 1 + l * 11;
        const float* xin = l == 0 ? p.in[0] : X;
        if (EN(1) && IN(pb + 0)) norm_phase<false>(p, l * 2, xin, lds);
        SEAM(pb + 0); TICK(1);
        if (EN(2) && IN(pb + 1)) {
            pg8::StaticOrder S; S.init(H, D, (const bf16*)(p.ws + WS_WIN) + (size_t)l * ZN * D, D, T / 256, ZN / 256, G, bx);
            pg8::gemm_phase(lds, D, D, D, S, EpiZ{p.ws});
        }
        SEAM(pb + 1); TICK(2);
        if (EN(3) && IN(pb + 2)) mixer_phase(p, l, lds);
        SEAM(pb + 2); TICK(3);
        if (EN(4) && IN(pb + 3)) scan_pass1(p, lds);
        SEAM(pb + 3); TICK(4);
        if (EN(5) && IN(pb + 4)) scan_carry(p, lds);
        SEAM(pb + 4); TICK(5);
        if (EN(6) && IN(pb + 5)) scan_pass2(p, l, lds);
        SEAM(pb + 5); TICK(6);
        if (EN(7) && IN(pb + 6)) {
            pg8::StaticOrder S; S.init(U, D, (const bf16*)(p.ws + WS_WMIX) + (size_t)l * D * D, D, T / 256, D / 256, G, bx);
            pg8::gemm_phase(lds, D, D, D, S, EpiMix{(const bf16*)(p.ws + WS_ZG), MRG});
        }
        SEAM(pb + 6); TICK(7);
        if (EN(8) && IN(pb + 7)) {
            pg8::StaticOrder S; S.init(MRG, D, (const bf16*)(p.ws + WS_WO) + (size_t)l * D * D, D, T / 256, D / 256, G, bx);
            pg8::gemm_phase(lds, D, D, D, S, EpiRes{xin, X, MOD + (size_t)((l * 2) * 4) * 3072 + 2048});
        }
        SEAM(pb + 7); TICK(8);
        if (l == 0) {
            if (EN(9) && IN(9)) norm_phase<false>(p, 1, X, lds);
            SEAM(9); TICK(9);
            if (EN(10) && IN(10)) {
                pg8::StaticOrder S; S.init(H, D, (const bf16*)(p.ws + WS_W13), D, T / 256, 2 * DFF / 256, G, bx);
                pg8::gemm_phase(lds, D, D, D, S, EpiSwi{(bf16*)(p.ws + WS_HID), DFF, 0});
            }
            SEAM(10); TICK(10);
            if (EN(11) && IN(11)) {
                pg8::StaticOrder S; S.init((const bf16*)(p.ws + WS_HID), DFF, (const bf16*)(p.ws + WS_W2), DFF, T / 256, D / 256, G, bx);
                pg8::gemm_phase(lds, DFF, DFF, DFF, S, EpiRes{X, X, MOD + (size_t)(1 * 4) * 3072 + 2048});
            }
            SEAM(11); TICK(11);
        } else {
            if (EN(12) && IN(20)) { norm_phase<true>(p, 3, X, lds); TICK(17); convert_moe_phase(p, lds); }
            SEAM(20); TICK(12);
            if (EN(13) && IN(21)) dispatch_phase(p);
            SEAM(21); TICK(13);
            const unsigned* cnt = (const unsigned*)(p.ws + WS_CTL);
            for (int g = 0; g < 2; ++g) {
                if (EN(14) && IN(22 + 2 * g)) {
                    MoeOrder S; S.init(p.ws + WS_HS, D, p.ws + WS_MW13, D, (size_t)2 * DFE * D * 2, cnt, g, 0, 2 * DFE / 256, G, bx);
                    pg8::gemm_phase(lds, D, D, D, S, EpiSwi{(bf16*)(p.ws + WS_EH), DFE, S.t0 * 256});
                }
                SEAM(22 + 2 * g); TICK(14);
                if (EN(15) && IN(23 + 2 * g)) {
                    MoeOrder S; S.init(p.ws + WS_EH, DFE, p.ws + WS_MW2, DFE, (size_t)D * DFE * 2, cnt, g, 1, D / 256, G, bx);
                    pg8::gemm_phase(lds, DFE, DFE, DFE, S, EpiMoeDown{(bf16*)(p.ws + WS_Y), (const int*)(p.ws + WS_ROWTK), (const float*)(p.ws + WS_ROWW)});
                }
                SEAM(23 + 2 * g); TICK(15);
            }
            if (EN(16) && IN(26)) final_phase<true>(p);
            TICK(16);
            if (PROF_SEL >= 0 && blockIdx.x == 0 && threadIdx.x == 0) { const unsigned long long t0_ = __builtin_amdgcn_s_memrealtime(); const unsigned long long w_ = 4ull * pfw[1]; while (__builtin_amdgcn_s_memrealtime() - t0_ < w_) __builtin_amdgcn_s_sleep(8); }
        }
    }
#undef IN
#undef SEAM
}
__global__ void k_fill(float* o, int n, float c) { int i = blockIdx.x * blockDim.x + threadIdx.x; if (i < n) o[i] = c; }

#ifndef ONE_LAUNCH
#define ONE_LAUNCH 1
#endif
extern "C" void kernel_launch(void* const* d_in, const int* in_sizes, int n_in, void* d_out, int out_size, void* d_ws, size_t ws_size, hipStream_t stream) {
    if (n_in != 39 || out_size != T * D || ws_size < WS_NEED) { hipLaunchKernelGGL(k_fill, dim3((out_size + 255) / 256), dim3(256), 0, stream, (float*)d_out, out_size, 3.0f); return; }
    static int grid = 0;
    if (!grid) {
        int dev = 0, cus = 0;
        (void)hipGetDevice(&dev); (void)hipDeviceGetAttribute(&cus, hipDeviceAttributeMultiprocessorCount, dev);
        (void)hipFuncSetAttribute((const void*)fwd, hipFuncAttributeMaxDynamicSharedMemorySize, LDS_BYTES);
        int per_cu = 0; (void)hipOccupancyMaxActiveBlocksPerMultiprocessor(&per_cu, (const void*)fwd, 512, LDS_BYTES);
        (void)hipGetLastError();
        grid = cus > 0 ? cus : 256;
    }
    Params p{};
    for (int i = 0; i < 39; ++i) p.in[i] = (const float*)d_in[i];
    p.out = (float*)d_out; p.ws = (unsigned char*)d_ws;
    (void)hipMemsetAsync((unsigned char*)d_ws + WS_CTL, 0, 32768, stream);
#if ONE_LAUNCH
    hipLaunchKernelGGL(fwd, dim3(grid), dim3(512), LDS_BYTES, stream, p, 0, NPH);
#else
    for (int k = 0; k < NPH; ++k) hipLaunchKernelGGL(fwd, dim3(grid), dim3(512), LDS_BYTES, stream, p, k, k + 1);
#endif
}
```

```cpp
#include <hip/hip_runtime.h>
#include <cstdint>
#include <cstdio>

#define DEV __device__ __forceinline__
#define LAS __attribute__((address_space(3)))
typedef unsigned short bf16;
typedef float f32x4 __attribute__((ext_vector_type(4)));
typedef float f32x2 __attribute__((ext_vector_type(2)));
typedef unsigned u32x4 __attribute__((ext_vector_type(4)));
typedef unsigned u32x2 __attribute__((ext_vector_type(2)));

constexpr int D = 1024, NB = 4, SEQ = 4096, T = NB * SEQ, NL = 2;
constexpr int IN_COLS = 5504, OFF_CONV = 256, OFF_RWKV = 768, OFF_GATE = 2432;
constexpr int RW = 512, NH = 8, HD = 64;
constexpr int DFF = 2816, NE = 8, DFE = 3584;
constexpr int ZR_W = 1792, ZG_W = 3072, ZP_W = 256, ZC_W = 512, ZN = 5632;
constexpr int NCH = 64, CH = 64;
constexpr int SCH = 384;
constexpr float RMS_EPS = 1e-6f, LN_EPS = 1e-5f, GN_EPS = 64e-5f;

constexpr size_t MiB = 1u << 20;
constexpr size_t WS_CTL = 0;
constexpr size_t WS_MOD = 1 * MiB;
constexpr size_t WS_H = 51 * MiB;
constexpr size_t WS_U = 83 * MiB;
constexpr size_t WS_VF = 115 * MiB;
constexpr size_t WS_G = 147 * MiB;
constexpr size_t WS_BON = 163 * MiB;
constexpr size_t WS_ZG = 164 * MiB;
constexpr size_t WS_ZR = 260 * MiB;
constexpr size_t WS_ZP = 316 * MiB;
constexpr size_t WS_ZC = 324 * MiB;
constexpr size_t WS_LS = 260 * MiB;
constexpr size_t WS_PM = 292 * MiB;
constexpr size_t WS_SC = 340 * MiB;
constexpr size_t WS_LORA = 2 * MiB;
constexpr size_t WS_WIN = 4 * MiB;
constexpr size_t WS_WMIX = 26 * MiB;
constexpr size_t WS_WO = 30 * MiB;
constexpr size_t WS_W13 = 34 * MiB;
constexpr size_t WS_W2 = 45 * MiB;
constexpr size_t WS_MRG = 51 * MiB;
constexpr size_t WS_HID = 340 * MiB;
constexpr size_t WS_MW13 = 83 * MiB;
constexpr size_t WS_MW2 = 195 * MiB;
constexpr size_t WS_HS = 251 * MiB;
constexpr size_t WS_EH = 319 * MiB;
constexpr size_t WS_Y = 438 * MiB;
constexpr size_t WS_LTOK = 502 * MiB;
constexpr size_t WS_LW = 503 * MiB;
constexpr size_t WS_ROWTK = 504 * MiB;
constexpr size_t WS_ROWW = 505 * MiB;
constexpr size_t WS_NEED = 532 * MiB;

struct Params {
    const float* in[39];
    float* out; unsigned char* ws;
};

DEV int tid_fresh() { int t = threadIdx.x; asm volatile("" : "+v"(t)); return t; }
DEV float bf2f(bf16 b) { return __uint_as_float(((unsigned)b) << 16); }
DEV unsigned f2bf(float f) { unsigned u = __float_as_uint(f); return (u + 0x7fffu + ((u >> 16) & 1u)) >> 16; }
DEV unsigned pk2(float lo, float hi) { return f2bf(lo) | (f2bf(hi) << 16); }
typedef float f32x16 __attribute__((ext_vector_type(16)));
#define DPPF(old, x, ctrl, rmask) __builtin_bit_cast(float, __builtin_amdgcn_update_dpp(__builtin_bit_cast(int, (float)(old)), __builtin_bit_cast(int, (float)(x)), ctrl, rmask, 0xF, false))
DEV float wave_sum(float x) {
    x += DPPF(0.f, x, 0xB1, 0xF); x += DPPF(0.f, x, 0x4E, 0xF); x += DPPF(0.f, x, 0x141, 0xF); x += DPPF(0.f, x, 0x140, 0xF);
    x += DPPF(0.f, x, 0x142, 0xA); x += DPPF(0.f, x, 0x143, 0xC);
    return __builtin_bit_cast(float, __builtin_amdgcn_readlane(__builtin_bit_cast(int, x), 63));
}
#define SLD16(dst, ptr, off) asm volatile("s_load_dwordx16 %0, %1, %2 glc" : "=s"(dst) : "s"(ptr), "n"(off))
#define SLD4(dst, ptr, off) asm volatile("s_load_dwordx4 %0, %1, %2 glc" : "=s"(dst) : "s"(ptr), "n"(off))
DEV float sigmoidf_(float x) { return 1.0f / (1.0f + __expf(-x)); }
DEV float siluf_(float x) { return x / (1.0f + __expf(-x)); }
DEV float fsig_(float x) { return __builtin_amdgcn_rcpf(1.0f + __expf(-x)); }
DEV f32x4 ld4bf(const bf16* p_) { const u32x2 w = *(const u32x2*)p_; return (f32x4){__uint_as_float(w.x << 16), __uint_as_float(w.x & 0xffff0000u), __uint_as_float(w.y << 16), __uint_as_float(w.y & 0xffff0000u)}; }
DEV u32x4 pack8b(const f32x4& a, const f32x4& b) { u32x4 w; w.x = pk2(a.x, a.y); w.y = pk2(a.z, a.w); w.z = pk2(b.x, b.y); w.w = pk2(b.z, b.w); return w; }
DEV unsigned pkh(float a, float b) { typedef _Float16 h2 __attribute__((ext_vector_type(2))); const h2 t = {(_Float16)a, (_Float16)b}; return __builtin_bit_cast(unsigned, t); }
DEV u32x4 packh8(const f32x4& a, const f32x4& b) { u32x4 w; w.x = pkh(a.x, a.y); w.y = pkh(a.z, a.w); w.z = pkh(b.x, b.y); w.w = pkh(b.z, b.w); return w; }
DEV void unpack8(const u32x4& w, f32x4& a, f32x4& b) {
    a.x = __uint_as_float(w.x << 16); a.y = __uint_as_float(w.x & 0xffff0000u); a.z = __uint_as_float(w.y << 16); a.w = __uint_as_float(w.y & 0xffff0000u);
    b.x = __uint_as_float(w.z << 16); b.y = __uint_as_float(w.z & 0xffff0000u); b.z = __uint_as_float(w.w << 16); b.w = __uint_as_float(w.w & 0xffff0000u); }
DEV float softplusf_(float y) { return fmaxf(y, 0.f) + log1pf(__expf(-fabsf(y))); }

DEV void mod_phase(const Params& p, LAS unsigned char* lds) {
    LAS float* sc = (LAS float*)lds;
    LAS float* red = (LAS float*)(lds + 16384);
    const int tid = tid_fresh(), lane = tid & 63, wv = tid >> 6;
    const float* c = p.in[1];
    for (int i = tid; i < 4096; i += 512) sc[i] = siluf_(c[i]);
    __syncthreads();
    float* MOD = (float*)(p.ws + WS_MOD);
    for (int item = blockIdx.x; item < 4 * 48; item += gridDim.x) {
        const int lk = item / 48, nb = item % 48, n = nb * 64 + lane;
        const float* W = p.in[2] + (size_t)lk * 1024 * 3072;
        float a0 = 0.f, a1 = 0.f, a2 = 0.f, a3 = 0.f;
#pragma unroll 16
        for (int k = wv * 128; k < wv * 128 + 128; ++k) {
            const float w = W[(size_t)k * 3072 + n];
            a0 += sc[k] * w; a1 += sc[1024 + k] * w; a2 += sc[2048 + k] * w; a3 += sc[3072 + k] * w;
        }
        red[(wv * 4 + 0) * 64 + lane] = a0; red[(wv * 4 + 1) * 64 + lane] = a1; red[(wv * 4 + 2) * 64 + lane] = a2; red[(wv * 4 + 3) * 64 + lane] = a3;
        __syncthreads();
        if (tid < 256) {
            const int b = tid >> 6; float s = p.in[3][lk * 3072 + n];
            for (int w8 = 0; w8 < 8; ++w8) s += red[(w8 * 4 + b) * 64 + lane];
            MOD[(size_t)(lk * 4 + b) * 3072 + n] = s;
        }
        __syncthreads();
    }
}

template <bool ROUTER>
DEV void norm_phase(const Params& p, int lk, const float* xin, LAS unsigned char* lds) {
    const int tid = tid_fresh(), lane = tid & 63, wv = tid >> 6;
    const int gw = blockIdx.x * 8 + wv, ngw = gridDim.x * 8;
    bf16* H = (bf16*)(p.ws + WS_H);
    const float* MOD = (const float*)(p.ws + WS_MOD);
    const float* g = p.in[4] + (size_t)lk * 1024;
    LAS unsigned* wgc = (LAS unsigned*)lds;
    for (int r0 = gw * 8; r0 < T; r0 += ngw * 8) {
        const int b = r0 / SEQ;
        const float* mod = MOD + (size_t)(lk * 4 + b) * 3072;
        int s_ea = 0, s_eb = 0; float s_wa = 0.f, s_wb = 0.f;
        if (ROUTER) { if (tid < 8) wgc[tid] = 0u; __syncthreads(); }
        f32x4 gs[4], sh[4];
#pragma unroll
        for (int j = 0; j < 4; ++j) {
            const int d = 4 * lane + 256 * j;
            const f32x4 gg = *(const f32x4*)(g + d), scl = *(const f32x4*)(mod + 1024 + d);
            gs[j] = gg * (scl + 1.0f); sh[j] = *(const f32x4*)(mod + d);
        }
        for (int r = r0; r < r0 + 8; ++r) {
            const float* xr = xin + (size_t)r * D;
            f32x4 v[4]; float ss = 0.f;
#pragma unroll
            for (int j = 0; j < 4; ++j) { v[j] = *(const f32x4*)(xr + 4 * lane + 256 * j); ss += (v[j].x * v[j].x + v[j].y * v[j].y) + (v[j].z * v[j].z + v[j].w * v[j].w); }
            const float rstd = 1.0f / sqrtf(wave_sum(ss) * (1.0f / D) + RMS_EPS);
#pragma unroll
            for (int j = 0; j < 4; ++j) v[j] = v[j] * rstd * gs[j] + sh[j];
#pragma unroll
            for (int j = 0; j < 4; ++j) { u32x2 o; o.x = pk2(v[j].x, v[j].y); o.y = pk2(v[j].z, v[j].w); *(u32x2*)(H + (size_t)r * D + 4 * lane + 256 * j) = o; }
            if (ROUTER) {
                const float* R = p.in[34];
                float lg[8];
#pragma unroll
                for (int e = 0; e < 8; ++e) lg[e] = 0.f;
#pragma unroll
                for (int j = 0; j < 4; ++j)
#pragma unroll
                    for (int q = 0; q < 4; ++q) {
                        const int d = 4 * lane + 256 * j + q; const float hv = v[j][q];
                        const f32x4 w0 = *(const f32x4*)(R + (size_t)d * 8), w1 = *(const f32x4*)(R + (size_t)d * 8 + 4);
                        lg[0] += hv * w0.x; lg[1] += hv * w0.y; lg[2] += hv * w0.z; lg[3] += hv * w0.w;
                        lg[4] += hv * w1.x; lg[5] += hv * w1.y; lg[6] += hv * w1.z; lg[7] += hv * w1.w;
                    }
#pragma unroll
                for (int e = 0; e < 8; ++e) lg[e] = wave_sum(lg[e]);
                int ea = 0; float va = lg[0];
#pragma unroll
                for (int e = 1; e < 8; ++e) if (lg[e] > va) { va = lg[e]; ea = e; }
                int eb = -1; float vb = -3.0e38f;
#pragma unroll
                for (int e = 0; e < 8; ++e) if (e != ea && lg[e] > vb) { vb = lg[e]; eb = e; }
                const float wa = 1.0f / (1.0f + __expf(vb - va)), wb = 1.0f - wa;
                if (lane == r - r0) { s_ea = ea; s_eb = eb; s_wa = wa; s_wb = wb; }
            }
        }
        if (ROUTER) {
            unsigned pa = 0u, pb = 0u;
            if (lane < 8) { pa = atomicAdd((unsigned*)(wgc + s_ea), 1u); pb = atomicAdd((unsigned*)(wgc + s_eb), 1u); }
            __syncthreads();
            if (tid < 8) wgc[8 + tid] = atomicAdd((unsigned*)(p.ws + WS_CTL) + tid * 32, wgc[tid]);
            __syncthreads();
            if (lane < 8) {
                int* LT = (int*)(p.ws + WS_LTOK); float* LW = (float*)(p.ws + WS_LW);
                const int r = r0 + lane; const unsigned ga = wgc[8 + s_ea] + pa, gb = wgc[8 + s_eb] + pb;
                LT[s_ea * T + ga] = r * 2 + 0; LW[s_ea * T + ga] = s_wa;
                LT[s_eb * T + gb] = r * 2 + 1; LW[s_eb * T + gb] = s_wb;
            }
            __syncthreads();
        }
    }
}

template <int WIN>
DEV void pool_rows(const LAS bf16* sp, bf16* U, int m0, int tl0, int half, int ch) {
    float u[32 + WIN - 1];
#pragma unroll
    for (int k = 0; k < 32 + WIN - 1; ++k) u[k] = bf2f(sp[(half * 32 + 16 - WIN + k) * 256 + ch]);
    float s = 0.f;
#pragma unroll
    for (int k = 0; k < WIN - 1; ++k) s += u[k];
#pragma unroll
    for (int i = 0; i < 32; ++i) {
        s += u[i + WIN - 1];
        const int tl = tl0 + half * 32 + i; const float cnt = (float)((tl + 1) < WIN ? (tl + 1) : WIN);
        U[(size_t)(m0 + half * 32 + i) * D + ch] = (bf16)f2bf(s / cnt - u[i + WIN - 1]);
        s -= u[i];
    }
}
DEV void mixer_phase(const Params& p, int l, LAS unsigned char* lds) {
    const bf16* Zr = (const bf16*)(p.ws + WS_ZR); const bf16* Zp = (const bf16*)(p.ws + WS_ZP); const bf16* Zc = (const bf16*)(p.ws + WS_ZC);
    bf16* U = (bf16*)(p.ws + WS_U); float* VF = (float*)(p.ws + WS_VF); bf16* G = (bf16*)(p.ws + WS_G); float* BON = (float*)(p.ws + WS_BON);
    for (int blk = blockIdx.x; blk < T / 64; blk += gridDim.x) {
        int tid_ = threadIdx.x; asm volatile("" : "+v"(tid_));
        const int tid = tid_, lane = tid & 63, wv = __builtin_amdgcn_readfirstlane(tid >> 6);
        const int m0 = blk * 64, b = m0 / SEQ, tl0 = m0 % SEQ;
        {
            LAS bf16* sp = (LAS bf16*)lds;
            { u32x4 pv[5];
#pragma unroll
              for (int k = 0; k < 5; ++k) { const int ci = tid + k * 512, tt = ci >> 5, c8 = (ci & 31) * 8, tl = tl0 - 15 + tt;
                  pv[k] = (u32x4){0u, 0u, 0u, 0u}; if (ci < 79 * 32 && tl >= 0) pv[k] = *(const u32x4*)(Zp + (size_t)(b * SEQ + tl) * ZP_W + c8); }
#pragma unroll
              for (int k = 0; k < 5; ++k) { const int ci = tid + k * 512, tt = ci >> 5, c8 = (ci & 31) * 8; if (ci < 79 * 32) *(LAS u32x4*)(sp + tt * 256 + c8) = pv[k]; } }
            __syncthreads();
            const int ch = tid & 255, half = tid >> 8, gi = (wv & 3);
            switch (gi) { case 0: pool_rows<2>(sp, U, m0, tl0, half, ch); break; case 1: pool_rows<4>(sp, U, m0, tl0, half, ch); break;
                          case 2: pool_rows<8>(sp, U, m0, tl0, half, ch); break; default: pool_rows<16>(sp, U, m0, tl0, half, ch); break; }
            __syncthreads();
        }
        {
            LAS float* ug = (LAS float*)lds;
            LAS float* cw = (LAS float*)(lds + 94 * 1024);
            { u32x4 av[6], bv[6];
#pragma unroll
              for (int k = 0; k < 6; ++k) { const int idx = tid + k * 512, tt = idx >> 5, c8 = (idx & 31) * 8, tl = tl0 - 30 + tt;
                  av[k] = (u32x4){0u, 0u, 0u, 0u}; bv[k] = av[k];
                  if (idx < 94 * 32 && tl >= 0) { const bf16* zr = Zc + (size_t)(b * SEQ + tl) * ZC_W; av[k] = *(const u32x4*)(zr + c8); bv[k] = *(const u32x4*)(zr + 256 + c8); } }
              f32x4 wv4[4]; const float* CW = p.in[9] + (size_t)l * 31 * 256;
#pragma unroll
              for (int k = 0; k < 4; ++k) { const int idx = tid + k * 512; wv4[k] = idx < 31 * 64 ? *(const f32x4*)(CW + idx * 4) : (f32x4){0.f, 0.f, 0.f, 0.f}; }
#pragma unroll
              for (int k = 0; k < 6; ++k) { const int idx = tid + k * 512, tt = idx >> 5, c8 = (idx & 31) * 8;
                  if (idx < 94 * 32) { f32x4 a0, a1, b0, b1; unpack8(av[k], a0, a1); unpack8(bv[k], b0, b1);
#pragma unroll
                      for (int e = 0; e < 4; ++e) { a0[e] *= fsig_(b0[e]); a1[e] *= fsig_(b1[e]); }
                      *(LAS f32x4*)(ug + tt * 256 + c8) = a0; *(LAS f32x4*)(ug + tt * 256 + c8 + 4) = a1; } }
#pragma unroll
              for (int k = 0; k < 4; ++k) { const int idx = tid + k * 512; if (idx < 31 * 64) *(LAS f32x4*)(cw + idx * 4) = wv4[k]; } }
            __syncthreads();
            const int c4 = 4 * lane;
            const f32x4 cb = *(const f32x4*)(p.in[10] + l * 256 + c4), lg = *(const f32x4*)(p.in[11] + l * 256 + c4), lb = *(const f32x4*)(p.in[12] + l * 256 + c4);
            {
                f32x4 wk[31];
#pragma unroll
                for (int k = 0; k < 31; ++k) wk[k] = *(const LAS f32x4*)(cw + k * 256 + c4);
                f32x4 acc[8];
#pragma unroll
                for (int j = 0; j < 8; ++j) acc[j] = cb;
#pragma unroll
                for (int r = 0; r < 38; ++r) {
                    const f32x4 x = *(const LAS f32x4*)(ug + (wv * 8 + r) * 256 + c4);
#pragma unroll
                    for (int j = 0; j < 8; ++j) if (r - j >= 0 && r - j <= 30) acc[j] += x * wk[r - j];
                }
#pragma unroll
                for (int j = 0; j < 8; ++j) {
                    const int i = wv * 8 + j;
                    const float mean = wave_sum((acc[j].x + acc[j].y) + (acc[j].z + acc[j].w)) * (1.0f / 256.0f);
                    const f32x4 d = acc[j] - mean;
                    const float var = wave_sum((d.x * d.x + d.y * d.y) + (d.z * d.z + d.w * d.w)) * (1.0f / 256.0f);
                    const float rstd = 1.0f / sqrtf(var + LN_EPS);
                    const f32x4 un = d * rstd * lg + lb;
                    u32x2 o; o.x = pk2(un.x * fsig_(un.x), un.y * fsig_(un.y)); o.y = pk2(un.z * fsig_(un.z), un.w * fsig_(un.w));
                    *(u32x2*)(U + (size_t)(m0 + i) * D + 256 + c4) = o;
                }
            }
            __syncthreads();
        }
        {
            typedef short bf16x8 __attribute__((ext_vector_type(8)));
            LAS bf16* LAb = (LAS bf16*)lds;
            const float* mu = p.in[14] + (size_t)l * 1664;
            { u32x4 zc[3], zq[3];
#pragma unroll
              for (int k = 0; k < 3; ++k) { const int idx = tid + k * 512, i = idx / 20, k8 = idx % 20, m = m0 + i, tl = tl0 + i;
                  zc[k] = (u32x4){0u, 0u, 0u, 0u}; zq[k] = zc[k];
                  if (idx < 64 * 20 && k8 < 18) { zc[k] = *(const u32x4*)(Zr + (size_t)m * ZR_W + 1536 + k8 * 8); if (tl > 0) zq[k] = *(const u32x4*)(Zr + (size_t)(m - 1) * ZR_W + 1536 + k8 * 8); } }
#pragma unroll
              for (int k = 0; k < 3; ++k) { const int idx = tid + k * 512, i = idx / 20, k8 = idx % 20;
                  if (idx < 64 * 20) { f32x4 c0, c1, q0, q1; unpack8(zc[k], c0, c1); unpack8(zq[k], q0, q1);
                      const float* mp = k8 < 16 ? mu + 1536 + k8 * 8 : p.in[27] + (k8 - 16) * 8;
                      f32x4 m0v = (f32x4){0.f, 0.f, 0.f, 0.f}, m1v = m0v; if (k8 < 18) { m0v = *(const f32x4*)mp; m1v = *(const f32x4*)(mp + 4); }
                      c0 = c0 + (q0 - c0) * m0v; c1 = c1 + (q1 - c1) * m1v;
                      if (k8 < 4) {
#pragma unroll
                          for (int e = 0; e < 4; ++e) { c0[e] = 1.0f - 2.0f * __builtin_amdgcn_rcpf(1.0f + __expf(2.0f * c0[e])); c1[e] = 1.0f - 2.0f * __builtin_amdgcn_rcpf(1.0f + __expf(2.0f * c1[e])); }
                      } else if (k8 >= 8 && k8 < 16) {
#pragma unroll
                          for (int e = 0; e < 4; ++e) { c0[e] = fsig_(c0[e]); c1[e] = fsig_(c1[e]); }
                      }
                      *(LAS u32x4*)(LAb + i * 168 + k8 * 8) = pack8b(c0, c1); } } }
            const int hh = wv, fr = lane & 15;
            __syncthreads();
            const f32x4 z4 = (f32x4){0.f, 0.f, 0.f, 0.f};
            bf16* SCh = (bf16*)(p.ws + WS_SC);
            LAS float* invL = (LAS float*)(lds + 24576) + wv * 64;
            LAS float* bonL = (LAS float*)(lds + 26624) + wv * 256;
            { int fq_ = lane >> 4; asm volatile("" : "+v"(fq_)); const int fq = fq_;
#pragma unroll 1
            for (int mt = 0; mt < 4; ++mt) {
                const int i = mt * 16 + fr, m = m0 + i, tl = tl0 + i;
                const bf16* zt = Zr + (size_t)m * ZR_W; const bf16* zp = zt - ZR_W; const bool hasp = tl > 0;
                float ss = 0.f;
#pragma unroll
                for (int q = 0; q < 2; ++q) {
                    const int c = hh * 64 + q * 32 + 8 * fq;
                    f32x4 kt0, kt1, kq0 = z4, kq1 = z4; unpack8(*(const u32x4*)(zt + 512 + c), kt0, kt1); if (hasp) unpack8(*(const u32x4*)(zp + 512 + c), kq0, kq1);
                    const f32x4 ka = (kt0 + (kq0 - kt0) * *(const f32x4*)(mu + 512 + c)) * *(const f32x4*)(p.in[20] + l * 512 + c);
                    const f32x4 kb = (kt1 + (kq1 - kt1) * *(const f32x4*)(mu + 512 + c + 4)) * *(const f32x4*)(p.in[20] + l * 512 + c + 4);
                    ss += ((ka.x * ka.x + ka.y * ka.y) + (ka.z * ka.z + ka.w * ka.w)) + ((kb.x * kb.x + kb.y * kb.y) + (kb.z * kb.z + kb.w * kb.w));
                }
                ss += __shfl_xor(ss, 16); ss += __shfl_xor(ss, 32);
                if (fq == 0) invL[i] = 1.0f / fmaxf(sqrtf(ss), 1e-12f);
            } }
            for (int q = 0; q < 2; ++q) {
                int fq_ = lane >> 4; asm volatile("" : "+v"(fq_));
                const int fq = fq_;
                bf16x8 Bw[2], Ba[2], Bg[2][2], Bv[2];
#pragma unroll
                for (int hf = 0; hf < 2; ++hf) {
                    const bf16* fp = (const bf16*)(p.ws + WS_LORA) + ((size_t)((((l * 8 + hh) * 2 + q) * 2 + hf) * 5) * 64 + lane) * 8;
                    Bw[hf] = *(const bf16x8*)(fp); Ba[hf] = *(const bf16x8*)(fp + 512); Bg[hf][0] = *(const bf16x8*)(fp + 1024); Bg[hf][1] = *(const bf16x8*)(fp + 1536); Bv[hf] = *(const bf16x8*)(fp + 2048);
                }
                const int c = hh * 64 + q * 32 + 8 * fq;
#pragma unroll 1
                for (int mt = 0; mt < 4; ++mt) {
                    const int i = mt * 16 + fr, m = m0 + i, tl = tl0 + i;
                    const float inv_i = invL[i];
                    bf16x8 Af[5];
#pragma unroll
                    for (int ks = 0; ks < 5; ++ks) Af[ks] = *(const LAS bf16x8*)(LAb + i * 168 + 32 * ks + 8 * fq);
                    const bf16* zt = Zr + (size_t)m * ZR_W; const bf16* zp = zt - ZR_W; const bool hasp = tl > 0;
                    bf16* rec = SCh + ((size_t)(b * NH + hh) * SEQ + tl) * SCH + fq * 96;
                    f32x4 rt[2], kt[2], vt[2], rq[2] = {z4, z4}, kq[2] = {z4, z4}, vq[2] = {z4, z4};
                    unpack8(*(const u32x4*)(zt + c), rt[0], rt[1]); unpack8(*(const u32x4*)(zt + 512 + c), kt[0], kt[1]); unpack8(*(const u32x4*)(zt + 1024 + c), vt[0], vt[1]);
                    if (hasp) { unpack8(*(const u32x4*)(zp + c), rq[0], rq[1]); unpack8(*(const u32x4*)(zp + 512 + c), kq[0], kq[1]); unpack8(*(const u32x4*)(zp + 1024 + c), vq[0], vq[1]); }
                    f32x4 om[2], kka[2], kpv[2], r4[2], kkv[2], v4[2], gg[2];
                    float bon = 0.f;
#pragma unroll
                    for (int hf = 0; hf < 2; ++hf) {
                        const int cc = c + 4 * hf;
                        const f32x4 aw_ = __builtin_amdgcn_mfma_f32_16x16x32_bf16(Bw[hf], Af[0], z4, 0, 0, 0);
                        const f32x4 aa_ = __builtin_amdgcn_mfma_f32_16x16x32_bf16(Ba[hf], Af[1], z4, 0, 0, 0);
                        gg[hf] = __builtin_amdgcn_mfma_f32_16x16x32_bf16(Bg[hf][1], Af[3], __builtin_amdgcn_mfma_f32_16x16x32_bf16(Bg[hf][0], Af[2], z4, 0, 0, 0), 0, 0, 0);
                        r4[hf] = rt[hf] + (rq[hf] - rt[hf]) * *(const f32x4*)(mu + cc);
                        const f32x4 k4 = kt[hf] + (kq[hf] - kt[hf]) * *(const f32x4*)(mu + 512 + cc);
                        v4[hf] = vt[hf] + (vq[hf] - vt[hf]) * *(const f32x4*)(mu + 1024 + cc);
                        const f32x4 wl = aw_ + *(const f32x4*)(p.in[15] + l * 512 + cc), al = aa_ + *(const f32x4*)(p.in[17] + l * 512 + cc);
                        f32x4 a4;
#pragma unroll
                        for (int e = 0; e < 4; ++e) {
                            const float y = -wl[e];
                            const float sp = fmaxf(y, 0.f) + __logf(1.0f + __expf(-fabsf(y)));
                            om[hf][e] = 1.0f - __expf(-__expf(-sp - 0.5f)); a4[e] = fsig_(al[e]);
                        }
                        kkv[hf] = k4 * *(const f32x4*)(p.in[20] + l * 512 + cc) * inv_i;
                        kpv[hf] = k4 * ((a4 - 1.0f) * *(const f32x4*)(p.in[21] + l * 512 + cc) + 1.0f); kka[hf] = kkv[hf] * a4;
                        const f32x4 rk = r4[hf] * kpv[hf] * *(const f32x4*)(p.in[22] + l * 512 + cc);
                        bon += (rk.x + rk.y) + (rk.z + rk.w);
                        if (l) {
                            const f32x4 vl = __builtin_amdgcn_mfma_f32_16x16x32_bf16(Bv[hf], Af[4], z4, 0, 0, 0) + *(const f32x4*)(p.in[28] + cc), vf = *(const f32x4*)(VF + (size_t)m * RW + cc);
#pragma unroll
                            for (int e = 0; e < 4; ++e) v4[hf][e] = v4[hf][e] + (vf[e] - v4[hf][e]) * fsig_(vl[e]);
                        } else *(f32x4*)(VF + (size_t)m * RW + cc) = v4[hf];
                    }
                    if (q == 0) bonL[mt * 64 + lane] = bon; else bon += bonL[mt * 64 + lane];
                    if (q == 1) { bon += __shfl_xor(bon, 16); bon += __shfl_xor(bon, 32); if (fq == 0) BON[(size_t)m * NH + hh] = bon; }
                    *(u32x4*)(rec + q * 40) = packh8(om[0], om[1]); *(u32x4*)(rec + q * 40 + 8) = packh8(kka[0], kka[1]); *(u32x4*)(rec + q * 40 + 16) = packh8(kpv[0], kpv[1]);
                    *(u32x4*)(rec + q * 40 + 24) = packh8(r4[0], r4[1]); *(u32x4*)(rec + q * 40 + 32) = packh8(kkv[0], kkv[1]);
                    *(u32x4*)(rec + 80 + q * 8) = packh8(v4[0], v4[1]);
                    u32x4 go; go.x = pk2(gg[0].x, gg[0].y); go.y = pk2(gg[0].z, gg[0].w); go.z = pk2(gg[1].x, gg[1].y); go.w = pk2(gg[1].z, gg[1].w);
                    *(u32x4*)(G + (size_t)m * RW + c) = go;
                }
            }
            __syncthreads();
        }
    }
}

struct RecRegs { u32x2 g2; unsigned g1; };
DEV void rec_load(RecRegs& r, const bf16* rec, int lane) { r.g2 = *(const u32x2*)(rec + lane * 4); r.g1 = *(const unsigned*)(rec + 256 + lane * 2); }
DEV void rec_put(const RecRegs& r, LAS unsigned char* slot, int lane) { *(LAS u32x2*)(slot + lane * 8) = r.g2; *(LAS unsigned*)(slot + 512 + lane * 4) = r.g1; }
DEV float h2f(unsigned short h) { return (float)__builtin_bit_cast(_Float16, h); }
DEV void blk4h_full(float& s0, float& s1, float& s2, float& s3, float (&o)[4], float (&san)[4], float sa, float vv, unsigned d0, unsigned d1, unsigned a0, unsigned a1, unsigned p0, unsigned p1, unsigned r0, unsigned r1, unsigned k0, unsigned k1) {
    asm volatile(
        "v_fma_mix_f32 %0, -%14, %0, %0 op_sel:[0,0,0] op_sel_hi:[1,0,0]\n v_fma_mix_f32 %1, -%14, %1, %1 op_sel:[1,0,0] op_sel_hi:[1,0,0]\n"
        "v_fma_mix_f32 %2, -%15, %2, %2 op_sel:[0,0,0] op_sel_hi:[1,0,0]\n v_fma_mix_f32 %3, -%15, %3, %3 op_sel:[1,0,0] op_sel_hi:[1,0,0]\n"
        "v_fma_mix_f32 %0, %16, %12, %0 op_sel:[0,0,0] op_sel_hi:[1,0,0]\n v_fma_mix_f32 %1, %16, %12, %1 op_sel:[1,0,0] op_sel_hi:[1,0,0]\n"
        "v_fma_mix_f32 %2, %17, %12, %2 op_sel:[0,0,0] op_sel_hi:[1,0,0]\n v_fma_mix_f32 %3, %17, %12, %3 op_sel:[1,0,0] op_sel_hi:[1,0,0]\n"
        "v_fma_mix_f32 %0, %18, %13, %0 op_sel:[0,0,0] op_sel_hi:[1,0,0]\n v_fma_mix_f32 %1, %18, %13, %1 op_sel:[1,0,0] op_sel_hi:[1,0,0]\n"
        "v_fma_mix_f32 %2, %19, %13, %2 op_sel:[0,0,0] op_sel_hi:[1,0,0]\n v_fma_mix_f32 %3, %19, %13, %3 op_sel:[1,0,0] op_sel_hi:[1,0,0]\n"
        "v_fma_mix_f32 %4, %20, %0, %4 op_sel:[0,0,0] op_sel_hi:[1,0,0]\n v_fma_mix_f32 %5, %20, %1, %5 op_sel:[1,0,0] op_sel_hi:[1,0,0]\n"
        "v_fma_mix_f32 %6, %21, %2, %6 op_sel:[0,0,0] op_sel_hi:[1,0,0]\n v_fma_mix_f32 %7, %21, %3, %7 op_sel:[1,0,0] op_sel_hi:[1,0,0]\n"
        "v_fma_mix_f32 %8, %22, %0, %8 op_sel:[0,0,0] op_sel_hi:[1,0,0]\n v_fma_mix_f32 %9, %22, %1, %9 op_sel:[1,0,0] op_sel_hi:[1,0,0]\n"
        "v_fma_mix_f32 %10, %23, %2, %10 op_sel:[0,0,0] op_sel_hi:[1,0,0]\n v_fma_mix_f32 %11, %23, %3, %11 op_sel:[1,0,0] op_sel_hi:[1,0,0]\n"
        : "+v"(s0), "+v"(s1), "+v"(s2), "+v"(s3), "+v"(o[0]), "+v"(o[1]), "+v"(o[2]), "+v"(o[3]), "+v"(san[0]), "+v"(san[1]), "+v"(san[2]), "+v"(san[3])
        : "v"(sa), "v"(vv), "v"(d0), "v"(d1), "v"(a0), "v"(a1), "v"(p0), "v"(p1), "v"(r0), "v"(r1), "v"(k0), "v"(k1));
}
DEV void blk4h_two(float& s0, float& s1, float& s2, float& s3, float& q0, float& q1, float& q2, float& q3, float (&sanl)[4], float (&sanp)[4], float sal, float sap, float vv,
                   unsigned d0, unsigned d1, unsigned a0, unsigned a1, unsigned p0, unsigned p1, unsigned k0, unsigned k1) {
    asm volatile(
        "v_fma_mix_f32 %0, -%19, %0, %0 op_sel:[0,0,0] op_sel_hi:[1,0,0]\n v_fma_mix_f32 %1, -%19, %1, %1 op_sel:[1,0,0] op_sel_hi:[1,0,0]\n"
        "v_fma_mix_f32 %2, -%20, %2, %2 op_sel:[0,0,0] op_sel_hi:[1,0,0]\n v_fma_mix_f32 %3, -%20, %3, %3 op_sel:[1,0,0] op_sel_hi:[1,0,0]\n"
        "v_fma_mix_f32 %4, -%19, %4, %4 op_sel:[0,0,0] op_sel_hi:[1,0,0]\n v_fma_mix_f32 %5, -%19, %5, %5 op_sel:[1,0,0] op_sel_hi:[1,0,0]\n"
        "v_fma_mix_f32 %6, -%20, %6, %6 op_sel:[0,0,0] op_sel_hi:[1,0,0]\n v_fma_mix_f32 %7, -%20, %7, %7 op_sel:[1,0,0] op_sel_hi:[1,0,0]\n"
        "v_fma_mix_f32 %0, %21, %16, %0 op_sel:[0,0,0] op_sel_hi:[1,0,0]\n v_fma_mix_f32 %1, %21, %16, %1 op_sel:[1,0,0] op_sel_hi:[1,0,0]\n"
        "v_fma_mix_f32 %2, %22, %16, %2 op_sel:[0,0,0] op_sel_hi:[1,0,0]\n v_fma_mix_f32 %3, %22, %16, %3 op_sel:[1,0,0] op_sel_hi:[1,0,0]\n"
        "v_fma_mix_f32 %4, %21, %17, %4 op_sel:[0,0,0] op_sel_hi:[1,0,0]\n v_fma_mix_f32 %5, %21, %17, %5 op_sel:[1,0,0] op_sel_hi:[1,0,0]\n"
        "v_fma_mix_f32 %6, %22, %17, %6 op_sel:[0,0,0] op_sel_hi:[1,0,0]\n v_fma_mix_f32 %7, %22, %17, %7 op_sel:[1,0,0] op_sel_hi:[1,0,0]\n"
        "v_fma_mix_f32 %0, %23, %18, %0 op_sel:[0,0,0] op_sel_hi:[1,0,0]\n v_fma_mix_f32 %1, %23, %18, %1 op_sel:[1,0,0] op_sel_hi:[1,0,0]\n"
        "v_fma_mix_f32 %2, %24, %18, %2 op_sel:[0,0,0] op_sel_hi:[1,0,0]\n v_fma_mix_f32 %3, %24, %18, %3 op_sel:[1,0,0] op_sel_hi:[1,0,0]\n"
        "v_fma_mix_f32 %8, %25, %0, %8 op_sel:[0,0,0] op_sel_hi:[1,0,0]\n v_fma_mix_f32 %9, %25, %1, %9 op_sel:[1,0,0] op_sel_hi:[1,0,0]\n"
        "v_fma_mix_f32 %10, %26, %2, %10 op_sel:[0,0,0] op_sel_hi:[1,0,0]\n v_fma_mix_f32 %11, %26, %3, %11 op_sel:[1,0,0] op_sel_hi:[1,0,0]\n"
        "v_fma_mix_f32 %12, %25, %4, %12 op_sel:[0,0,0] op_sel_hi:[1,0,0]\n v_fma_mix_f32 %13, %25, %5, %13 op_sel:[1,0,0] op_sel_hi:[1,0,0]\n"
        "v_fma_mix_f32 %14, %26, %6, %14 op_sel:[0,0,0] op_sel_hi:[1,0,0]\n v_fma_mix_f32 %15, %26, %7, %15 op_sel:[1,0,0] op_sel_hi:[1,0,0]\n"
        : "+v"(s0), "+v"(s1), "+v"(s2), "+v"(s3), "+v"(q0), "+v"(q1), "+v"(q2), "+v"(q3), "+v"(sanl[0]), "+v"(sanl[1]), "+v"(sanl[2]), "+v"(sanl[3]), "+v"(sanp[0]), "+v"(sanp[1]), "+v"(sanp[2]), "+v"(sanp[3])
        : "v"(sal), "v"(sap), "v"(vv), "v"(d0), "v"(d1), "v"(a0), "v"(a1), "v"(p0), "v"(p1), "v"(k0), "v"(k1));
}
#define BLK_OFF(b8) (((b8) >> 1) * 192 + ((b8) & 1) * 80)
#define BLK_J0(b8) (((b8) & 1) * 32 + ((b8) >> 1) * 8)

DEV void scan_pass1(const Params& p, LAS unsigned char* lds) {
    const int tid = tid_fresh(), lane = tid & 63, wv = __builtin_amdgcn_readfirstlane(tid >> 6);
    const bf16* SC = (const bf16*)(p.ws + WS_SC); float* LS = (float*)(p.ws + WS_LS); float* PM = (float*)(p.ws + WS_PM);
    LAS unsigned char* ring = lds + wv * 1536;
    const int lq = lane >> 5, lfq = (lane >> 3) & 3, le = lane & 7;
    const int voff = lfq * 192 + 160 + lq * 16 + le * 2, koff = lfq * 192 + lq * 80 + 64 + le * 2;
    for (int u = blockIdx.x * 8 + wv; u < 32 * NCH; u += gridDim.x * 8) {
        const int c = u % NCH;
        const bf16* rec = SC + (size_t)u * CH * SCH;
        float S[64], Q[64];
        int ln = lane; asm volatile("" : "+v"(ln));
#pragma unroll
        for (int j = 0; j < 64; ++j) { S[j] = 0.f; Q[j] = (j == ln) ? 1.f : 0.f; }
        RecRegs r1, r2, r3;
        { RecRegs r0; rec_load(r0, rec, lane); rec_put(r0, ring, lane); }
        rec_load(r1, rec + SCH, lane); rec_load(r2, rec + 2 * SCH, lane);
        float sal = 0.f, sap = -h2f(*(const LAS unsigned short*)(ring + koff));
        for (int t = 0; t < CH; t += 2) {
#pragma unroll
            for (int h = 0; h < 2; ++h) {
                LAS unsigned char* cur = ring + h * 768; LAS unsigned char* nxt = ring + (h ^ 1) * 768;
                rec_load(r3, rec + 3 * SCH, lane);
                rec_put(r1, nxt, lane); r1 = r2; r2 = r3;
                const float vv = h2f(*(const LAS unsigned short*)(cur + voff));
                float sanl[4] = {0.f, 0.f, 0.f, 0.f}, sanp[4] = {0.f, 0.f, 0.f, 0.f};
#define P1_LD(X, B8) do { X##0 = *(const LAS u32x4*)(cur + BLK_OFF(B8)); X##1 = *(const LAS u32x4*)(cur + BLK_OFF(B8) + 16); X##2 = *(const LAS u32x4*)(cur + BLK_OFF(B8) + 32); X##3 = *(const LAS u32x4*)(nxt + BLK_OFF(B8) + 64); } while (0)
#define P1_CB(J0, H, D, A, P, K) blk4h_two(S[(J0)], S[(J0) + 1], S[(J0) + 2], S[(J0) + 3], Q[(J0)], Q[(J0) + 1], Q[(J0) + 2], Q[(J0) + 3], sanl, sanp, sal, sap, vv, D[2 * (H)], D[2 * (H) + 1], A[2 * (H)], A[2 * (H) + 1], P[2 * (H)], P[2 * (H) + 1], K[2 * (H)], K[2 * (H) + 1])
#define P1_BLK(B8, X, Y) do { if ((B8) < 7) P1_LD(Y, (B8) + 1); __builtin_amdgcn_sched_barrier(0); P1_CB(BLK_J0(B8), 0, X##0, X##1, X##2, X##3); P1_CB(BLK_J0(B8) + 4, 1, X##0, X##1, X##2, X##3); __builtin_amdgcn_sched_barrier(0); } while (0)
                u32x4 oa0, oa1, oa2, oa3, ob0, ob1, ob2, ob3;
                P1_LD(oa, 0);
                P1_BLK(0, oa, ob); P1_BLK(1, ob, oa); P1_BLK(2, oa, ob); P1_BLK(3, ob, oa); P1_BLK(4, oa, ob); P1_BLK(5, ob, oa); P1_BLK(6, oa, ob); P1_BLK(7, ob, oa);
#undef P1_LD
#undef P1_CB
#undef P1_BLK
                sal = -((sanl[0] + sanl[1]) + (sanl[2] + sanl[3])); sap = -((sanp[0] + sanp[1]) + (sanp[2] + sanp[3])); rec += SCH;
            }
        }
        asm volatile("" :: "v"(r1.g2), "v"(r1.g1), "v"(r2.g2), "v"(r2.g1));
        float* o = LS + ((size_t)u * 64 + lane) * 64;
#pragma unroll
        for (int j = 0; j < 64; j += 4) *(f32x4*)(o + j) = (f32x4){S[j], S[j + 1], S[j + 2], S[j + 3]};
        if (c > 0) {
            o = PM + ((size_t)u * 64 + lane) * 64;
#pragma unroll
            for (int j = 0; j < 64; j += 4) *(f32x4*)(o + j) = (f32x4){Q[j], Q[j + 1], Q[j + 2], Q[j + 3]};
        }
    }
}
DEV float rdl(float v, int j) { return __builtin_bit_cast(float, __builtin_amdgcn_readlane(__builtin_bit_cast(int, v), j)); }
DEV void scan_carry(const Params& p, LAS unsigned char* lds) {
    const int tid = tid_fresh(), lane = tid & 63, wv = __builtin_amdgcn_readfirstlane(tid >> 6);
    float* LS = (float*)(p.ws + WS_LS); const float* PM = (const float*)(p.ws + WS_PM);
    LAS float* Pb = (LAS float*)lds;
    for (int u = blockIdx.x; u < 32 * 8; u += gridDim.x) {
        const int bh = u >> 3, i = (u & 7) * 8 + wv;
        float* Lp = LS + (size_t)bh * NCH * 4096 + i * 64 + lane;
        const float* Pp = PM + (size_t)bh * NCH * 4096 + (wv * 8) * 64 + lane;
        float s = 0.f, pr[8];
#pragma unroll
        for (int j = 0; j < 8; ++j) pr[j] = Pp[(size_t)1 * 4096 + j * 64];
        float Lc = Lp[0];
        __builtin_amdgcn_s_barrier();
        for (int c = 0; c < NCH; ++c) {
            LAS float* cur = Pb + (c & 1) * 4096; LAS float* nxt = Pb + ((c + 1) & 1) * 4096;
            if (c + 1 < NCH) {
#pragma unroll
                for (int j = 0; j < 8; ++j) nxt[(wv * 8 + j) * 64 + lane] = pr[j];
            }
            const int c2 = c + 2 < NCH ? c + 2 : NCH - 1, c1 = c + 1 < NCH ? c + 1 : NCH - 1;
#pragma unroll
            for (int j = 0; j < 8; ++j) pr[j] = Pp[(size_t)c2 * 4096 + j * 64];
            const float Ln = Lp[(size_t)c1 * 4096];
            float acc = Lc;
            if (c > 0) {
                float a0 = 0.f, a1 = 0.f, a2 = 0.f, a3 = 0.f;
#pragma unroll
                for (int j = 0; j < 64; j += 4) { a0 += rdl(s, j) * cur[j * 64 + lane]; a1 += rdl(s, j + 1) * cur[(j + 1) * 64 + lane]; a2 += rdl(s, j + 2) * cur[(j + 2) * 64 + lane]; a3 += rdl(s, j + 3) * cur[(j + 3) * 64 + lane]; }
                acc += (a0 + a1) + (a2 + a3);
            }
            Lp[(size_t)c * 4096] = s; s = acc; Lc = Ln;
            asm volatile("s_waitcnt lgkmcnt(0)" ::: "memory"); __builtin_amdgcn_s_barrier(); asm volatile("" ::: "memory");
        }
    }
}
DEV void scan_pass2(const Params& p, int l, LAS unsigned char* lds) {
    const int tid = tid_fresh(), lane = tid & 63, wv = __builtin_amdgcn_readfirstlane(tid >> 6);
    const bf16* SC = (const bf16*)(p.ws + WS_SC); const float* LS = (const float*)(p.ws + WS_LS);
    const bf16* G = (const bf16*)(p.ws + WS_G); const float* BON = (const float*)(p.ws + WS_BON); bf16* U = (bf16*)(p.ws + WS_U);
    LAS unsigned char* ring = lds + wv * 1536;
    const int voff = ((lane >> 3) & 3) * 192 + 160 + (lane >> 5) * 16 + (lane & 7) * 2;
    for (int u = blockIdx.x * 8 + wv; u < 32 * NCH; u += gridDim.x * 8) {
        const int bh = u / NCH, c = u % NCH, b = bh >> 3, hh = bh & 7;
        const bf16* rec = SC + (size_t)u * CH * SCH;
        const float lg = p.in[23][l * 512 + hh * 64 + lane], lb = p.in[24][l * 512 + hh * 64 + lane];
        float S[64];
        const float* s0 = LS + ((size_t)u * 64 + lane) * 64;
#pragma unroll
        for (int j = 0; j < 64; j += 4) { const f32x4 v = *(const f32x4*)(s0 + j); S[j] = v.x; S[j + 1] = v.y; S[j + 2] = v.z; S[j + 3] = v.w; }
        RecRegs r1, r2, r3;
        { RecRegs r0; rec_load(r0, rec, lane); rec_put(r0, ring, lane); }
        rec_load(r1, rec + SCH, lane); rec_load(r2, rec + 2 * SCH, lane);
        float sa = 0.f;
        if (c > 0) {
#pragma unroll
            for (int b8 = 0; b8 < 8; ++b8) { const u32x4 kv = *(const LAS u32x4*)(ring + BLK_OFF(b8) + 64);
#pragma unroll
                for (int e = 0; e < 4; ++e) { sa -= S[BLK_J0(b8) + 2 * e] * h2f((unsigned short)(kv[e] & 0xffffu)); sa -= S[BLK_J0(b8) + 2 * e + 1] * h2f((unsigned short)(kv[e] >> 16)); } }
        }
        const int m0 = b * SEQ + c * CH;
        for (int t = 0; t < CH; t += 2) {
#pragma unroll
            for (int h = 0; h < 2; ++h) {
                LAS unsigned char* cur = ring + h * 768; LAS unsigned char* nxt = ring + (h ^ 1) * 768;
                rec_load(r3, rec + 3 * SCH, lane);
                rec_put(r1, nxt, lane); r1 = r2; r2 = r3;
                const float vv = h2f(*(const LAS unsigned short*)(cur + voff));
                const int m = m0 + t + h;
                const float bon = BON[(size_t)m * NH + hh], gt = bf2f(G[(size_t)m * RW + hh * 64 + lane]);
                float o4[4] = {0.f, 0.f, 0.f, 0.f}, san4[4] = {0.f, 0.f, 0.f, 0.f};
#define P2_LD(X, B8) do { X##0 = *(const LAS u32x4*)(cur + BLK_OFF(B8)); X##1 = *(const LAS u32x4*)(cur + BLK_OFF(B8) + 16); X##2 = *(const LAS u32x4*)(cur + BLK_OFF(B8) + 32); X##3 = *(const LAS u32x4*)(cur + BLK_OFF(B8) + 48); X##4 = *(const LAS u32x4*)(nxt + BLK_OFF(B8) + 64); } while (0)
#define P2_CB(J0, H, D, A, P, R, K) blk4h_full(S[(J0)], S[(J0) + 1], S[(J0) + 2], S[(J0) + 3], o4, san4, sa, vv, D[2 * (H)], D[2 * (H) + 1], A[2 * (H)], A[2 * (H) + 1], P[2 * (H)], P[2 * (H) + 1], R[2 * (H)], R[2 * (H) + 1], K[2 * (H)], K[2 * (H) + 1])
#define P2_BLK(B8, X, Y) do { if ((B8) < 7) P2_LD(Y, (B8) + 1); __builtin_amdgcn_sched_barrier(0); P2_CB(BLK_J0(B8), 0, X##0, X##1, X##2, X##3, X##4); P2_CB(BLK_J0(B8) + 4, 1, X##0, X##1, X##2, X##3, X##4); __builtin_amdgcn_sched_barrier(0); } while (0)
                u32x4 oa0, oa1, oa2, oa3, oa4, ob0, ob1, ob2, ob3, ob4;
                P2_LD(oa, 0);
                P2_BLK(0, oa, ob); P2_BLK(1, ob, oa); P2_BLK(2, oa, ob); P2_BLK(3, ob, oa); P2_BLK(4, oa, ob); P2_BLK(5, ob, oa); P2_BLK(6, oa, ob); P2_BLK(7, ob, oa);
#undef P2_LD
#undef P2_CB
#undef P2_BLK
                sa = -((san4[0] + san4[1]) + (san4[2] + san4[3])); rec += SCH;
                const float o = (o4[0] + o4[1]) + (o4[2] + o4[3]);
                const float mean = wave_sum(o) * (1.0f / 64.0f), dlt = o - mean;
                const float var = wave_sum(dlt * dlt) * (1.0f / 64.0f);
                const float on = dlt * (1.0f / sqrtf(var + GN_EPS)) * lg + lb;
                U[(size_t)m * D + 512 + hh * 64 + lane] = (bf16)f2bf((on + bon * vv) * gt);
            }
        }
        asm volatile("" :: "v"(r1.g2), "v"(r1.g1), "v"(r2.g2), "v"(r2.g1));
    }
}

template <bool MOE>
DEV void final_phase(const Params& p) {
    const int tid = tid_fresh(), lane = tid & 63, wv = tid >> 6;
    const float* g = p.in[38]; float* X = p.out;
    const bf16* Y = (const bf16*)(p.ws + WS_Y);
    const float* MOD = (const float*)(p.ws + WS_MOD);
    for (int r = blockIdx.x * 8 + wv; r < T; r += gridDim.x * 8) {
        const int b = r / SEQ;
        const float* gate = MOD + (size_t)(3 * 4 + b) * 3072 + 2048;
        f32x4 v[4]; float ss = 0.f;
#pragma unroll
        for (int j = 0; j < 4; ++j) {
            const int d = 4 * lane + 256 * j;
            v[j] = *(const f32x4*)(X + (size_t)r * D + d);
            if (MOE) {
                const u32x2 y0 = *(const u32x2*)(Y + (size_t)r * D + d), y1 = *(const u32x2*)(Y + (size_t)(T + r) * D + d);
                const f32x4 gt = *(const f32x4*)(gate + d);
                f32x4 ys;
                ys.x = __uint_as_float(y0.x << 16) + __uint_as_float(y1.x << 16); ys.y = __uint_as_float(y0.x & 0xffff0000u) + __uint_as_float(y1.x & 0xffff0000u);
                ys.z = __uint_as_float(y0.y << 16) + __uint_as_float(y1.y << 16); ys.w = __uint_as_float(y0.y & 0xffff0000u) + __uint_as_float(y1.y & 0xffff0000u);
                v[j] += gt * ys;
            }
            ss += (v[j].x * v[j].x + v[j].y * v[j].y) + (v[j].z * v[j].z + v[j].w * v[j].w);
        }
        const float rstd = 1.0f / sqrtf(wave_sum(ss) * (1.0f / D) + RMS_EPS);
#pragma unroll
        for (int j = 0; j < 4; ++j) { const int d = 4 * lane + 256 * j; *(f32x4*)(X + (size_t)r * D + d) = v[j] * rstd * *(const f32x4*)(g + d); }
    }
}

namespace pg8 {
typedef short bf16x8 __attribute__((ext_vector_type(8)));
constexpr int BM = 256, BK = 64, HALF = 128, HTB = HALF * BK * 2  , STAGE_BYTES = 8 * HTB, NXCD = 8, WGM = 8;
DEV int lds_byte(int r, int c) { const int st = (r >> 4) * 2 + (c >> 5), rr = r & 15, cc = c & 31, ob = rr * 64 + cc * 2; return st * 1024 + (ob ^ (((ob >> 9) & 1) << 5)); }
DEV void stage_rc(int b, int& R, int& C) { const int st = b / 1024, sb = b % 1024, swz = sb ^ (((sb >> 9) & 1) << 5); R = (st >> 1) * 16 + swz / 64; C = (st & 1) * 32 + (swz % 64) / 2; }
DEV int perm32(int rho) { const int n = rho >> 4, i = rho & 15; return 8 * (i >> 2) + 4 * n + (i & 3); }
struct Unit { int pm, pn; };
struct StaticOrder {
    const char* A; const char* Bt; int lda, ldb; int nM, nN, nwg, G, c;
    DEV void init(const void* A_, int lda_, const void* Bt_, int ldb_, int nM_, int nN_, int G_, int c_) { A = (const char*)A_; Bt = (const char*)Bt_; lda = lda_; ldb = ldb_; nM = nM_; nN = nN_; nwg = nM * nN; G = G_; c = c_; }
    DEV bool next(int i, Unit& u) const {
        const long L = (long)i * G + c; if (L >= nwg) return false;
        int wgid = (int)L; { const int q = nwg / NXCD, r = nwg % NXCD, xcd = wgid % NXCD, off = wgid / NXCD; wgid = (xcd < r ? xcd * (q + 1) : r * (q + 1) + (xcd - r) * q) + off; }
        const int nig = WGM * nN, gid = wgid / nig, fm = gid * WGM, gsz = (nM - fm) < WGM ? (nM - fm) : WGM;
        u.pm = fm + ((wgid % nig) % gsz); u.pn = (wgid % nig) / gsz; return true;
    }
    DEV const char* a_ptr(const Unit& u) const { return A + (size_t)u.pm * BM * lda * 2; }
    DEV const char* b_ptr(const Unit& u) const { return Bt + (size_t)u.pn * BM * ldb * 2; }
};
template <class Epi, class Sched>
DEV void gemm_phase(LAS unsigned char* lds, const int K, const int lda, const int ldb, const Sched& S, const Epi& E) {
    const int tid = tid_fresh(), wid = __builtin_amdgcn_readfirstlane(tid >> 6), lane = tid & 63, wr = wid >> 2, wc = wid & 3, fr = lane & 15, fq = lane >> 4;
    const int nt = K / BK;
    unsigned voffA[2], voffB[2];
#pragma unroll
    for (int i = 0; i < 2; ++i) { int R, C; stage_rc(tid * 16 + i * 8192, R, C); const int Rb = (R & ~31) + perm32(R & 31);
        voffA[i] = (unsigned)(R * lda + C) * 2u; voffB[i] = (unsigned)(Rb * ldb + C) * 2u; }
    const size_t kstep = (size_t)(BK * 2);
    const size_t hstepA = (size_t)HALF * lda * 2, hstepB = (size_t)HALF * ldb * 2;
    const unsigned ldsw = (unsigned)wid * 1024u;
    const int aoff = lds_byte(wr * 64 + fr, fq * 8), boff = lds_byte(wc * 32 + fr, fq * 8);
#define PG8_SA(b, h) (((b) * 2 + (h)) * HTB)
#define PG8_SB(b, h) ((4 + (b) * 2 + (h)) * HTB)
#define PG8_STAGE(bufoff, gbase, voff) do { _Pragma("unroll") for (int _i = 0; _i < 2; ++_i) \
        __builtin_amdgcn_global_load_lds((const unsigned*)((const char*)(gbase) + (voff)[_i]), (LAS unsigned*)(lds + (bufoff) + ldsw + _i * 8192), 16, 0, 0); } while (0)
#define PG8_LDA(dst, b, h) do { _Pragma("unroll") for (int m = 0; m < 4; ++m) _Pragma("unroll") for (int k = 0; k < 2; ++k) dst[m][k] = *(const LAS bf16x8*)(lds + PG8_SA(b, h) + aoff + m * 2048 + k * 1024); } while (0)
#define PG8_LDB(dst, b, h) do { _Pragma("unroll") for (int n = 0; n < 2; ++n) _Pragma("unroll") for (int k = 0; k < 2; ++k) dst[n][k] = *(const LAS bf16x8*)(lds + PG8_SB(b, h) + boff + n * 2048 + k * 1024); } while (0)
#define PG8_MMA(ai, bj, At, Bt) do { __builtin_amdgcn_s_setprio(1); _Pragma("unroll") for (int m = 0; m < 4; ++m) _Pragma("unroll") for (int n = 0; n < 2; ++n) _Pragma("unroll") for (int k = 0; k < 2; ++k) \
        acc[ai][bj][m][n] = __builtin_amdgcn_mfma_f32_16x16x32_bf16(Bt[n][k], At[m][k], acc[ai][bj][m][n], 0, 0, 0); __builtin_amdgcn_s_setprio(0); } while (0)
#define PG8_WAIT_V(n) asm volatile("s_waitcnt vmcnt(" #n ")" ::: "memory")
#define PG8_WAIT_L(n) asm volatile("s_waitcnt lgkmcnt(" #n ")" ::: "memory")
#define PG8_BAR __builtin_amdgcn_s_barrier()
#define PG8_SCHED __builtin_amdgcn_sched_barrier(0)
    Unit cur, nxt; int ui = 0;
    if (!S.next(0, cur)) return;
    f32x4 acc[2][2][4][2];
#pragma unroll
    for (int a = 0; a < 2; ++a)
#pragma unroll
        for (int b = 0; b < 2; ++b)
#pragma unroll
            for (int m = 0; m < 4; ++m)
#pragma unroll
                for (int n = 0; n < 2; ++n) acc[a][b][m][n] = (f32x4){0.f, 0.f, 0.f, 0.f};
    bf16x8 At[4][2], B0[2][2], B1[2][2];
    const char* cA = S.a_ptr(cur); const char* cB = S.b_ptr(cur);
    PG8_STAGE(PG8_SB(0, 0), cB, voffB); PG8_STAGE(PG8_SB(0, 1), cB + hstepB, voffB); PG8_STAGE(PG8_SA(0, 0), cA, voffA); PG8_STAGE(PG8_SA(0, 1), cA + hstepA, voffA);
    if (wr == 1) PG8_BAR;
    PG8_WAIT_V(2); PG8_BAR;
    PG8_STAGE(PG8_SB(1, 0), cB + kstep, voffB); PG8_STAGE(PG8_SA(1, 0), cA + kstep, voffA); PG8_STAGE(PG8_SB(1, 1), cB + hstepB + kstep, voffB);
    PG8_WAIT_V(6); PG8_BAR;
    for (;;) {
        const bool has_next = S.next(ui + 1, nxt);
        const char* nA = has_next ? S.a_ptr(nxt) : cA; const char* nB = has_next ? S.b_ptr(nxt) : cB;
        for (int t = 0; t < nt; t += 2) {
            const bool last = (t == nt - 2);
            const char* a1 = cA + (size_t)(t + 1) * kstep;
            const char* a2 = last ? nA : cA + (size_t)(t + 2) * kstep; const char* b2 = last ? nB : cB + (size_t)(t + 2) * kstep;
            const char* a3 = a2 + kstep; const char* b3 = b2 + kstep;
            if constexpr (Epi::NMID > 0) { if (t == Epi::MID0 || t == Epi::MID1) E.mid(acc, cur, t == Epi::MID0 ? 0 : 1, wr, wc, fr, fq); }
            PG8_LDB(B0, 0, 0); PG8_LDB(B1, 0, 1); PG8_SCHED; PG8_LDA(At, 0, 0); PG8_STAGE(PG8_SA(1, 1), a1 + hstepA, voffA);
            PG8_WAIT_V(8); PG8_WAIT_L(0); PG8_BAR; PG8_MMA(0, 0, At, B0); PG8_MMA(0, 1, At, B1); PG8_BAR; PG8_SCHED;
            PG8_LDA(At, 0, 1); PG8_STAGE(PG8_SB(0, 0), b2, voffB); PG8_STAGE(PG8_SB(0, 1), b2 + hstepB, voffB); PG8_STAGE(PG8_SA(0, 0), a2, voffA);
            PG8_WAIT_V(8); PG8_WAIT_L(0); PG8_BAR; PG8_MMA(1, 0, At, B0); PG8_MMA(1, 1, At, B1); PG8_BAR; PG8_SCHED;
            PG8_LDB(B0, 1, 0); PG8_LDB(B1, 1, 1); PG8_SCHED; PG8_LDA(At, 1, 0); PG8_STAGE(PG8_SA(0, 1), a2 + hstepA, voffA);
            PG8_WAIT_V(8); PG8_WAIT_L(0); PG8_BAR; PG8_MMA(0, 0, At, B0); PG8_MMA(0, 1, At, B1); PG8_BAR; PG8_SCHED;
            PG8_LDA(At, 1, 1); PG8_STAGE(PG8_SB(1, 0), b3, voffB); PG8_STAGE(PG8_SB(1, 1), b3 + hstepB, voffB); PG8_STAGE(PG8_SA(1, 0), a3, voffA);
            PG8_WAIT_V(8); PG8_WAIT_L(0); PG8_BAR; PG8_MMA(1, 0, At, B0); PG8_MMA(1, 1, At, B1); PG8_BAR; PG8_SCHED;
        }
        if (wr == 0) PG8_BAR;
        E(acc, cur, wr, wc, fr, fq);
        if (!has_next) break;
#pragma unroll
        for (int a = 0; a < 2; ++a)
#pragma unroll
            for (int b = 0; b < 2; ++b)
#pragma unroll
                for (int m = 0; m < 4; ++m)
#pragma unroll
                    for (int n = 0; n < 2; ++n) acc[a][b][m][n] = (f32x4){0.f, 0.f, 0.f, 0.f};
        cur = nxt; cA = nA; cB = nB; ++ui;
        if (wr == 1) PG8_BAR;
    }
    PG8_WAIT_V(0);
    PG8_BAR;
#undef PG8_SA
#undef PG8_SB
#undef PG8_STAGE
#undef PG8_LDA
#undef PG8_LDB
#undef PG8_MMA
#undef PG8_WAIT_V
#undef PG8_WAIT_L
#undef PG8_BAR
#undef PG8_SCHED
}
}

typedef f32x4 Acc[2][2][4][2];
DEV unsigned cvt_pk_bf16(float lo, float hi) { unsigned r; asm volatile("v_cvt_pk_bf16_f32 %0, %1, %2" : "=v"(r) : "v"(lo), "v"(hi)); return r; }
DEV float fsig(float x) { return __builtin_amdgcn_rcpf(1.0f + __builtin_amdgcn_exp2f(-1.44269504f * x)); }
DEV u32x4 pack8(const f32x4& a, const f32x4& b) { u32x4 w; w.x = cvt_pk_bf16(a.x, a.y); w.y = cvt_pk_bf16(a.z, a.w); w.z = cvt_pk_bf16(b.x, b.y); w.w = cvt_pk_bf16(b.z, b.w); return w; }
struct EpiZ { unsigned char* ws;
    static constexpr int NMID = 0, MID0 = -1, MID1 = -1;
    DEV void operator()(const Acc& acc, const pg8::Unit& u, int wr, int wc, int fr, int fq) const {
        bf16* base; int ld, colt; bool sig = false;
        if (u.pn < 7) { base = (bf16*)(ws + WS_ZR); ld = ZR_W; colt = u.pn * 256; }
        else if (u.pn < 19) { base = (bf16*)(ws + WS_ZG); ld = ZG_W; colt = (u.pn - 7) * 256; sig = true; }
        else if (u.pn == 19) { base = (bf16*)(ws + WS_ZP); ld = ZP_W; colt = 0; }
        else { base = (bf16*)(ws + WS_ZC); ld = ZC_W; colt = (u.pn - 20) * 256; }
        const int row0 = u.pm * 256 + wr * 64 + fr, col0 = colt + wc * 32 + 8 * fq;
#pragma unroll
        for (int ai = 0; ai < 2; ++ai)
#pragma unroll
            for (int m = 0; m < 4; ++m) { bf16* rowp = base + (size_t)(row0 + ai * 128 + m * 16) * ld + col0;
#pragma unroll
                for (int bj = 0; bj < 2; ++bj) { f32x4 v0 = acc[ai][bj][m][0], v1 = acc[ai][bj][m][1];
                    if (sig) {
#pragma unroll
                        for (int e = 0; e < 4; ++e) { v0[e] = fsig(v0[e]); v1[e] = fsig(v1[e]); } }
                    *(u32x4*)(rowp + bj * 128) = pack8(v0, v1); } }
    } };
struct EpiMix { const bf16* Zg; bf16* O;
    static constexpr int NMID = 2, MID0 = 4, MID1 = 8;
    DEV void mid(Acc& acc, const pg8::Unit& u, int seg, int wr, int wc, int fr, int fq) const {
        const int row0 = u.pm * 256 + wr * 64 + fr, col0 = u.pn * 256 + wc * 32 + 8 * fq;
        const bf16* gp = Zg + (size_t)row0 * ZG_W + seg * 1024 + col0;
#pragma unroll
        for (int ai = 0; ai < 2; ++ai) {
#pragma unroll
            for (int m = 0; m < 4; ++m) {
                asm volatile("" : "+v"(gp));
#pragma unroll
                for (int bj = 0; bj < 2; ++bj) { f32x4 n0, n1, d0, d1; unpack8(*(const u32x4*)(gp + bj * 128), n0, n1); unpack8(*(const u32x4*)(gp + 1024 + bj * 128), d0, d1);
#pragma unroll
                    for (int e = 0; e < 4; ++e) { acc[ai][bj][m][0][e] *= n0[e] * __builtin_amdgcn_rcpf(d0[e]); acc[ai][bj][m][1][e] *= n1[e] * __builtin_amdgcn_rcpf(d1[e]); } }
                asm volatile("" : "+v"(acc[ai][0][m][0]), "+v"(acc[ai][0][m][1]), "+v"(acc[ai][1][m][0]), "+v"(acc[ai][1][m][1]) :: "memory");
                gp += 16 * ZG_W; }
            gp += (128 - 64) * ZG_W; }
    }
    DEV void operator()(const Acc& acc, const pg8::Unit& u, int wr, int wc, int fr, int fq) const {
        const int row0 = u.pm * 256 + wr * 64 + fr, col0 = u.pn * 256 + wc * 32 + 8 * fq;
#pragma unroll
        for (int ai = 0; ai < 2; ++ai)
#pragma unroll
            for (int m = 0; m < 4; ++m) { const size_t r = (size_t)(row0 + ai * 128 + m * 16);
#pragma unroll
                for (int bj = 0; bj < 2; ++bj) { f32x4 g0, g1; unpack8(*(const u32x4*)(Zg + r * ZG_W + 2048 + col0 + bj * 128), g0, g1);
                    *(u32x4*)(O + r * D + col0 + bj * 128) = pack8(acc[ai][bj][m][0] * g0, acc[ai][bj][m][1] * g1); }
                asm volatile("" ::: "memory"); }
    } };
struct EpiRes { const float* xin; float* xout; const float* gate;
    static constexpr int NMID = 0, MID0 = -1, MID1 = -1;
    DEV void operator()(const Acc& acc, const pg8::Unit& u, int wr, int wc, int fr, int fq) const {
        const int row0 = u.pm * 256 + wr * 64 + fr, col0 = u.pn * 256 + wc * 32 + 8 * fq;
        const float* g = gate + (size_t)(u.pm >> 4) * 3072 + col0;
        f32x4 gv[2][2];
#pragma unroll
        for (int bj = 0; bj < 2; ++bj)
#pragma unroll
            for (int n = 0; n < 2; ++n) gv[bj][n] = *(const f32x4*)(g + bj * 128 + 4 * n);
#pragma unroll
        for (int ai = 0; ai < 2; ++ai)
#pragma unroll
            for (int m = 0; m < 4; ++m) { const size_t off = (size_t)(row0 + ai * 128 + m * 16) * D + col0;
#pragma unroll
                for (int bj = 0; bj < 2; ++bj)
#pragma unroll
                    for (int n = 0; n < 2; ++n) { const f32x4 x = *(const f32x4*)(xin + off + bj * 128 + 4 * n); *(f32x4*)(xout + off + bj * 128 + 4 * n) = x + gv[bj][n] * acc[ai][bj][m][n]; }
                if (m & 1) asm volatile("" ::: "memory"); }
    } };
struct EpiSwi { bf16* O; int ldo, row_shift;
    static constexpr int NMID = 0, MID0 = -1, MID1 = -1;
    DEV void operator()(const Acc& acc, const pg8::Unit& u, int wr, int wc, int fr, int fq) const {
        const int row0 = u.pm * 256 - row_shift + wr * 64 + fr, col0 = u.pn * 128 + wc * 32 + 8 * fq;
#pragma unroll
        for (int ai = 0; ai < 2; ++ai)
#pragma unroll
            for (int m = 0; m < 4; ++m) { f32x4 h0, h1;
#pragma unroll
                for (int e = 0; e < 4; ++e) { const float a = acc[ai][0][m][0][e], b = acc[ai][0][m][1][e]; h0[e] = a * fsig(a) * acc[ai][1][m][0][e]; h1[e] = b * fsig(b) * acc[ai][1][m][1][e]; }
                *(u32x4*)(O + (size_t)(row0 + ai * 128 + m * 16) * ldo + col0) = pack8(h0, h1); }
    } };
struct EpiMoeDown { bf16* Y; const int* rowtk; const float* roww;
    static constexpr int NMID = 0, MID0 = -1, MID1 = -1;
    DEV void operator()(const Acc& acc, const pg8::Unit& u, int wr, int wc, int fr, int fq) const {
        const int row0 = u.pm * 256 + wr * 64 + fr, col0 = u.pn * 256 + wc * 32 + 8 * fq;
#pragma unroll
        for (int ai = 0; ai < 2; ++ai)
#pragma unroll
            for (int m = 0; m < 4; ++m) { const int r = row0 + ai * 128 + m * 16; const int tk = rowtk[r]; const float w = roww[r];
                if (tk >= 0) { bf16* yp = Y + ((size_t)(tk & 1) * T + (size_t)(tk >> 1)) * D + col0;
#pragma unroll
                    for (int bj = 0; bj < 2; ++bj) *(u32x4*)(yp + bj * 128) = pack8(acc[ai][bj][m][0] * w, acc[ai][bj][m][1] * w); } }
    } };
constexpr int MOE_NG = 3;
struct MoeOrder {
    const char* A; const char* Bt; int lda, ldb; size_t estride; int t0, ashift, nM, nN, nwg, G, c; int toff[9];
    DEV void init(const void* A_, int lda_, const void* Bt_, int ldb_, size_t estride_, const unsigned* cnt, int grp, int rel, int nN_, int G_, int c_) {
        A = (const char*)A_; Bt = (const char*)Bt_; lda = lda_; ldb = ldb_; estride = estride_; nN = nN_; G = G_; c = c_;
        int s = 0;
#pragma unroll
        for (int e = 0; e < 8; ++e) { toff[e] = s; s += ((int)cnt[e * 32] + 255) >> 8; }
        toff[8] = s;
        const int per = (s + MOE_NG - 1) / MOE_NG; t0 = grp * per; int t1 = t0 + per; if (t1 > s) t1 = s; if (t0 > s) t0 = s; nM = t1 - t0; nwg = nM * nN; ashift = rel ? t0 : 0;
    }
    DEV bool next(int i, pg8::Unit& u) const {
        const long L = (long)i * G + c; if (L >= nwg) return false;
        int wgid = (int)L; { const int q = nwg / 8, r = nwg % 8, xcd = wgid % 8, off = wgid / 8; wgid = (xcd < r ? xcd * (q + 1) : r * (q + 1) + (xcd - r) * q) + off; }
        const int nig = 8 * nN, gid = wgid / nig, fm = gid * 8, gsz = (nM - fm) < 8 ? (nM - fm) : 8;
        u.pm = t0 + fm + ((wgid % nig) % gsz); u.pn = (wgid % nig) / gsz; return true;
    }
    DEV int expert(int pm) const { int e = 0;
#pragma unroll
        for (int q = 1; q < 8; ++q) e += (pm >= toff[q]) ? 1 : 0;
        return e; }
    DEV const char* a_ptr(const pg8::Unit& u) const { return A + (size_t)(u.pm - ashift) * 256 * lda * 2; }
    DEV const char* b_ptr(const pg8::Unit& u) const { return Bt + (size_t)expert(u.pm) * estride + (size_t)u.pn * 256 * ldb * 2; }
};

template <class Src>
DEV void tr_item(const Src& src, bf16* WT, int ldt, int k0, int n0, LAS float* scr, int lane) {
    f32x4 v[8];
    const int kr = lane >> 3, c4 = (lane & 7) * 4;
#pragma unroll
    for (int i = 0; i < 8; ++i) v[i] = src.ld4(k0 + i * 8 + kr, n0 + c4);
#pragma unroll
    for (int i = 0; i < 8; ++i) { LAS float* s = scr + (i * 8 + kr) * 33 + c4; s[0] = v[i].x; s[1] = v[i].y; s[2] = v[i].z; s[3] = v[i].w; }
    asm volatile("s_waitcnt lgkmcnt(0)" ::: "memory");
    const int c = lane & 7;
#pragma unroll
    for (int j = 0; j < 4; ++j) { const int n = (lane >> 3) + 8 * j; const LAS float* s = scr + (8 * c) * 33 + n;
        u32x4 o; o.x = pk2(s[0 * 33], s[1 * 33]); o.y = pk2(s[2 * 33], s[3 * 33]); o.z = pk2(s[4 * 33], s[5 * 33]); o.w = pk2(s[6 * 33], s[7 * 33]);
        *(u32x4*)(WT + (size_t)(n0 + n) * ldt + k0 + 8 * c) = o; }
    asm volatile("s_waitcnt lgkmcnt(0)" ::: "memory");
}
struct SrcPlain { const float* W; int ld; DEV f32x4 ld4(int k, int n) const { return *(const f32x4*)(W + (size_t)k * ld + n); } };
struct SrcIn { const float* W; const float* Wv; int live;
    DEV f32x4 ld4(int k, int n) const {
        const f32x4 z = (f32x4){0.f, 0.f, 0.f, 0.f};
        if (n < 1664) return *(const f32x4*)(W + (size_t)k * IN_COLS + OFF_RWKV + n);
        if (n < 1680) return live ? *(const f32x4*)(Wv + (size_t)k * 16 + (n - 1664)) : z;
        if (n < 1792) return z;
        if (n < 4864) return *(const f32x4*)(W + (size_t)k * IN_COLS + OFF_GATE + (n - 1792));
        if (n < 5120) return *(const f32x4*)(W + (size_t)k * IN_COLS + (n - 4864));
        return *(const f32x4*)(W + (size_t)k * IN_COLS + OFF_CONV + (n - 5120));
    } };
struct SrcPair { const float* W1; const float* W3; int ld;
    DEV f32x4 ld4(int k, int n) const { const int pn = n >> 8, j = n & 255; const float* W = W1 + (ptrdiff_t)(j >> 7) * (W3 - W1); return *(const f32x4*)(W + (size_t)k * ld + pn * 128 + (j & 127)); } };
template <class Src>
DEV void tr_job(const Src& src, bf16* WT, int ldt, int K, int N, int koff, LAS float* scr, int gw, int ngw, int lane) {
    const int nkb = K / 64, nnb = N / 32;
    for (int it = gw; it < nkb * nnb; it += ngw) { const int kb = it / nnb, nb = it % nnb;
        tr_item(src, WT + koff, ldt, kb * 64, nb * 32, scr, lane); }
}
DEV void convert_phase(const Params& p, LAS unsigned char* lds) {
    const int tid = tid_fresh(), lane = tid & 63, wv = __builtin_amdgcn_readfirstlane(tid >> 6);
    LAS float* scr = (LAS float*)(lds + 32768 + wv * 8704);
    const int gw = blockIdx.x * 8 + wv, ngw = gridDim.x * 8;
    for (int l = 0; l < NL; ++l) {
        bf16* WinT = (bf16*)(p.ws + WS_WIN) + (size_t)l * ZN * D;
        tr_job(SrcIn{p.in[5] + (size_t)l * D * IN_COLS, p.in[26], l}, WinT, D, D, ZN, 0, scr, gw, ngw, lane);
        bf16* WmixT = (bf16*)(p.ws + WS_WMIX) + (size_t)l * D * D;
        tr_job(SrcPlain{p.in[13] + (size_t)l * 256 * D, D}, WmixT, D, 256, D, 256, scr, gw, ngw, lane);
        tr_job(SrcPlain{p.in[25] + (size_t)l * 512 * D, D}, WmixT, D, 512, D, 512, scr, gw, ngw, lane);
        tr_job(SrcPlain{p.in[30] + (size_t)l * D * D, D}, (bf16*)(p.ws + WS_WO) + (size_t)l * D * D, D, D, D, 0, scr, gw, ngw, lane);
        const float* pw = p.in[6] + (size_t)l * 4 * 64 * 64; const float* ps = p.in[7] + l * 256; const float* pp = p.in[8] + (size_t)l * 256 * D;
        for (int it = gw; it < 32 * 16; it += ngw) {
            const int k8 = it >> 4, n = (it & 15) * 64 + lane, g = k8 >> 3;
            float a[8];
#pragma unroll
            for (int e = 0; e < 8; ++e) a[e] = 0.f;
            for (int d = 0; d < 64; ++d) { const float pv = pp[(size_t)(g * 64 + d) * D + n] * ps[g * 64 + d];
#pragma unroll
                for (int e = 0; e < 8; ++e) a[e] += pw[(size_t)(k8 * 8 + e) * 64 + d] * pv; }
            u32x4 o; o.x = pk2(a[0], a[1]); o.y = pk2(a[2], a[3]); o.z = pk2(a[4], a[5]); o.w = pk2(a[6], a[7]);
            *(u32x4*)(WmixT + (size_t)n * D + k8 * 8) = o;
        }
    }
    for (int it = gw; it < 2 * 8 * 2 * 2 * 5; it += ngw) {
        const int kind = it % 5, hf = (it / 5) & 1, q = (it / 10) & 1, hh = (it / 20) & 7, l = it / 160, fr = lane & 15, fq = lane >> 4;
        const int ch = hh * 64 + q * 32 + (fr >> 2) * 8 + hf * 4 + (fr & 3);
        float t8[8];
#pragma unroll
        for (int e = 0; e < 8; ++e) { const int k = 8 * fq + e;
            t8[e] = kind == 0 ? p.in[16][(size_t)(l * 32 + k) * 512 + ch] : kind == 1 ? p.in[18][(size_t)(l * 32 + k) * 512 + ch] : kind == 2 ? p.in[19][(size_t)(l * 64 + k) * 512 + ch]
                  : kind == 3 ? p.in[19][(size_t)(l * 64 + 32 + k) * 512 + ch] : ((l && k < 16) ? p.in[29][(size_t)k * 512 + ch] : 0.f); }
        u32x4 o; o.x = pk2(t8[0], t8[1]); o.y = pk2(t8[2], t8[3]); o.z = pk2(t8[4], t8[5]); o.w = pk2(t8[6], t8[7]);
        *(u32x4*)((bf16*)(p.ws + WS_LORA) + ((size_t)it * 64 + lane) * 8) = o;
    }
    tr_job(SrcPair{p.in[31], p.in[32], DFF}, (bf16*)(p.ws + WS_W13), D, D, 2 * DFF, 0, scr, gw, ngw, lane);
    tr_job(SrcPlain{p.in[33], D}, (bf16*)(p.ws + WS_W2), DFF, DFF, D, 0, scr, gw, ngw, lane);
}
DEV void convert_moe_phase(const Params& p, LAS unsigned char* lds) {
    const int tid = tid_fresh(), lane = tid & 63, wv = __builtin_amdgcn_readfirstlane(tid >> 6);
    LAS float* scr = (LAS float*)(lds + 32768 + wv * 8704);
    const int gw = blockIdx.x * 8 + wv, ngw = gridDim.x * 8;
    for (int e = 0; e < NE; ++e) {
        tr_job(SrcPair{p.in[35] + (size_t)e * D * DFE, p.in[36] + (size_t)e * D * DFE, DFE}, (bf16*)(p.ws + WS_MW13) + (size_t)e * 2 * DFE * D, D, D, 2 * DFE, 0, scr, gw, ngw, lane);
        tr_job(SrcPlain{p.in[37] + (size_t)e * DFE * D, D}, (bf16*)(p.ws + WS_MW2) + (size_t)e * D * DFE, DFE, DFE, D, 0, scr, gw, ngw, lane);
    }
}
DEV void dispatch_phase(const Params& p) {
    const int tid = tid_fresh(), lane = tid & 63, wv = tid >> 6;
    const unsigned* cnt = (const unsigned*)(p.ws + WS_CTL);
    const int* LT = (const int*)(p.ws + WS_LTOK); const float* LW = (const float*)(p.ws + WS_LW);
    int* RT = (int*)(p.ws + WS_ROWTK); float* RW_ = (float*)(p.ws + WS_ROWW);
    const bf16* H = (const bf16*)(p.ws + WS_H); bf16* Hs = (bf16*)(p.ws + WS_HS);
    int off[9]; { int s = 0;
#pragma unroll
        for (int e = 0; e < 8; ++e) { off[e] = s; s += (((int)cnt[e * 32] + 255) >> 8) << 8; } off[8] = s; }
    for (int row = blockIdx.x * 8 + wv; row < off[8]; row += gridDim.x * 8) {
        int e = 0;
#pragma unroll
        for (int q = 1; q < 8; ++q) e += (row >= off[q]) ? 1 : 0;
        const int idx = row - off[e];
        int tk = -1; float w = 0.f;
        if (idx < (int)cnt[e * 32]) { tk = LT[e * T + idx]; w = LW[e * T + idx]; }
        u32x4 v0 = (u32x4){0u, 0u, 0u, 0u}, v1 = v0;
        if (tk >= 0) { const bf16* hr = H + (size_t)(tk >> 1) * D; v0 = *(const u32x4*)(hr + lane * 8); v1 = *(const u32x4*)(hr + 512 + lane * 8); }
        *(u32x4*)(Hs + (size_t)row * D + lane * 8) = v0; *(u32x4*)(Hs + (size_t)row * D + 512 + lane * 8) = v1;
        if (lane == 0) { RT[row] = tk; RW_[row] = w; }
    }
}

#define XB_TMO      128
#define XB_XCNT(j)  (256  + 64 * (j))
#define XB_XSUB(j)  (1280 + 64 * (j))
#define XB_XGEN(j)  (2304 + 64 * (j))
#define XB_TOP      3328
#define XB_TOPGEN   3392
#define XCD_BAR_WORDS 3456
#define XB_SPIN_CAP (1u << 18)
__device__ __forceinline__ unsigned xb_ld(unsigned* p)              { return __hip_atomic_load(p, __ATOMIC_RELAXED, __HIP_MEMORY_SCOPE_AGENT); }
__device__ __forceinline__ unsigned xb_add(unsigned* p, unsigned v) { return __hip_atomic_fetch_add(p, v, __ATOMIC_RELAXED, __HIP_MEMORY_SCOPE_AGENT); }
__device__ __forceinline__ unsigned xb_xcc_id() { return (unsigned)__builtin_amdgcn_s_getreg((3 << 11) | 20) & 0xFu; }
#define XB_SPIN(cond, bar) do { unsigned _sp = 0; while (cond) { __builtin_amdgcn_s_sleep(1); \
    if ((++_sp & 255u) == 0u) { if (xb_ld(&(bar)[XB_TMO])) break; if (_sp > XB_SPIN_CAP) { atomicAdd(&(bar)[XB_TMO], 1u); break; } } } } while (0)
struct XcdBarrier { unsigned* bar; unsigned x; volatile LAS unsigned* st; };
__device__ __forceinline__ XcdBarrier xcd_barrier_post(unsigned* bar, volatile LAS unsigned* st) {
    XcdBarrier b; b.bar = bar; b.x = xb_xcc_id(); b.st = st;
    if (threadIdx.x == 0) (void)xb_add(&bar[XB_XCNT(b.x)], 1u);
    return b;
}
__device__ __forceinline__ void xcd_barrier_complete(unsigned* bar, unsigned x, unsigned& nloc, unsigned& nx) {
    const unsigned G = gridDim.x * gridDim.y * gridDim.z;
    unsigned sum, cnt, mine, sp = 0u;
    for (;;) {
        sum = 0u; cnt = 0u; mine = 0u;
#pragma unroll
        for (unsigned j = 0; j < 16; ++j) { const unsigned c = xb_ld(&bar[XB_XCNT(j)]); sum += c; cnt += (c > 0u) ? 1u : 0u; mine = (j == x) ? c : mine; }
        if (sum == G) break;
        __builtin_amdgcn_s_sleep(1);
        if ((++sp & 255u) == 0u) { if (xb_ld(&bar[XB_TMO])) break; if (sp > XB_SPIN_CAP) { atomicAdd(&bar[XB_TMO], 1u); break; } }
    }
    nloc = mine > 0u ? mine : 1u; nx = cnt > 0u ? cnt : 1u;
}
__device__ __forceinline__ void xcd_barrier(const XcdBarrier& b) {
    asm volatile("s_waitcnt vmcnt(0)" ::: "memory");
    __syncthreads();
    if (threadIdx.x == 0) {
        unsigned* bar = b.bar;
        __builtin_amdgcn_s_waitcnt(0);
        unsigned nloc = b.st[0], nx = b.st[1];
        if (nloc == 0u) { xcd_barrier_complete(bar, b.x, nloc, nx); b.st[0] = nloc; b.st[1] = nx; }
        const unsigned old = xb_add(&bar[XB_XSUB(b.x)], 1u);
        const unsigned gen = old / nloc;
        if (old + 1u == (gen + 1u) * nloc) {
            __builtin_amdgcn_fence(__ATOMIC_RELEASE, "agent");
            asm volatile("s_waitcnt vmcnt(0)" ::: "memory");
            const unsigned og = xb_add(&bar[XB_TOP], 1u);
            const unsigned tg = og / nx;
            if (og + 1u == (tg + 1u) * nx) xb_add(&bar[XB_TOPGEN], 1u);
            else XB_SPIN(xb_ld(&bar[XB_TOPGEN]) == tg, bar);
            __builtin_amdgcn_fence(__ATOMIC_ACQUIRE, "agent");
            xb_add(&bar[XB_XGEN(b.x)], 1u);
            asm volatile("s_waitcnt vmcnt(0)" ::: "memory");
        } else {
            XB_SPIN(xb_ld(&bar[XB_XGEN(b.x)]) == gen, bar);
            __builtin_amdgcn_fence(__ATOMIC_ACQUIRE, "agent");
            asm volatile("s_waitcnt vmcnt(0)" ::: "memory");
        }
    }
    __syncthreads();
}

constexpr int LDS_BYTES = 147456;
constexpr int MISC_OFF = 131072 + 320;
constexpr int NPH = 29;
__global__ void __launch_bounds__(512, 2) fwd(const Params p, const int lo, const int hi) {
    extern __shared__ __attribute__((aligned(16))) unsigned char lds_[];
    LAS unsigned char* lds = (LAS unsigned char*)lds_;
    volatile LAS unsigned* MISC = (volatile LAS unsigned*)(lds + MISC_OFF);
    for (int u = threadIdx.x; u < (LDS_BYTES - 131072) / 4; u += 512) ((LAS unsigned*)(lds + 131072))[u] = 0u;
    __syncthreads();
    unsigned* ctl = (unsigned*)(p.ws + WS_CTL);
    XcdBarrier bar; bar.bar = ctl + 1024; bar.x = 0; bar.st = nullptr;
    if (hi - lo > 1) bar = xcd_barrier_post(ctl + 1024, MISC + 8);
#ifndef ENMASK
#define ENMASK 0xFFFFFFFFu
#endif
#define EN(x) (((ENMASK) >> (x)) & 1u)
#define IN(k) (lo <= (k) && (k) < hi)
#define SEAM(k) do { if (IN(k) && IN((k) + 1)) xcd_barrier(bar); } while (0)
#ifndef PROF_SEL
#define PROF_SEL -1
#endif
    volatile LAS unsigned long long* pfw = (volatile LAS unsigned long long*)(lds + MISC_OFF + 64);
#define TICK(ty) do { if (PROF_SEL >= 0 && blockIdx.x == 0 && threadIdx.x == 0) { const unsigned long long now_ = __builtin_amdgcn_s_memrealtime(); if ((ty) == PROF_SEL) pfw[1] = pfw[1] + (now_ - pfw[0]); pfw[0] = now_; } } while (0)
    TICK(-2);
    const int G = gridDim.x, bx = blockIdx.x;
    float* X = p.out;
    const float* MOD = (const float*)(p.ws + WS_MOD);
    bf16* H = (bf16*)(p.ws + WS_H); bf16* U = (bf16*)(p.ws + WS_U); bf16* MRG = (bf16*)(p.ws + WS_MRG);

    if (EN(0) && IN(0)) { mod_phase(p, lds); convert_phase(p, lds); }
    SEAM(0); TICK(0);
    for (int l = 0; l < NL; ++l) {
        const int pb = 1 + l * 11;
        const float* xin = l == 0 ? p.in[0] : X;
        if (EN(1) && IN(pb + 0)) norm_phase<false>(p, l * 2, xin, lds);
        SEAM(pb + 0); TICK(1);
        if (EN(2) && IN(pb + 1)) {
            pg8::StaticOrder S; S.init(H, D, (const bf16*)(p.ws + WS_WIN) + (size_t)l * ZN * D, D, T / 256, ZN / 256, G, bx);
            pg8::gemm_phase(lds, D, D, D, S, EpiZ{p.ws});
        }
        SEAM(pb + 1); TICK(2);
        if (EN(3) && IN(pb + 2)) mixer_phase(p, l, lds);
        SEAM(pb + 2); TICK(3);
        if (EN(4) && IN(pb + 3)) scan_pass1(p, lds);
        SEAM(pb + 3); TICK(4);
        if (EN(5) && IN(pb + 4)) scan_carry(p, lds);
        SEAM(pb + 4); TICK(5);
        if (EN(6) && IN(pb + 5)) scan_pass2(p, l, lds);
        SEAM(pb + 5); TICK(6);
        if (EN(7) && IN(pb + 6)) {
            pg8::StaticOrder S; S.init(U, D, (const bf16*)(p.ws + WS_WMIX) + (size_t)l * D * D, D, T / 256, D / 256, G, bx);
            pg8::gemm_phase(lds, D, D, D, S, EpiMix{(const bf16*)(p.ws + WS_ZG), MRG});
        }
        SEAM(pb + 6); TICK(7);
        if (EN(8) && IN(pb + 7)) {
            pg8::StaticOrder S; S.init(MRG, D, (const bf16*)(p.ws + WS_WO) + (size_t)l * D * D, D, T / 256, D / 256, G, bx);
            pg8::gemm_phase(lds, D, D, D, S, EpiRes{xin, X, MOD + (size_t)((l * 2) * 4) * 3072 + 2048});
        }
        SEAM(pb + 7); TICK(8);
        if (l == 0) {
            if (EN(9) && IN(9)) norm_phase<false>(p, 1, X, lds);
            SEAM(9); TICK(9);
            if (EN(10) && IN(10)) {
                pg8::StaticOrder S; S.init(H, D, (const bf16*)(p.ws + WS_W13), D, T / 256, 2 * DFF / 256, G, bx);
                pg8::gemm_phase(lds, D, D, D, S, EpiSwi{(bf16*)(p.ws + WS_HID), DFF, 0});
            }
            SEAM(10); TICK(10);
            if (EN(11) && IN(11)) {
                pg8::StaticOrder S; S.init((const bf16*)(p.ws + WS_HID), DFF, (const bf16*)(p.ws + WS_W2), DFF, T / 256, D / 256, G, bx);
                pg8::gemm_phase(lds, DFF, DFF, DFF, S, EpiRes{X, X, MOD + (size_t)(1 * 4) * 3072 + 2048});
            }
            SEAM(11); TICK(11);
        } else {
            if (EN(12) && IN(20)) { norm_phase<true>(p, 3, X, lds); TICK(17); convert_moe_phase(p, lds); }
            SEAM(20); TICK(12);
            if (EN(13) && IN(21)) dispatch_phase(p);
            SEAM(21); TICK(13);
            const unsigned* cnt = (const unsigned*)(p.ws + WS_CTL);
            for (int g = 0; g < MOE_NG; ++g) {
                if (EN(14) && IN(22 + 2 * g)) {
                    MoeOrder S; S.init(p.ws + WS_HS, D, p.ws + WS_MW13, D, (size_t)2 * DFE * D * 2, cnt, g, 0, 2 * DFE / 256, G, bx);
                    pg8::gemm_phase(lds, D, D, D, S, EpiSwi{(bf16*)(p.ws + WS_EH), DFE, S.t0 * 256});
                }
                SEAM(22 + 2 * g); TICK(14);
                if (EN(15) && IN(23 + 2 * g)) {
                    MoeOrder S; S.init(p.ws + WS_EH, DFE, p.ws + WS_MW2, DFE, (size_t)D * DFE * 2, cnt, g, 1, D / 256, G, bx);
                    pg8::gemm_phase(lds, DFE, DFE, DFE, S, EpiMoeDown{(bf16*)(p.ws + WS_Y), (const int*)(p.ws + WS_ROWTK), (const float*)(p.ws + WS_ROWW)});
                }
                SEAM(23 + 2 * g); TICK(15);
            }
            if (EN(16) && IN(22 + 2 * MOE_NG)) final_phase<true>(p);
            TICK(16);
            if (PROF_SEL >= 0 && blockIdx.x == 0 && threadIdx.x == 0) { const unsigned long long t0_ = __builtin_amdgcn_s_memrealtime(); const unsigned long long w_ = 4ull * pfw[1]; while (__builtin_amdgcn_s_memrealtime() - t0_ < w_) __builtin_amdgcn_s_sleep(8); }
        }
    }
#undef IN
#undef SEAM
}
__global__ void k_fill(float* o, int n, float c) { int i = blockIdx.x * blockDim.x + threadIdx.x; if (i < n) o[i] = c; }

#ifndef ONE_LAUNCH
#define ONE_LAUNCH 1
#endif
extern "C" void kernel_launch(void* const* d_in, const int* in_sizes, int n_in, void* d_out, int out_size, void* d_ws, size_t ws_size, hipStream_t stream) {
    if (n_in != 39 || out_size != T * D || ws_size < WS_NEED) { hipLaunchKernelGGL(k_fill, dim3((out_size + 255) / 256), dim3(256), 0, stream, (float*)d_out, out_size, 3.0f); return; }
    static int grid = 0;
    if (!grid) {
        int dev = 0, cus = 0;
        (void)hipGetDevice(&dev); (void)hipDeviceGetAttribute(&cus, hipDeviceAttributeMultiprocessorCount, dev);
        (void)hipFuncSetAttribute((const void*)fwd, hipFuncAttributeMaxDynamicSharedMemorySize, LDS_BYTES);
        int per_cu = 0; (void)hipOccupancyMaxActiveBlocksPerMultiprocessor(&per_cu, (const void*)fwd, 512, LDS_BYTES);
        (void)hipGetLastError();
        grid = cus > 0 ? cus : 256;
    }
    Params p{};
    for (int i = 0; i < 39; ++i) p.in[i] = (const float*)d_in[i];
    p.out = (float*)d_out; p.ws = (unsigned char*)d_ws;
    (void)hipMemsetAsync((unsigned char*)d_ws + WS_CTL, 0, 32768, stream);
#if ONE_LAUNCH
    hipLaunchKernelGGL(fwd, dim3(grid), dim3(512), LDS_BYTES, stream, p, 0, NPH);
#else
    for (int k = 0; k < NPH; ++k) hipLaunchKernelGGL(fwd, dim3(grid), dim3(512), LDS_BYTES, stream, p, k, k + 1);
#endif
}
```

```cpp
#include <hip/hip_runtime.h>
#include <cstdint>
#include <cstdio>

#define DEV __device__ __forceinline__
#define LAS __attribute__((address_space(3)))
typedef unsigned short bf16;
typedef float f32x4 __attribute__((ext_vector_type(4)));
typedef float f32x2 __attribute__((ext_vector_type(2)));
typedef unsigned u32x4 __attribute__((ext_vector_type(4)));
typedef unsigned u32x2 __attribute__((ext_vector_type(2)));

constexpr int D = 1024, NB = 4, SEQ = 4096, T = NB * SEQ, NL = 2;
constexpr int IN_COLS = 5504, OFF_CONV = 256, OFF_RWKV = 768, OFF_GATE = 2432;
constexpr int RW = 512, NH = 8, HD = 64;
constexpr int DFF = 2816, NE = 8, DFE = 3584;
constexpr int ZR_W = 1792, ZG_W = 3072, ZP_W = 256, ZC_W = 512, ZN = 5632;
constexpr int NCH = 64, CH = 64;
constexpr int SCH = 384;
constexpr float RMS_EPS = 1e-6f, LN_EPS = 1e-5f, GN_EPS = 64e-5f;

constexpr size_t MiB = 1u << 20;
constexpr size_t WS_CTL = 0;
constexpr size_t WS_MOD = 1 * MiB;
constexpr size_t WS_H = 51 * MiB;
constexpr size_t WS_U = 83 * MiB;
constexpr size_t WS_VF = 115 * MiB;
constexpr size_t WS_G = 147 * MiB;
constexpr size_t WS_BON = 163 * MiB;
constexpr size_t WS_ZG = 164 * MiB;
constexpr size_t WS_ZR = 260 * MiB;
constexpr size_t WS_ZP = 316 * MiB;
constexpr size_t WS_ZC = 324 * MiB;
constexpr size_t WS_LS = 260 * MiB;
constexpr size_t WS_PM = 292 * MiB;
constexpr size_t WS_SC = 340 * MiB;
constexpr size_t WS_LORA = 2 * MiB;
constexpr size_t WS_WIN = 4 * MiB;
constexpr size_t WS_WMIX = 26 * MiB;
constexpr size_t WS_WO = 30 * MiB;
constexpr size_t WS_W13 = 34 * MiB;
constexpr size_t WS_W2 = 45 * MiB;
constexpr size_t WS_MRG = 51 * MiB;
constexpr size_t WS_HID = 340 * MiB;
constexpr size_t WS_MW13 = 83 * MiB;
constexpr size_t WS_MW2 = 195 * MiB;
constexpr size_t WS_HS = 251 * MiB;
constexpr size_t WS_EH = 319 * MiB;
constexpr size_t WS_Y = 438 * MiB;
constexpr size_t WS_LTOK = 502 * MiB;
constexpr size_t WS_LW = 503 * MiB;
constexpr size_t WS_ROWTK = 504 * MiB;
constexpr size_t WS_ROWW = 505 * MiB;
constexpr size_t WS_NEED = 532 * MiB;

struct Params {
    const float* in[39];
    float* out; unsigned char* ws;
};

DEV int tid_fresh() { int t = threadIdx.x; asm volatile("" : "+v"(t)); return t; }
DEV float bf2f(bf16 b) { return __uint_as_float(((unsigned)b) << 16); }
DEV unsigned f2bf(float f) { unsigned u = __float_as_uint(f); return (u + 0x7fffu + ((u >> 16) & 1u)) >> 16; }
DEV unsigned pk2(float lo, float hi) { return f2bf(lo) | (f2bf(hi) << 16); }
typedef float f32x16 __attribute__((ext_vector_type(16)));
#define DPPF(old, x, ctrl, rmask) __builtin_bit_cast(float, __builtin_amdgcn_update_dpp(__builtin_bit_cast(int, (float)(old)), __builtin_bit_cast(int, (float)(x)), ctrl, rmask, 0xF, false))
DEV float wave_sum(float x) {
    x += DPPF(0.f, x, 0xB1, 0xF); x += DPPF(0.f, x, 0x4E, 0xF); x += DPPF(0.f, x, 0x141, 0xF); x += DPPF(0.f, x, 0x140, 0xF);
    x += DPPF(0.f, x, 0x142, 0xA); x += DPPF(0.f, x, 0x143, 0xC);
    return __builtin_bit_cast(float, __builtin_amdgcn_readlane(__builtin_bit_cast(int, x), 63));
}
#define SLD16(dst, ptr, off) asm volatile("s_load_dwordx16 %0, %1, %2 glc" : "=s"(dst) : "s"(ptr), "n"(off))
#define SLD4(dst, ptr, off) asm volatile("s_load_dwordx4 %0, %1, %2 glc" : "=s"(dst) : "s"(ptr), "n"(off))
DEV float sigmoidf_(float x) { return 1.0f / (1.0f + __expf(-x)); }
DEV float siluf_(float x) { return x / (1.0f + __expf(-x)); }
DEV float fsig_(float x) { return __builtin_amdgcn_rcpf(1.0f + __expf(-x)); }
DEV f32x4 ld4bf(const bf16* p_) { const u32x2 w = *(const u32x2*)p_; return (f32x4){__uint_as_float(w.x << 16), __uint_as_float(w.x & 0xffff0000u), __uint_as_float(w.y << 16), __uint_as_float(w.y & 0xffff0000u)}; }
DEV u32x4 pack8b(const f32x4& a, const f32x4& b) { u32x4 w; w.x = pk2(a.x, a.y); w.y = pk2(a.z, a.w); w.z = pk2(b.x, b.y); w.w = pk2(b.z, b.w); return w; }
DEV unsigned pkh(float a, float b) { typedef _Float16 h2 __attribute__((ext_vector_type(2))); const h2 t = {(_Float16)a, (_Float16)b}; return __builtin_bit_cast(unsigned, t); }
DEV unsigned pk4_fp8(float a, float b, float c, float d) { int w = 0; w = __builtin_amdgcn_cvt_pk_fp8_f32(a, b, w, false); w = __builtin_amdgcn_cvt_pk_fp8_f32(c, d, w, true); return (unsigned)w; }
DEV u32x4 packh8(const f32x4& a, const f32x4& b) { u32x4 w; w.x = pkh(a.x, a.y); w.y = pkh(a.z, a.w); w.z = pkh(b.x, b.y); w.w = pkh(b.z, b.w); return w; }
DEV void unpack8(const u32x4& w, f32x4& a, f32x4& b) {
    a.x = __uint_as_float(w.x << 16); a.y = __uint_as_float(w.x & 0xffff0000u); a.z = __uint_as_float(w.y << 16); a.w = __uint_as_float(w.y & 0xffff0000u);
    b.x = __uint_as_float(w.z << 16); b.y = __uint_as_float(w.z & 0xffff0000u); b.z = __uint_as_float(w.w << 16); b.w = __uint_as_float(w.w & 0xffff0000u); }
DEV float softplusf_(float y) { return fmaxf(y, 0.f) + log1pf(__expf(-fabsf(y))); }

DEV void mod_phase(const Params& p, LAS unsigned char* lds) {
    LAS float* sc = (LAS float*)lds;
    LAS float* red = (LAS float*)(lds + 16384);
    const int tid = tid_fresh(), lane = tid & 63, wv = tid >> 6;
    const float* c = p.in[1];
    for (int i = tid; i < 4096; i += 512) sc[i] = siluf_(c[i]);
    __syncthreads();
    float* MOD = (float*)(p.ws + WS_MOD);
    for (int item = blockIdx.x; item < 4 * 48; item += gridDim.x) {
        const int lk = item / 48, nb = item % 48, n = nb * 64 + lane;
        const float* W = p.in[2] + (size_t)lk * 1024 * 3072;
        float a0 = 0.f, a1 = 0.f, a2 = 0.f, a3 = 0.f;
#pragma unroll 16
        for (int k = wv * 128; k < wv * 128 + 128; ++k) {
            const float w = W[(size_t)k * 3072 + n];
            a0 += sc[k] * w; a1 += sc[1024 + k] * w; a2 += sc[2048 + k] * w; a3 += sc[3072 + k] * w;
        }
        red[(wv * 4 + 0) * 64 + lane] = a0; red[(wv * 4 + 1) * 64 + lane] = a1; red[(wv * 4 + 2) * 64 + lane] = a2; red[(wv * 4 + 3) * 64 + lane] = a3;
        __syncthreads();
        if (tid < 256) {
            const int b = tid >> 6; float s = p.in[3][lk * 3072 + n];
            for (int w8 = 0; w8 < 8; ++w8) s += red[(w8 * 4 + b) * 64 + lane];
            MOD[(size_t)(lk * 4 + b) * 3072 + n] = s;
        }
        __syncthreads();
    }
}

template <bool ROUTER>
DEV void norm_phase(const Params& p, int lk, const float* xin, LAS unsigned char* lds) {
    const int tid = tid_fresh(), lane = tid & 63, wv = tid >> 6;
    const int gw = blockIdx.x * 8 + wv, ngw = gridDim.x * 8;
    bf16* H = (bf16*)(p.ws + WS_H);
    const float* MOD = (const float*)(p.ws + WS_MOD);
    const float* g = p.in[4] + (size_t)lk * 1024;
    LAS unsigned* wgc = (LAS unsigned*)lds;
    for (int r0 = gw * 8; r0 < T; r0 += ngw * 8) {
        const int b = r0 / SEQ;
        const float* mod = MOD + (size_t)(lk * 4 + b) * 3072;
        int s_ea = 0, s_eb = 0; float s_wa = 0.f, s_wb = 0.f;
        if (ROUTER) { if (tid < 8) wgc[tid] = 0u; __syncthreads(); }
        f32x4 gs[4], sh[4];
#pragma unroll
        for (int j = 0; j < 4; ++j) {
            const int d = 4 * lane + 256 * j;
            const f32x4 gg = *(const f32x4*)(g + d), scl = *(const f32x4*)(mod + 1024 + d);
            gs[j] = gg * (scl + 1.0f); sh[j] = *(const f32x4*)(mod + d);
        }
        f32x4 vn[4];
#pragma unroll
        for (int j = 0; j < 4; ++j) vn[j] = *(const f32x4*)(xin + (size_t)r0 * D + 4 * lane + 256 * j);
        for (int r = r0; r < r0 + 8; ++r) {
            f32x4 v[4]; float ss = 0.f;
            const float* xn = xin + (size_t)(r + 1 < r0 + 8 ? r + 1 : r) * D;
#pragma unroll
            for (int j = 0; j < 4; ++j) { v[j] = vn[j]; vn[j] = *(const f32x4*)(xn + 4 * lane + 256 * j); ss += (v[j].x * v[j].x + v[j].y * v[j].y) + (v[j].z * v[j].z + v[j].w * v[j].w); }
            const float rstd = 1.0f / sqrtf(wave_sum(ss) * (1.0f / D) + RMS_EPS);
#pragma unroll
            for (int j = 0; j < 4; ++j) v[j] = v[j] * rstd * gs[j] + sh[j];
#pragma unroll
            for (int j = 0; j < 4; ++j) { u32x2 o; o.x = pk2(v[j].x, v[j].y); o.y = pk2(v[j].z, v[j].w); *(u32x2*)(H + (size_t)r * D + 4 * lane + 256 * j) = o; }
            if (ROUTER) {
                const float* R = p.in[34];
                float lg[8];
#pragma unroll
                for (int e = 0; e < 8; ++e) lg[e] = 0.f;
#pragma unroll
                for (int j = 0; j < 4; ++j)
#pragma unroll
                    for (int q = 0; q < 4; ++q) {
                        const int d = 4 * lane + 256 * j + q; const float hv = v[j][q];
                        const f32x4 w0 = *(const f32x4*)(R + (size_t)d * 8), w1 = *(const f32x4*)(R + (size_t)d * 8 + 4);
                        lg[0] += hv * w0.x; lg[1] += hv * w0.y; lg[2] += hv * w0.z; lg[3] += hv * w0.w;
                        lg[4] += hv * w1.x; lg[5] += hv * w1.y; lg[6] += hv * w1.z; lg[7] += hv * w1.w;
                    }
#pragma unroll
                for (int e = 0; e < 8; ++e) lg[e] = wave_sum(lg[e]);
                int ea = 0; float va = lg[0];
#pragma unroll
                for (int e = 1; e < 8; ++e) if (lg[e] > va) { va = lg[e]; ea = e; }
                int eb = -1; float vb = -3.0e38f;
#pragma unroll
                for (int e = 0; e < 8; ++e) if (e != ea && lg[e] > vb) { vb = lg[e]; eb = e; }
                const float wa = 1.0f / (1.0f + __expf(vb - va)), wb = 1.0f - wa;
                if (lane == r - r0) { s_ea = ea; s_eb = eb; s_wa = wa; s_wb = wb; }
            }
        }
        if (ROUTER) {
            unsigned pa = 0u, pb = 0u;
            if (lane < 8) { pa = atomicAdd((unsigned*)(wgc + s_ea), 1u); pb = atomicAdd((unsigned*)(wgc + s_eb), 1u); }
            __syncthreads();
            if (tid < 8) wgc[8 + tid] = atomicAdd((unsigned*)(p.ws + WS_CTL) + tid * 32, wgc[tid]);
            __syncthreads();
            if (lane < 8) {
                int* LT = (int*)(p.ws + WS_LTOK); float* LW = (float*)(p.ws + WS_LW);
                const int r = r0 + lane; const unsigned ga = wgc[8 + s_ea] + pa, gb = wgc[8 + s_eb] + pb;
                LT[s_ea * T + ga] = r * 2 + 0; LW[s_ea * T + ga] = s_wa;
                LT[s_eb * T + gb] = r * 2 + 1; LW[s_eb * T + gb] = s_wb;
            }
            __syncthreads();
        }
    }
}

template <int WIN>
DEV void pool_rows(const LAS bf16* sp, bf16* U, int m0, int tl0, int half, int ch) {
    float u[32 + WIN - 1];
#pragma unroll
    for (int k = 0; k < 32 + WIN - 1; ++k) u[k] = bf2f(sp[(half * 32 + 16 - WIN + k) * 256 + ch]);
    float s = 0.f;
#pragma unroll
    for (int k = 0; k < WIN - 1; ++k) s += u[k];
#pragma unroll
    for (int i = 0; i < 32; ++i) {
        s += u[i + WIN - 1];
        const int tl = tl0 + half * 32 + i; const float cnt = (float)((tl + 1) < WIN ? (tl + 1) : WIN);
        U[(size_t)(m0 + half * 32 + i) * D + ch] = (bf16)f2bf(s / cnt - u[i + WIN - 1]);
        s -= u[i];
    }
}
DEV void mixer_phase(const Params& p, int l, LAS unsigned char* lds) {
    const bf16* Zr = (const bf16*)(p.ws + WS_ZR); const bf16* Zp = (const bf16*)(p.ws + WS_ZP); const bf16* Zc = (const bf16*)(p.ws + WS_ZC);
    bf16* U = (bf16*)(p.ws + WS_U); float* VF = (float*)(p.ws + WS_VF); bf16* G = (bf16*)(p.ws + WS_G); float* BON = (float*)(p.ws + WS_BON);
    for (int blk = blockIdx.x; blk < T / 64; blk += gridDim.x) {
        int tid_ = threadIdx.x; asm volatile("" : "+v"(tid_));
        const int tid = tid_, lane = tid & 63, wv = __builtin_amdgcn_readfirstlane(tid >> 6);
        const int m0 = blk * 64, b = m0 / SEQ, tl0 = m0 % SEQ;
        {
            LAS bf16* sp = (LAS bf16*)lds;
            { u32x4 pv[5];
#pragma unroll
              for (int k = 0; k < 5; ++k) { const int ci = tid + k * 512, tt = ci >> 5, c8 = (ci & 31) * 8, tl = tl0 - 15 + tt;
                  pv[k] = (u32x4){0u, 0u, 0u, 0u}; if (ci < 79 * 32 && tl >= 0) pv[k] = *(const u32x4*)(Zp + (size_t)(b * SEQ + tl) * ZP_W + c8); }
#pragma unroll
              for (int k = 0; k < 5; ++k) { const int ci = tid + k * 512, tt = ci >> 5, c8 = (ci & 31) * 8; if (ci < 79 * 32) *(LAS u32x4*)(sp + tt * 256 + c8) = pv[k]; } }
            __syncthreads();
            const int ch = tid & 255, half = tid >> 8, gi = (wv & 3);
            switch (gi) { case 0: pool_rows<2>(sp, U, m0, tl0, half, ch); break; case 1: pool_rows<4>(sp, U, m0, tl0, half, ch); break;
                          case 2: pool_rows<8>(sp, U, m0, tl0, half, ch); break; default: pool_rows<16>(sp, U, m0, tl0, half, ch); break; }
            __syncthreads();
        }
        {
            LAS float* ug = (LAS float*)lds;
            LAS float* cw = (LAS float*)(lds + 94 * 1024);
            { u32x4 av[6], bv[6];
#pragma unroll
              for (int k = 0; k < 6; ++k) { const int idx = tid + k * 512, tt = idx >> 5, c8 = (idx & 31) * 8, tl = tl0 - 30 + tt;
                  av[k] = (u32x4){0u, 0u, 0u, 0u}; bv[k] = av[k];
                  if (idx < 94 * 32 && tl >= 0) { const bf16* zr = Zc + (size_t)(b * SEQ + tl) * ZC_W; av[k] = *(const u32x4*)(zr + c8); bv[k] = *(const u32x4*)(zr + 256 + c8); } }
              f32x4 wv4[4]; const float* CW = p.in[9] + (size_t)l * 31 * 256;
#pragma unroll
              for (int k = 0; k < 4; ++k) { const int idx = tid + k * 512; wv4[k] = idx < 31 * 64 ? *(const f32x4*)(CW + idx * 4) : (f32x4){0.f, 0.f, 0.f, 0.f}; }
#pragma unroll
              for (int k = 0; k < 6; ++k) { const int idx = tid + k * 512, tt = idx >> 5, c8 = (idx & 31) * 8;
                  if (idx < 94 * 32) { f32x4 a0, a1, b0, b1; unpack8(av[k], a0, a1); unpack8(bv[k], b0, b1);
#pragma unroll
                      for (int e = 0; e < 4; ++e) { a0[e] *= fsig_(b0[e]); a1[e] *= fsig_(b1[e]); }
                      *(LAS f32x4*)(ug + tt * 256 + c8) = a0; *(LAS f32x4*)(ug + tt * 256 + c8 + 4) = a1; } }
#pragma unroll
              for (int k = 0; k < 4; ++k) { const int idx = tid + k * 512; if (idx < 31 * 64) *(LAS f32x4*)(cw + idx * 4) = wv4[k]; } }
            __syncthreads();
            const int c4 = 4 * lane;
            const f32x4 cb = *(const f32x4*)(p.in[10] + l * 256 + c4), lg = *(const f32x4*)(p.in[11] + l * 256 + c4), lb = *(const f32x4*)(p.in[12] + l * 256 + c4);
            {
                f32x4 wk[31];
#pragma unroll
                for (int k = 0; k < 31; ++k) wk[k] = *(const LAS f32x4*)(cw + k * 256 + c4);
                f32x4 acc[8];
#pragma unroll
                for (int j = 0; j < 8; ++j) acc[j] = cb;
#pragma unroll
                for (int r = 0; r < 38; ++r) {
                    const f32x4 x = *(const LAS f32x4*)(ug + (wv * 8 + r) * 256 + c4);
#pragma unroll
                    for (int j = 0; j < 8; ++j) if (r - j >= 0 && r - j <= 30) acc[j] += x * wk[r - j];
                }
#pragma unroll
                for (int j = 0; j < 8; ++j) {
                    const int i = wv * 8 + j;
                    const float mean = wave_sum((acc[j].x + acc[j].y) + (acc[j].z + acc[j].w)) * (1.0f / 256.0f);
                    const f32x4 d = acc[j] - mean;
                    const float var = wave_sum((d.x * d.x + d.y * d.y) + (d.z * d.z + d.w * d.w)) * (1.0f / 256.0f);
                    const float rstd = 1.0f / sqrtf(var + LN_EPS);
                    const f32x4 un = d * rstd * lg + lb;
                    u32x2 o; o.x = pk2(un.x * fsig_(un.x), un.y * fsig_(un.y)); o.y = pk2(un.z * fsig_(un.z), un.w * fsig_(un.w));
                    *(u32x2*)(U + (size_t)(m0 + i) * D + 256 + c4) = o;
                }
            }
            __syncthreads();
        }
        {
            typedef short bf16x8 __attribute__((ext_vector_type(8)));
            LAS bf16* LAb = (LAS bf16*)lds;
            const float* mu = p.in[14] + (size_t)l * 1664;
            { u32x4 zc[3], zq[3];
#pragma unroll
              for (int k = 0; k < 3; ++k) { const int idx = tid + k * 512, i = idx / 20, k8 = idx % 20, m = m0 + i, tl = tl0 + i;
                  zc[k] = (u32x4){0u, 0u, 0u, 0u}; zq[k] = zc[k];
                  if (idx < 64 * 20 && k8 < 18) { zc[k] = *(const u32x4*)(Zr + (size_t)m * ZR_W + 1536 + k8 * 8); if (tl > 0) zq[k] = *(const u32x4*)(Zr + (size_t)(m - 1) * ZR_W + 1536 + k8 * 8); } }
#pragma unroll
              for (int k = 0; k < 3; ++k) { const int idx = tid + k * 512, i = idx / 20, k8 = idx % 20;
                  if (idx < 64 * 20) { f32x4 c0, c1, q0, q1; unpack8(zc[k], c0, c1); unpack8(zq[k], q0, q1);
                      const float* mp = k8 < 16 ? mu + 1536 + k8 * 8 : p.in[27] + (k8 - 16) * 8;
                      f32x4 m0v = (f32x4){0.f, 0.f, 0.f, 0.f}, m1v = m0v; if (k8 < 18) { m0v = *(const f32x4*)mp; m1v = *(const f32x4*)(mp + 4); }
                      c0 = c0 + (q0 - c0) * m0v; c1 = c1 + (q1 - c1) * m1v;
                      if (k8 < 4) {
#pragma unroll
                          for (int e = 0; e < 4; ++e) { c0[e] = 1.0f - 2.0f * __builtin_amdgcn_rcpf(1.0f + __expf(2.0f * c0[e])); c1[e] = 1.0f - 2.0f * __builtin_amdgcn_rcpf(1.0f + __expf(2.0f * c1[e])); }
                      } else if (k8 >= 8 && k8 < 16) {
#pragma unroll
                          for (int e = 0; e < 4; ++e) { c0[e] = fsig_(c0[e]); c1[e] = fsig_(c1[e]); }
                      }
                      *(LAS u32x4*)(LAb + i * 168 + k8 * 8) = pack8b(c0, c1); } } }
            const int hh = wv, fr = lane & 15;
            __syncthreads();
            const f32x4 z4 = (f32x4){0.f, 0.f, 0.f, 0.f};
            bf16* SCh = (bf16*)(p.ws + WS_SC);
            LAS float* invL = (LAS float*)(lds + 24576) + wv * 64;
            LAS float* bonL = (LAS float*)(lds + 26624) + wv * 256;
            { int fq_ = lane >> 4; asm volatile("" : "+v"(fq_)); const int fq = fq_;
#pragma unroll 1
            for (int mt = 0; mt < 4; ++mt) {
                const int i = mt * 16 + fr, m = m0 + i, tl = tl0 + i;
                const bf16* zt = Zr + (size_t)m * ZR_W; const bf16* zp = zt - ZR_W; const bool hasp = tl > 0;
                float ss = 0.f;
#pragma unroll
                for (int q = 0; q < 2; ++q) {
                    const int c = hh * 64 + q * 32 + 8 * fq;
                    f32x4 kt0, kt1, kq0 = z4, kq1 = z4; unpack8(*(const u32x4*)(zt + 512 + c), kt0, kt1); if (hasp) unpack8(*(const u32x4*)(zp + 512 + c), kq0, kq1);
                    const f32x4 ka = (kt0 + (kq0 - kt0) * *(const f32x4*)(mu + 512 + c)) * *(const f32x4*)(p.in[20] + l * 512 + c);
                    const f32x4 kb = (kt1 + (kq1 - kt1) * *(const f32x4*)(mu + 512 + c + 4)) * *(const f32x4*)(p.in[20] + l * 512 + c + 4);
                    ss += ((ka.x * ka.x + ka.y * ka.y) + (ka.z * ka.z + ka.w * ka.w)) + ((kb.x * kb.x + kb.y * kb.y) + (kb.z * kb.z + kb.w * kb.w));
                }
                ss += __shfl_xor(ss, 16); ss += __shfl_xor(ss, 32);
                if (fq == 0) invL[i] = 1.0f / fmaxf(sqrtf(ss), 1e-12f);
            } }
            for (int q = 0; q < 2; ++q) {
                int fq_ = lane >> 4; asm volatile("" : "+v"(fq_));
                const int fq = fq_;
                bf16x8 Bw[2], Ba[2], Bg[2][2], Bv[2];
#pragma unroll
                for (int hf = 0; hf < 2; ++hf) {
                    const bf16* fp = (const bf16*)(p.ws + WS_LORA) + ((size_t)((((l * 8 + hh) * 2 + q) * 2 + hf) * 5) * 64 + lane) * 8;
                    Bw[hf] = *(const bf16x8*)(fp); Ba[hf] = *(const bf16x8*)(fp + 512); Bg[hf][0] = *(const bf16x8*)(fp + 1024); Bg[hf][1] = *(const bf16x8*)(fp + 1536); Bv[hf] = *(const bf16x8*)(fp + 2048);
                }
                const int c = hh * 64 + q * 32 + 8 * fq;
#pragma unroll 1
                for (int mt = 0; mt < 4; ++mt) {
                    const int i = mt * 16 + fr, m = m0 + i, tl = tl0 + i;
                    const float inv_i = invL[i];
                    bf16x8 Af[5];
#pragma unroll
                    for (int ks = 0; ks < 5; ++ks) Af[ks] = *(const LAS bf16x8*)(LAb + i * 168 + 32 * ks + 8 * fq);
                    const bf16* zt = Zr + (size_t)m * ZR_W; const bf16* zp = zt - ZR_W; const bool hasp = tl > 0;
                    bf16* rec = SCh + ((size_t)(b * NH + hh) * SEQ + tl) * SCH + fq * 96;
                    f32x4 rt[2], kt[2], vt[2], rq[2] = {z4, z4}, kq[2] = {z4, z4}, vq[2] = {z4, z4};
                    unpack8(*(const u32x4*)(zt + c), rt[0], rt[1]); unpack8(*(const u32x4*)(zt + 512 + c), kt[0], kt[1]); unpack8(*(const u32x4*)(zt + 1024 + c), vt[0], vt[1]);
                    if (hasp) { unpack8(*(const u32x4*)(zp + c), rq[0], rq[1]); unpack8(*(const u32x4*)(zp + 512 + c), kq[0], kq[1]); unpack8(*(const u32x4*)(zp + 1024 + c), vq[0], vq[1]); }
                    f32x4 om[2], kka[2], kpv[2], r4[2], kkv[2], v4[2], gg[2];
                    float bon = 0.f;
#pragma unroll
                    for (int hf = 0; hf < 2; ++hf) {
                        const int cc = c + 4 * hf;
                        const f32x4 aw_ = __builtin_amdgcn_mfma_f32_16x16x32_bf16(Bw[hf], Af[0], z4, 0, 0, 0);
                        const f32x4 aa_ = __builtin_amdgcn_mfma_f32_16x16x32_bf16(Ba[hf], Af[1], z4, 0, 0, 0);
                        gg[hf] = __builtin_amdgcn_mfma_f32_16x16x32_bf16(Bg[hf][1], Af[3], __builtin_amdgcn_mfma_f32_16x16x32_bf16(Bg[hf][0], Af[2], z4, 0, 0, 0), 0, 0, 0);
                        r4[hf] = rt[hf] + (rq[hf] - rt[hf]) * *(const f32x4*)(mu + cc);
                        const f32x4 k4 = kt[hf] + (kq[hf] - kt[hf]) * *(const f32x4*)(mu + 512 + cc);
                        v4[hf] = vt[hf] + (vq[hf] - vt[hf]) * *(const f32x4*)(mu + 1024 + cc);
                        const f32x4 wl = aw_ + *(const f32x4*)(p.in[15] + l * 512 + cc), al = aa_ + *(const f32x4*)(p.in[17] + l * 512 + cc);
                        f32x4 a4;
#pragma unroll
                        for (int e = 0; e < 4; ++e) {
                            const float y = -wl[e];
                            const float sp = fmaxf(y, 0.f) + __logf(1.0f + __expf(-fabsf(y)));
                            om[hf][e] = 1.0f - __expf(-__expf(-sp - 0.5f)); a4[e] = fsig_(al[e]);
                        }
                        kkv[hf] = k4 * *(const f32x4*)(p.in[20] + l * 512 + cc) * inv_i;
                        kpv[hf] = k4 * ((a4 - 1.0f) * *(const f32x4*)(p.in[21] + l * 512 + cc) + 1.0f); kka[hf] = kkv[hf] * a4;
                        const f32x4 rk = r4[hf] * kpv[hf] * *(const f32x4*)(p.in[22] + l * 512 + cc);
                        bon += (rk.x + rk.y) + (rk.z + rk.w);
                        if (l) {
                            const f32x4 vl = __builtin_amdgcn_mfma_f32_16x16x32_bf16(Bv[hf], Af[4], z4, 0, 0, 0) + *(const f32x4*)(p.in[28] + cc), vf = *(const f32x4*)(VF + (size_t)m * RW + cc);
#pragma unroll
                            for (int e = 0; e < 4; ++e) v4[hf][e] = v4[hf][e] + (vf[e] - v4[hf][e]) * fsig_(vl[e]);
                        } else *(f32x4*)(VF + (size_t)m * RW + cc) = v4[hf];
                    }
                    if (q == 0) bonL[mt * 64 + lane] = bon; else bon += bonL[mt * 64 + lane];
                    if (q == 1) { bon += __shfl_xor(bon, 16); bon += __shfl_xor(bon, 32); if (fq == 0) BON[(size_t)m * NH + hh] = bon; }
                    *(u32x4*)(rec + q * 40) = packh8(om[0], om[1]); *(u32x4*)(rec + q * 40 + 8) = packh8(kka[0], kka[1]); *(u32x4*)(rec + q * 40 + 16) = packh8(kpv[0], kpv[1]);
                    *(u32x4*)(rec + q * 40 + 24) = packh8(r4[0], r4[1]); *(u32x4*)(rec + q * 40 + 32) = packh8(kkv[0], kkv[1]);
                    *(u32x4*)(rec + 80 + q * 8) = packh8(v4[0], v4[1]);
                    u32x4 go; go.x = pk2(gg[0].x, gg[0].y); go.y = pk2(gg[0].z, gg[0].w); go.z = pk2(gg[1].x, gg[1].y); go.w = pk2(gg[1].z, gg[1].w);
                    *(u32x4*)(G + (size_t)m * RW + c) = go;
                }
            }
            __syncthreads();
        }
    }
}

struct RecRegs { u32x2 g2; unsigned g1; };
DEV void rec_load(RecRegs& r, const bf16* rec, int lane) { r.g2 = *(const u32x2*)(rec + lane * 4); r.g1 = *(const unsigned*)(rec + 256 + lane * 2); }
DEV void rec_put(const RecRegs& r, LAS unsigned char* slot, int lane) { *(LAS u32x2*)(slot + lane * 8) = r.g2; *(LAS unsigned*)(slot + 512 + lane * 4) = r.g1; }
DEV float h2f(unsigned short h) { return (float)__builtin_bit_cast(_Float16, h); }
DEV void blk4h_full(float& s0, float& s1, float& s2, float& s3, float (&o)[4], float (&san)[4], float sa, float vv, unsigned d0, unsigned d1, unsigned a0, unsigned a1, unsigned p0, unsigned p1, unsigned r0, unsigned r1, unsigned k0, unsigned k1) {
    asm volatile(
        "v_fma_mix_f32 %0, -%14, %0, %0 op_sel:[0,0,0] op_sel_hi:[1,0,0]\n v_fma_mix_f32 %1, -%14, %1, %1 op_sel:[1,0,0] op_sel_hi:[1,0,0]\n"
        "v_fma_mix_f32 %2, -%15, %2, %2 op_sel:[0,0,0] op_sel_hi:[1,0,0]\n v_fma_mix_f32 %3, -%15, %3, %3 op_sel:[1,0,0] op_sel_hi:[1,0,0]\n"
        "v_fma_mix_f32 %0, %16, %12, %0 op_sel:[0,0,0] op_sel_hi:[1,0,0]\n v_fma_mix_f32 %1, %16, %12, %1 op_sel:[1,0,0] op_sel_hi:[1,0,0]\n"
        "v_fma_mix_f32 %2, %17, %12, %2 op_sel:[0,0,0] op_sel_hi:[1,0,0]\n v_fma_mix_f32 %3, %17, %12, %3 op_sel:[1,0,0] op_sel_hi:[1,0,0]\n"
        "v_fma_mix_f32 %0, %18, %13, %0 op_sel:[0,0,0] op_sel_hi:[1,0,0]\n v_fma_mix_f32 %1, %18, %13, %1 op_sel:[1,0,0] op_sel_hi:[1,0,0]\n"
        "v_fma_mix_f32 %2, %19, %13, %2 op_sel:[0,0,0] op_sel_hi:[1,0,0]\n v_fma_mix_f32 %3, %19, %13, %3 op_sel:[1,0,0] op_sel_hi:[1,0,0]\n"
        "v_fma_mix_f32 %4, %20, %0, %4 op_sel:[0,0,0] op_sel_hi:[1,0,0]\n v_fma_mix_f32 %5, %20, %1, %5 op_sel:[1,0,0] op_sel_hi:[1,0,0]\n"
        "v_fma_mix_f32 %6, %21, %2, %6 op_sel:[0,0,0] op_sel_hi:[1,0,0]\n v_fma_mix_f32 %7, %21, %3, %7 op_sel:[1,0,0] op_sel_hi:[1,0,0]\n"
        "v_fma_mix_f32 %8, %22, %0, %8 op_sel:[0,0,0] op_sel_hi:[1,0,0]\n v_fma_mix_f32 %9, %22, %1, %9 op_sel:[1,0,0] op_sel_hi:[1,0,0]\n"
        "v_fma_mix_f32 %10, %23, %2, %10 op_sel:[0,0,0] op_sel_hi:[1,0,0]\n v_fma_mix_f32 %11, %23, %3, %11 op_sel:[1,0,0] op_sel_hi:[1,0,0]\n"
        : "+v"(s0), "+v"(s1), "+v"(s2), "+v"(s3), "+v"(o[0]), "+v"(o[1]), "+v"(o[2]), "+v"(o[3]), "+v"(san[0]), "+v"(san[1]), "+v"(san[2]), "+v"(san[3])
        : "v"(sa), "v"(vv), "v"(d0), "v"(d1), "v"(a0), "v"(a1), "v"(p0), "v"(p1), "v"(r0), "v"(r1), "v"(k0), "v"(k1));
}
DEV void blk4h_two(float& s0, float& s1, float& s2, float& s3, float& q0, float& q1, float& q2, float& q3, float (&sanl)[4], float (&sanp)[4], float sal, float sap, float vv,
                   unsigned d0, unsigned d1, unsigned a0, unsigned a1, unsigned p0, unsigned p1, unsigned k0, unsigned k1) {
    asm volatile(
        "v_fma_mix_f32 %0, -%19, %0, %0 op_sel:[0,0,0] op_sel_hi:[1,0,0]\n v_fma_mix_f32 %1, -%19, %1, %1 op_sel:[1,0,0] op_sel_hi:[1,0,0]\n"
        "v_fma_mix_f32 %2, -%20, %2, %2 op_sel:[0,0,0] op_sel_hi:[1,0,0]\n v_fma_mix_f32 %3, -%20, %3, %3 op_sel:[1,0,0] op_sel_hi:[1,0,0]\n"
        "v_fma_mix_f32 %4, -%19, %4, %4 op_sel:[0,0,0] op_sel_hi:[1,0,0]\n v_fma_mix_f32 %5, -%19, %5, %5 op_sel:[1,0,0] op_sel_hi:[1,0,0]\n"
        "v_fma_mix_f32 %6, -%20, %6, %6 op_sel:[0,0,0] op_sel_hi:[1,0,0]\n v_fma_mix_f32 %7, -%20, %7, %7 op_sel:[1,0,0] op_sel_hi:[1,0,0]\n"
        "v_fma_mix_f32 %0, %21, %16, %0 op_sel:[0,0,0] op_sel_hi:[1,0,0]\n v_fma_mix_f32 %1, %21, %16, %1 op_sel:[1,0,0] op_sel_hi:[1,0,0]\n"
        "v_fma_mix_f32 %2, %22, %16, %2 op_sel:[0,0,0] op_sel_hi:[1,0,0]\n v_fma_mix_f32 %3, %22, %16, %3 op_sel:[1,0,0] op_sel_hi:[1,0,0]\n"
        "v_fma_mix_f32 %4, %21, %17, %4 op_sel:[0,0,0] op_sel_hi:[1,0,0]\n v_fma_mix_f32 %5, %21, %17, %5 op_sel:[1,0,0] op_sel_hi:[1,0,0]\n"
        "v_fma_mix_f32 %6, %22, %17, %6 op_sel:[0,0,0] op_sel_hi:[1,0,0]\n v_fma_mix_f32 %7, %22, %17, %7 op_sel:[1,0,0] op_sel_hi:[1,0,0]\n"
        "v_fma_mix_f32 %0, %23, %18, %0 op_sel:[0,0,0] op_sel_hi:[1,0,0]\n v_fma_mix_f32 %1, %23, %18, %1 op_sel:[1,0,0] op_sel_hi:[1,0,0]\n"
        "v_fma_mix_f32 %2, %24, %18, %2 op_sel:[0,0,0] op_sel_hi:[1,0,0]\n v_fma_mix_f32 %3, %24, %18, %3 op_sel:[1,0,0] op_sel_hi:[1,0,0]\n"
        "v_fma_mix_f32 %8, %25, %0, %8 op_sel:[0,0,0] op_sel_hi:[1,0,0]\n v_fma_mix_f32 %9, %25, %1, %9 op_sel:[1,0,0] op_sel_hi:[1,0,0]\n"
        "v_fma_mix_f32 %10, %26, %2, %10 op_sel:[0,0,0] op_sel_hi:[1,0,0]\n v_fma_mix_f32 %11, %26, %3, %11 op_sel:[1,0,0] op_sel_hi:[1,0,0]\n"
        "v_fma_mix_f32 %12, %25, %4, %12 op_sel:[0,0,0] op_sel_hi:[1,0,0]\n v_fma_mix_f32 %13, %25, %5, %13 op_sel:[1,0,0] op_sel_hi:[1,0,0]\n"
        "v_fma_mix_f32 %14, %26, %6, %14 op_sel:[0,0,0] op_sel_hi:[1,0,0]\n v_fma_mix_f32 %15, %26, %7, %15 op_sel:[1,0,0] op_sel_hi:[1,0,0]\n"
        : "+v"(s0), "+v"(s1), "+v"(s2), "+v"(s3), "+v"(q0), "+v"(q1), "+v"(q2), "+v"(q3), "+v"(sanl[0]), "+v"(sanl[1]), "+v"(sanl[2]), "+v"(sanl[3]), "+v"(sanp[0]), "+v"(sanp[1]), "+v"(sanp[2]), "+v"(sanp[3])
        : "v"(sal), "v"(sap), "v"(vv), "v"(d0), "v"(d1), "v"(a0), "v"(a1), "v"(p0), "v"(p1), "v"(k0), "v"(k1));
}
#define BLK_OFF(b8) (((b8) >> 1) * 192 + ((b8) & 1) * 80)
#define BLK_J0(b8) (((b8) & 1) * 32 + ((b8) >> 1) * 8)

DEV void scan_pass1(const Params& p, LAS unsigned char* lds) {
    const int tid = tid_fresh(), lane = tid & 63, wv = __builtin_amdgcn_readfirstlane(tid >> 6);
    const bf16* SC = (const bf16*)(p.ws + WS_SC); float* LS = (float*)(p.ws + WS_LS); float* PM = (float*)(p.ws + WS_PM);
    LAS unsigned char* ring = lds + wv * 1536;
    const int lq = lane >> 5, lfq = (lane >> 3) & 3, le = lane & 7;
    const int voff = lfq * 192 + 160 + lq * 16 + le * 2, koff = lfq * 192 + lq * 80 + 64 + le * 2;
    for (int u = blockIdx.x * 8 + wv; u < 32 * NCH; u += gridDim.x * 8) {
        const int c = u % NCH;
        const bf16* rec = SC + (size_t)u * CH * SCH;
        float S[64], Q[64];
        int ln = lane; asm volatile("" : "+v"(ln));
#pragma unroll
        for (int j = 0; j < 64; ++j) { S[j] = 0.f; Q[j] = (j == ln) ? 1.f : 0.f; }
        RecRegs r1, r2, r3;
        { RecRegs r0; rec_load(r0, rec, lane); rec_put(r0, ring, lane); }
        rec_load(r1, rec + SCH, lane); rec_load(r2, rec + 2 * SCH, lane);
        float sal = 0.f, sap = -h2f(*(const LAS unsigned short*)(ring + koff));
        for (int t = 0; t < CH; t += 2) {
#pragma unroll
            for (int h = 0; h < 2; ++h) {
                LAS unsigned char* cur = ring + h * 768; LAS unsigned char* nxt = ring + (h ^ 1) * 768;
                rec_load(r3, rec + 3 * SCH, lane);
                rec_put(r1, nxt, lane); r1 = r2; r2 = r3;
                const float vv = h2f(*(const LAS unsigned short*)(cur + voff));
                float sanl[4] = {0.f, 0.f, 0.f, 0.f}, sanp[4] = {0.f, 0.f, 0.f, 0.f};
#define P1_LD(X, B8) do { X##0 = *(const LAS u32x4*)(cur + BLK_OFF(B8)); X##1 = *(const LAS u32x4*)(cur + BLK_OFF(B8) + 16); X##2 = *(const LAS u32x4*)(cur + BLK_OFF(B8) + 32); X##3 = *(const LAS u32x4*)(nxt + BLK_OFF(B8) + 64); } while (0)
#define P1_CB(J0, H, D, A, P, K) blk4h_two(S[(J0)], S[(J0) + 1], S[(J0) + 2], S[(J0) + 3], Q[(J0)], Q[(J0) + 1], Q[(J0) + 2], Q[(J0) + 3], sanl, sanp, sal, sap, vv, D[2 * (H)], D[2 * (H) + 1], A[2 * (H)], A[2 * (H) + 1], P[2 * (H)], P[2 * (H) + 1], K[2 * (H)], K[2 * (H) + 1])
#define P1_BLK(B8, X, Y) do { if ((B8) < 7) P1_LD(Y, (B8) + 1); __builtin_amdgcn_sched_barrier(0); P1_CB(BLK_J0(B8), 0, X##0, X##1, X##2, X##3); P1_CB(BLK_J0(B8) + 4, 1, X##0, X##1, X##2, X##3); __builtin_amdgcn_sched_barrier(0); } while (0)
                u32x4 oa0, oa1, oa2, oa3, ob0, ob1, ob2, ob3;
                P1_LD(oa, 0);
                P1_BLK(0, oa, ob); P1_BLK(1, ob, oa); P1_BLK(2, oa, ob); P1_BLK(3, ob, oa); P1_BLK(4, oa, ob); P1_BLK(5, ob, oa); P1_BLK(6, oa, ob); P1_BLK(7, ob, oa);
#undef P1_LD
#undef P1_CB
#undef P1_BLK
                sal = -((sanl[0] + sanl[1]) + (sanl[2] + sanl[3])); sap = -((sanp[0] + sanp[1]) + (sanp[2] + sanp[3])); rec += SCH;
            }
        }
        asm volatile("" :: "v"(r1.g2), "v"(r1.g1), "v"(r2.g2), "v"(r2.g1));
        float* o = LS + ((size_t)u * 64 + lane) * 64;
#pragma unroll
        for (int j = 0; j < 64; j += 4) *(f32x4*)(o + j) = (f32x4){S[j], S[j + 1], S[j + 2], S[j + 3]};
        if (c > 0) {
            o = PM + ((size_t)u * 64 + lane) * 64;
#pragma unroll
            for (int j = 0; j < 64; j += 4) *(f32x4*)(o + j) = (f32x4){Q[j], Q[j + 1], Q[j + 2], Q[j + 3]};
        }
    }
}
DEV float rdl(float v, int j) { return __builtin_bit_cast(float, __builtin_amdgcn_readlane(__builtin_bit_cast(int, v), j)); }
DEV void scan_carry(const Params& p, LAS unsigned char* lds) {
    const int tid = tid_fresh(), lane = tid & 63, wv = __builtin_amdgcn_readfirstlane(tid >> 6);
    float* LS = (float*)(p.ws + WS_LS); const float* PM = (const float*)(p.ws + WS_PM);
    LAS float* Pb = (LAS float*)lds;
    for (int u = blockIdx.x; u < 32 * 8; u += gridDim.x) {
        const int bh = u >> 3, i = (u & 7) * 8 + wv;
        float* Lp = LS + (size_t)bh * NCH * 4096 + i * 64 + lane;
        const float* Pp = PM + (size_t)bh * NCH * 4096 + (wv * 8) * 64 + lane;
        float s = 0.f, pr[8];
#pragma unroll
        for (int j = 0; j < 8; ++j) pr[j] = Pp[(size_t)1 * 4096 + j * 64];
        float Lc = Lp[0];
        __builtin_amdgcn_s_barrier();
        for (int c = 0; c < NCH; ++c) {
            LAS float* cur = Pb + (c & 1) * 4096; LAS float* nxt = Pb + ((c + 1) & 1) * 4096;
            if (c + 1 < NCH) {
#pragma unroll
                for (int j = 0; j < 8; ++j) nxt[(wv * 8 + j) * 64 + lane] = pr[j];
            }
            const int c2 = c + 2 < NCH ? c + 2 : NCH - 1, c1 = c + 1 < NCH ? c + 1 : NCH - 1;
#pragma unroll
            for (int j = 0; j < 8; ++j) pr[j] = Pp[(size_t)c2 * 4096 + j * 64];
            const float Ln = Lp[(size_t)c1 * 4096];
            float acc = Lc;
            if (c > 0) {
                float a0 = 0.f, a1 = 0.f, a2 = 0.f, a3 = 0.f;
#pragma unroll
                for (int j = 0; j < 64; j += 4) { a0 += rdl(s, j) * cur[j * 64 + lane]; a1 += rdl(s, j + 1) * cur[(j + 1) * 64 + lane]; a2 += rdl(s, j + 2) * cur[(j + 2) * 64 + lane]; a3 += rdl(s, j + 3) * cur[(j + 3) * 64 + lane]; }
                acc += (a0 + a1) + (a2 + a3);
            }
            Lp[(size_t)c * 4096] = s; s = acc; Lc = Ln;
            asm volatile("s_waitcnt lgkmcnt(0)" ::: "memory"); __builtin_amdgcn_s_barrier(); asm volatile("" ::: "memory");
        }
    }
}
DEV void scan_pass2(const Params& p, int l, LAS unsigned char* lds) {
    const int tid = tid_fresh(), lane = tid & 63, wv = __builtin_amdgcn_readfirstlane(tid >> 6);
    const bf16* SC = (const bf16*)(p.ws + WS_SC); const float* LS = (const float*)(p.ws + WS_LS);
    const bf16* G = (const bf16*)(p.ws + WS_G); const float* BON = (const float*)(p.ws + WS_BON); bf16* U = (bf16*)(p.ws + WS_U);
    LAS unsigned char* ring = lds + wv * 1536;
    const int voff = ((lane >> 3) & 3) * 192 + 160 + (lane >> 5) * 16 + (lane & 7) * 2;
    for (int u = blockIdx.x * 8 + wv; u < 32 * NCH; u += gridDim.x * 8) {
        const int bh = u / NCH, c = u % NCH, b = bh >> 3, hh = bh & 7;
        const bf16* rec = SC + (size_t)u * CH * SCH;
        const float lg = p.in[23][l * 512 + hh * 64 + lane], lb = p.in[24][l * 512 + hh * 64 + lane];
        float S[64];
        const float* s0 = LS + ((size_t)u * 64 + lane) * 64;
#pragma unroll
        for (int j = 0; j < 64; j += 4) { const f32x4 v = *(const f32x4*)(s0 + j); S[j] = v.x; S[j + 1] = v.y; S[j + 2] = v.z; S[j + 3] = v.w; }
        RecRegs r1, r2, r3;
        { RecRegs r0; rec_load(r0, rec, lane); rec_put(r0, ring, lane); }
        rec_load(r1, rec + SCH, lane); rec_load(r2, rec + 2 * SCH, lane);
        float sa = 0.f;
        if (c > 0) {
#pragma unroll
            for (int b8 = 0; b8 < 8; ++b8) { const u32x4 kv = *(const LAS u32x4*)(ring + BLK_OFF(b8) + 64);
#pragma unroll
                for (int e = 0; e < 4; ++e) { sa -= S[BLK_J0(b8) + 2 * e] * h2f((unsigned short)(kv[e] & 0xffffu)); sa -= S[BLK_J0(b8) + 2 * e + 1] * h2f((unsigned short)(kv[e] >> 16)); } }
        }
        const int m0 = b * SEQ + c * CH;
        for (int t = 0; t < CH; t += 2) {
#pragma unroll
            for (int h = 0; h < 2; ++h) {
                LAS unsigned char* cur = ring + h * 768; LAS unsigned char* nxt = ring + (h ^ 1) * 768;
                rec_load(r3, rec + 3 * SCH, lane);
                rec_put(r1, nxt, lane); r1 = r2; r2 = r3;
                const float vv = h2f(*(const LAS unsigned short*)(cur + voff));
                const int m = m0 + t + h;
                const float bon = BON[(size_t)m * NH + hh], gt = bf2f(G[(size_t)m * RW + hh * 64 + lane]);
                float o4[4] = {0.f, 0.f, 0.f, 0.f}, san4[4] = {0.f, 0.f, 0.f, 0.f};
#define P2_LD(X, B8) do { X##0 = *(const LAS u32x4*)(cur + BLK_OFF(B8)); X##1 = *(const LAS u32x4*)(cur + BLK_OFF(B8) + 16); X##2 = *(const LAS u32x4*)(cur + BLK_OFF(B8) + 32); X##3 = *(const LAS u32x4*)(cur + BLK_OFF(B8) + 48); X##4 = *(const LAS u32x4*)(nxt + BLK_OFF(B8) + 64); } while (0)
#define P2_CB(J0, H, D, A, P, R, K) blk4h_full(S[(J0)], S[(J0) + 1], S[(J0) + 2], S[(J0) + 3], o4, san4, sa, vv, D[2 * (H)], D[2 * (H) + 1], A[2 * (H)], A[2 * (H) + 1], P[2 * (H)], P[2 * (H) + 1], R[2 * (H)], R[2 * (H) + 1], K[2 * (H)], K[2 * (H) + 1])
#define P2_BLK(B8, X, Y) do { if ((B8) < 7) P2_LD(Y, (B8) + 1); __builtin_amdgcn_sched_barrier(0); P2_CB(BLK_J0(B8), 0, X##0, X##1, X##2, X##3, X##4); P2_CB(BLK_J0(B8) + 4, 1, X##0, X##1, X##2, X##3, X##4); __builtin_amdgcn_sched_barrier(0); } while (0)
                u32x4 oa0, oa1, oa2, oa3, oa4, ob0, ob1, ob2, ob3, ob4;
                P2_LD(oa, 0);
                P2_BLK(0, oa, ob); P2_BLK(1, ob, oa); P2_BLK(2, oa, ob); P2_BLK(3, ob, oa); P2_BLK(4, oa, ob); P2_BLK(5, ob, oa); P2_BLK(6, oa, ob); P2_BLK(7, ob, oa);
#undef P2_LD
#undef P2_CB
#undef P2_BLK
                sa = -((san4[0] + san4[1]) + (san4[2] + san4[3])); rec += SCH;
                const float o = (o4[0] + o4[1]) + (o4[2] + o4[3]);
                const float mean = wave_sum(o) * (1.0f / 64.0f), dlt = o - mean;
                const float var = wave_sum(dlt * dlt) * (1.0f / 64.0f);
                const float on = dlt * (1.0f / sqrtf(var + GN_EPS)) * lg + lb;
                U[(size_t)m * D + 512 + hh * 64 + lane] = (bf16)f2bf((on + bon * vv) * gt);
            }
        }
        asm volatile("" :: "v"(r1.g2), "v"(r1.g1), "v"(r2.g2), "v"(r2.g1));
    }
}

template <bool MOE>
DEV void final_phase(const Params& p) {
    const int tid = tid_fresh(), lane = tid & 63, wv = tid >> 6;
    const float* g = p.in[38]; float* X = p.out;
    const bf16* Y = (const bf16*)(p.ws + WS_Y);
    const float* MOD = (const float*)(p.ws + WS_MOD);
    const int nw = gridDim.x * 8;
    for (int r0 = blockIdx.x * 8 + wv; r0 < T; r0 += 2 * nw) {
        f32x4 v[2][4]; u32x2 y0[2][4], y1[2][4];
#pragma unroll
        for (int k = 0; k < 2; ++k) { const int r = r0 + k * nw < T ? r0 + k * nw : r0;
#pragma unroll
            for (int j = 0; j < 4; ++j) { const int d = 4 * lane + 256 * j; v[k][j] = *(const f32x4*)(X + (size_t)r * D + d);
                if (MOE) { y0[k][j] = *(const u32x2*)(Y + (size_t)r * D + d); y1[k][j] = *(const u32x2*)(Y + (size_t)(T + r) * D + d); } } }
#pragma unroll
        for (int k = 0; k < 2; ++k) { const int r = r0 + k * nw;
            if (r < T) {
                const int b = r / SEQ;
                const float* gate = MOD + (size_t)(3 * 4 + b) * 3072 + 2048;
                float ss = 0.f;
#pragma unroll
                for (int j = 0; j < 4; ++j) { const int d = 4 * lane + 256 * j;
                    if (MOE) { const f32x4 gt = *(const f32x4*)(gate + d); f32x4 ys;
                        ys.x = __uint_as_float(y0[k][j].x << 16) + __uint_as_float(y1[k][j].x << 16); ys.y = __uint_as_float(y0[k][j].x & 0xffff0000u) + __uint_as_float(y1[k][j].x & 0xffff0000u);
                        ys.z = __uint_as_float(y0[k][j].y << 16) + __uint_as_float(y1[k][j].y << 16); ys.w = __uint_as_float(y0[k][j].y & 0xffff0000u) + __uint_as_float(y1[k][j].y & 0xffff0000u);
                        v[k][j] += gt * ys; }
                    ss += (v[k][j].x * v[k][j].x + v[k][j].y * v[k][j].y) + (v[k][j].z * v[k][j].z + v[k][j].w * v[k][j].w); }
                const float rstd = 1.0f / sqrtf(wave_sum(ss) * (1.0f / D) + RMS_EPS);
#pragma unroll
                for (int j = 0; j < 4; ++j) { const int d = 4 * lane + 256 * j; *(f32x4*)(X + (size_t)r * D + d) = v[k][j] * rstd * *(const f32x4*)(g + d); }
            } }
    }
}

namespace pg8 {
typedef short bf16x8 __attribute__((ext_vector_type(8)));
constexpr int BM = 256, BK = 64, HALF = 128, HTB = HALF * BK * 2  , STAGE_BYTES = 8 * HTB, NXCD = 8, WGM = 8;
DEV int lds_byte(int r, int c) { const int st = (r >> 4) * 2 + (c >> 5), rr = r & 15, cc = c & 31, ob = rr * 64 + cc * 2; return st * 1024 + (ob ^ (((ob >> 9) & 1) << 5)); }
DEV void stage_rc(int b, int& R, int& C) { const int st = b / 1024, sb = b % 1024, swz = sb ^ (((sb >> 9) & 1) << 5); R = (st >> 1) * 16 + swz / 64; C = (st & 1) * 32 + (swz % 64) / 2; }
DEV int perm32(int rho) { const int n = rho >> 4, i = rho & 15; return 8 * (i >> 2) + 4 * n + (i & 3); }
struct Unit { int pm, pn; };
struct StaticOrder {
    const char* A; const char* Bt; int lda, ldb; int nM, nN, nwg, G, c;
    DEV void init(const void* A_, int lda_, const void* Bt_, int ldb_, int nM_, int nN_, int G_, int c_) { A = (const char*)A_; Bt = (const char*)Bt_; lda = lda_; ldb = ldb_; nM = nM_; nN = nN_; nwg = nM * nN; G = G_; c = c_; }
    DEV bool next(int i, Unit& u) const {
        const long L = (long)i * G + c; if (L >= nwg) return false;
        int wgid = (int)L; { const int q = nwg / NXCD, r = nwg % NXCD, xcd = wgid % NXCD, off = wgid / NXCD; wgid = (xcd < r ? xcd * (q + 1) : r * (q + 1) + (xcd - r) * q) + off; }
        const int nig = WGM * nN, gid = wgid / nig, fm = gid * WGM, gsz = (nM - fm) < WGM ? (nM - fm) : WGM;
        u.pm = fm + ((wgid % nig) % gsz); u.pn = (wgid % nig) / gsz; return true;
    }
    DEV const char* a_ptr(const Unit& u) const { return A + (size_t)u.pm * BM * lda * 2; }
    DEV const char* b_ptr(const Unit& u) const { return Bt + (size_t)u.pn * BM * ldb * 2; }
};
template <class Epi, class Sched, bool FP8 = false>
DEV void gemm_phase(LAS unsigned char* lds, const int K, const int lda, const int ldb, const Sched& S, const Epi& E) {
    const int tid = tid_fresh(), wid = __builtin_amdgcn_readfirstlane(tid >> 6), lane = tid & 63, wr = wid >> 2, wc = wid & 3, fr = lane & 15, fq = lane >> 4;
    const int nt = K / BK;
    unsigned voffA[2], voffB[2];
#pragma unroll
    for (int i = 0; i < 2; ++i) { int R, C; stage_rc(tid * 16 + i * 8192, R, C); const int Rb = (R & ~31) + perm32(R & 31);
        voffA[i] = (unsigned)(R * lda + C) * 2u; voffB[i] = (unsigned)(Rb * ldb + C) * 2u; }
    const size_t kstep = (size_t)(BK * 2);
    const size_t hstepA = (size_t)HALF * lda * 2, hstepB = (size_t)HALF * ldb * 2;
    const unsigned ldsw = (unsigned)wid * 1024u;
    const int aoff = lds_byte(wr * 64 + fr, fq * 8), boff = lds_byte(wc * 32 + fr, fq * 8);
#define PG8_SA(b, h) (((b) * 2 + (h)) * HTB)
#define PG8_SB(b, h) ((4 + (b) * 2 + (h)) * HTB)
#define PG8_STAGE(bufoff, gbase, voff) do { _Pragma("unroll") for (int _i = 0; _i < 2; ++_i) \
        __builtin_amdgcn_global_load_lds((const unsigned*)((const char*)(gbase) + (voff)[_i]), (LAS unsigned*)(lds + (bufoff) + ldsw + _i * 8192), 16, 0, 0); } while (0)
#define PG8_LD8(p_) __builtin_shufflevector(*(const LAS v4i_*)(p_), *(const LAS v4i_*)((p_) + 1024), 0, 1, 2, 3, 4, 5, 6, 7)
#define PG8_LDA(dst, b, h) do { _Pragma("unroll") for (int m = 0; m < 4; ++m) { if constexpr (FP8) dst##8[m] = PG8_LD8(lds + PG8_SA(b, h) + aoff + m * 2048); else { _Pragma("unroll") for (int k = 0; k < 2; ++k) dst[m][k] = *(const LAS bf16x8*)(lds + PG8_SA(b, h) + aoff + m * 2048 + k * 1024); } } } while (0)
#define PG8_LDB(dst, b, h) do { _Pragma("unroll") for (int n = 0; n < 2; ++n) { if constexpr (FP8) dst##8[n] = PG8_LD8(lds + PG8_SB(b, h) + boff + n * 2048); else { _Pragma("unroll") for (int k = 0; k < 2; ++k) dst[n][k] = *(const LAS bf16x8*)(lds + PG8_SB(b, h) + boff + n * 2048 + k * 1024); } } } while (0)
#define PG8_MMA(ai, bj, At, Bt) do { __builtin_amdgcn_s_setprio(1); _Pragma("unroll") for (int m = 0; m < 4; ++m) _Pragma("unroll") for (int n = 0; n < 2; ++n) { \
        if constexpr (FP8) asm volatile("v_mfma_scale_f32_16x16x128_f8f6f4 %0, %1, %2, %0, %3, %3 op_sel_hi:[0,0,0]" : "+v"(acc[ai][bj][m][n]) : "v"(Bt##8[n]), "v"(At##8[m]), "v"(one_scale));   \
        else { _Pragma("unroll") for (int k = 0; k < 2; ++k) acc[ai][bj][m][n] = __builtin_amdgcn_mfma_f32_16x16x32_bf16(Bt[n][k], At[m][k], acc[ai][bj][m][n], 0, 0, 0); } } \
        __builtin_amdgcn_s_setprio(0); } while (0)
#define PG8_WAIT_V(n) asm volatile("s_waitcnt vmcnt(" #n ")" ::: "memory")
#define PG8_WAIT_L(n) asm volatile("s_waitcnt lgkmcnt(" #n ")" ::: "memory")
#define PG8_BAR __builtin_amdgcn_s_barrier()
#define PG8_SCHED __builtin_amdgcn_sched_barrier(0)
#define PG8_PIN do { if constexpr (FP8) __builtin_amdgcn_sched_barrier(0); } while (0)
    Unit cur, nxt; int ui = 0;
    if (!S.next(0, cur)) return;
    f32x4 acc[2][2][4][2];
#pragma unroll
    for (int a = 0; a < 2; ++a)
#pragma unroll
        for (int b = 0; b < 2; ++b)
#pragma unroll
            for (int m = 0; m < 4; ++m)
#pragma unroll
                for (int n = 0; n < 2; ++n) acc[a][b][m][n] = (f32x4){0.f, 0.f, 0.f, 0.f};
    typedef int v8i_ __attribute__((ext_vector_type(8))); typedef int v4i_ __attribute__((ext_vector_type(4)));
    const int one_scale = 0x7f7f7f7f;
    bf16x8 At[4][2], B0[2][2], B1[2][2]; v8i_ At8[4], B08[2], B18[2];
    const char* cA = S.a_ptr(cur); const char* cB = S.b_ptr(cur);
    PG8_STAGE(PG8_SB(0, 0), cB, voffB); PG8_STAGE(PG8_SB(0, 1), cB + hstepB, voffB); PG8_STAGE(PG8_SA(0, 0), cA, voffA); PG8_STAGE(PG8_SA(0, 1), cA + hstepA, voffA);
    if (wr == 1) PG8_BAR;
    PG8_WAIT_V(2); PG8_BAR;
    PG8_STAGE(PG8_SB(1, 0), cB + kstep, voffB); PG8_STAGE(PG8_SA(1, 0), cA + kstep, voffA); PG8_STAGE(PG8_SB(1, 1), cB + hstepB + kstep, voffB);
    PG8_WAIT_V(6); PG8_BAR;
    for (;;) {
        const bool has_next = S.next(ui + 1, nxt);
        const char* nA = has_next ? S.a_ptr(nxt) : cA; const char* nB = has_next ? S.b_ptr(nxt) : cB;
        for (int t = 0; t < nt; t += 2) {
            const bool last = (t == nt - 2);
            const char* a1 = cA + (size_t)(t + 1) * kstep;
            const char* a2 = last ? nA : cA + (size_t)(t + 2) * kstep; const char* b2 = last ? nB : cB + (size_t)(t + 2) * kstep;
            const char* a3 = a2 + kstep; const char* b3 = b2 + kstep;
            if constexpr (Epi::NMID > 0) { if (t == Epi::MID0 || t == Epi::MID1) E.mid(acc, cur, t == Epi::MID0 ? 0 : 1, wr, wc, fr, fq); }
            PG8_LDB(B0, 0, 0); PG8_LDB(B1, 0, 1); PG8_SCHED; PG8_LDA(At, 0, 0); PG8_STAGE(PG8_SA(1, 1), a1 + hstepA, voffA);
            PG8_WAIT_V(8); PG8_WAIT_L(0); PG8_BAR; PG8_PIN; PG8_MMA(0, 0, At, B0); PG8_MMA(0, 1, At, B1); PG8_PIN; PG8_BAR; PG8_SCHED;
            PG8_LDA(At, 0, 1); PG8_STAGE(PG8_SB(0, 0), b2, voffB); PG8_STAGE(PG8_SB(0, 1), b2 + hstepB, voffB); PG8_STAGE(PG8_SA(0, 0), a2, voffA);
            PG8_WAIT_V(8); PG8_WAIT_L(0); PG8_BAR; PG8_PIN; PG8_MMA(1, 0, At, B0); PG8_MMA(1, 1, At, B1); PG8_PIN; PG8_BAR; PG8_SCHED;
            PG8_LDB(B0, 1, 0); PG8_LDB(B1, 1, 1); PG8_SCHED; PG8_LDA(At, 1, 0); PG8_STAGE(PG8_SA(0, 1), a2 + hstepA, voffA);
            PG8_WAIT_V(8); PG8_WAIT_L(0); PG8_BAR; PG8_PIN; PG8_MMA(0, 0, At, B0); PG8_MMA(0, 1, At, B1); PG8_PIN; PG8_BAR; PG8_SCHED;
            PG8_LDA(At, 1, 1); PG8_STAGE(PG8_SB(1, 0), b3, voffB); PG8_STAGE(PG8_SB(1, 1), b3 + hstepB, voffB); PG8_STAGE(PG8_SA(1, 0), a3, voffA);
            PG8_WAIT_V(8); PG8_WAIT_L(0); PG8_BAR; PG8_PIN; PG8_MMA(1, 0, At, B0); PG8_MMA(1, 1, At, B1); PG8_PIN; PG8_BAR; PG8_SCHED;
        }
        if (wr == 0) PG8_BAR;
        E(acc, cur, wr, wc, fr, fq);
        if (!has_next) break;
#pragma unroll
        for (int a = 0; a < 2; ++a)
#pragma unroll
            for (int b = 0; b < 2; ++b)
#pragma unroll
                for (int m = 0; m < 4; ++m)
#pragma unroll
                    for (int n = 0; n < 2; ++n) acc[a][b][m][n] = (f32x4){0.f, 0.f, 0.f, 0.f};
        cur = nxt; cA = nA; cB = nB; ++ui;
        if (wr == 1) PG8_BAR;
    }
    PG8_WAIT_V(0);
    PG8_BAR;
#undef PG8_SA
#undef PG8_SB
#undef PG8_STAGE
#undef PG8_LDA
#undef PG8_LD8
#undef PG8_LDB
#undef PG8_MMA
#undef PG8_WAIT_V
#undef PG8_WAIT_L
#undef PG8_BAR
#undef PG8_SCHED
#undef PG8_PIN
}
}

typedef f32x4 Acc[2][2][4][2];
DEV unsigned cvt_pk_bf16(float lo, float hi) { unsigned r; asm volatile("v_cvt_pk_bf16_f32 %0, %1, %2" : "=v"(r) : "v"(lo), "v"(hi)); return r; }
DEV float fsig(float x) { return __builtin_amdgcn_rcpf(1.0f + __builtin_amdgcn_exp2f(-1.44269504f * x)); }
DEV u32x4 pack8(const f32x4& a, const f32x4& b) { u32x4 w; w.x = cvt_pk_bf16(a.x, a.y); w.y = cvt_pk_bf16(a.z, a.w); w.z = cvt_pk_bf16(b.x, b.y); w.w = cvt_pk_bf16(b.z, b.w); return w; }
struct EpiZ { unsigned char* ws;
    static constexpr int NMID = 0, MID0 = -1, MID1 = -1;
    DEV void operator()(const Acc& acc, const pg8::Unit& u, int wr, int wc, int fr, int fq) const {
        bf16* base; int ld, colt; bool sig = false;
        if (u.pn < 7) { base = (bf16*)(ws + WS_ZR); ld = ZR_W; colt = u.pn * 256; }
        else if (u.pn < 19) { base = (bf16*)(ws + WS_ZG); ld = ZG_W; colt = (u.pn - 7) * 256; sig = true; }
        else if (u.pn == 19) { base = (bf16*)(ws + WS_ZP); ld = ZP_W; colt = 0; }
        else { base = (bf16*)(ws + WS_ZC); ld = ZC_W; colt = (u.pn - 20) * 256; }
        const int row0 = u.pm * 256 + wr * 64 + fr, col0 = colt + wc * 32 + 8 * fq;
#pragma unroll
        for (int ai = 0; ai < 2; ++ai)
#pragma unroll
            for (int m = 0; m < 4; ++m) { bf16* rowp = base + (size_t)(row0 + ai * 128 + m * 16) * ld + col0;
#pragma unroll
                for (int bj = 0; bj < 2; ++bj) { f32x4 v0 = acc[ai][bj][m][0], v1 = acc[ai][bj][m][1];
                    if (sig) {
#pragma unroll
                        for (int e = 0; e < 4; ++e) { v0[e] = fsig(v0[e]); v1[e] = fsig(v1[e]); } }
                    *(u32x4*)(rowp + bj * 128) = pack8(v0, v1); } }
    } };
struct EpiMix { const bf16* Zg; bf16* O;
    static constexpr int NMID = 2, MID0 = 4, MID1 = 8;
    DEV void mid(Acc& acc, const pg8::Unit& u, int seg, int wr, int wc, int fr, int fq) const {
        const int row0 = u.pm * 256 + wr * 64 + fr, col0 = u.pn * 256 + wc * 32 + 8 * fq;
        const bf16* gp = Zg + (size_t)row0 * ZG_W + seg * 1024 + col0;
#pragma unroll
        for (int ai = 0; ai < 2; ++ai) {
            u32x4 nv[4][2], dv[4][2];
#pragma unroll
            for (int m = 0; m < 4; ++m) { const bf16* q = gp + (size_t)(ai * 128 + m * 16) * ZG_W;
#pragma unroll
                for (int bj = 0; bj < 2; ++bj) { nv[m][bj] = *(const u32x4*)(q + bj * 128); dv[m][bj] = *(const u32x4*)(q + 1024 + bj * 128); } }
#pragma unroll
            for (int m = 0; m < 4; ++m)
#pragma unroll
                for (int bj = 0; bj < 2; ++bj) { f32x4 n0, n1, d0, d1; unpack8(nv[m][bj], n0, n1); unpack8(dv[m][bj], d0, d1);
#pragma unroll
                    for (int e = 0; e < 4; ++e) { acc[ai][bj][m][0][e] *= n0[e] * __builtin_amdgcn_rcpf(d0[e]); acc[ai][bj][m][1][e] *= n1[e] * __builtin_amdgcn_rcpf(d1[e]); } }
            asm volatile("" ::: "memory");
        }
    }
    DEV void operator()(const Acc& acc, const pg8::Unit& u, int wr, int wc, int fr, int fq) const {
        const int row0 = u.pm * 256 + wr * 64 + fr, col0 = u.pn * 256 + wc * 32 + 8 * fq;
#pragma unroll
        for (int ai = 0; ai < 2; ++ai) {
            u32x4 gv[4][2];
#pragma unroll
            for (int m = 0; m < 4; ++m)
#pragma unroll
                for (int bj = 0; bj < 2; ++bj) gv[m][bj] = *(const u32x4*)(Zg + (size_t)(row0 + ai * 128 + m * 16) * ZG_W + 2048 + col0 + bj * 128);
#pragma unroll
            for (int m = 0; m < 4; ++m)
#pragma unroll
                for (int bj = 0; bj < 2; ++bj) { f32x4 g0, g1; unpack8(gv[m][bj], g0, g1);
                    *(u32x4*)(O + (size_t)(row0 + ai * 128 + m * 16) * D + col0 + bj * 128) = pack8(acc[ai][bj][m][0] * g0, acc[ai][bj][m][1] * g1); }
            asm volatile("" ::: "memory");
        }
    } };
struct EpiRes { const float* xin; float* xout; const float* gate;
    static constexpr int NMID = 0, MID0 = -1, MID1 = -1;
    DEV void operator()(const Acc& acc, const pg8::Unit& u, int wr, int wc, int fr, int fq) const {
        const int row0 = u.pm * 256 + wr * 64 + fr, col0 = u.pn * 256 + wc * 32 + 8 * fq;
        const float* g = gate + (size_t)(u.pm >> 4) * 3072 + col0;
        f32x4 gv[2][2];
#pragma unroll
        for (int bj = 0; bj < 2; ++bj)
#pragma unroll
            for (int n = 0; n < 2; ++n) gv[bj][n] = *(const f32x4*)(g + bj * 128 + 4 * n);
#pragma unroll
        for (int ai = 0; ai < 2; ++ai)
#pragma unroll
            for (int m = 0; m < 4; ++m) { const size_t off = (size_t)(row0 + ai * 128 + m * 16) * D + col0;
#pragma unroll
                for (int bj = 0; bj < 2; ++bj)
#pragma unroll
                    for (int n = 0; n < 2; ++n) { const f32x4 x = *(const f32x4*)(xin + off + bj * 128 + 4 * n); *(f32x4*)(xout + off + bj * 128 + 4 * n) = x + gv[bj][n] * acc[ai][bj][m][n]; }
                if (m == 3) asm volatile("" ::: "memory"); }
    } };
struct EpiSwi { bf16* O; int ldo, row_shift;
    static constexpr int NMID = 0, MID0 = -1, MID1 = -1;
    DEV void operator()(const Acc& acc, const pg8::Unit& u, int wr, int wc, int fr, int fq) const {
        const int row0 = u.pm * 256 - row_shift + wr * 64 + fr, col0 = u.pn * 128 + wc * 32 + 8 * fq;
#pragma unroll
        for (int ai = 0; ai < 2; ++ai)
#pragma unroll
            for (int m = 0; m < 4; ++m) { f32x4 h0, h1;
#pragma unroll
                for (int e = 0; e < 4; ++e) { const float a = acc[ai][0][m][0][e], b = acc[ai][0][m][1][e]; h0[e] = a * fsig(a) * acc[ai][1][m][0][e]; h1[e] = b * fsig(b) * acc[ai][1][m][1][e]; }
                *(u32x4*)(O + (size_t)(row0 + ai * 128 + m * 16) * ldo + col0) = pack8(h0, h1); }
    } };
struct EpiSwi8 { unsigned char* O; int ldo;
    static constexpr int NMID = 0, MID0 = -1, MID1 = -1;
    DEV void operator()(const Acc& acc, const pg8::Unit& u, int wr, int wc, int fr, int fq) const {
        const int row0 = u.pm * 256 + wr * 64 + fr, col0 = u.pn * 128 + wc * 32 + 8 * fq;
#pragma unroll
        for (int ai = 0; ai < 2; ++ai)
#pragma unroll
            for (int m = 0; m < 4; ++m) { f32x4 h0, h1;
#pragma unroll
                for (int e = 0; e < 4; ++e) { const float a = acc[ai][0][m][0][e] * (1.0f / 32.0f), b = acc[ai][0][m][1][e] * (1.0f / 32.0f);
                    h0[e] = a * fsig(a) * acc[ai][1][m][0][e] * (4.0f / 32.0f); h1[e] = b * fsig(b) * acc[ai][1][m][1][e] * (4.0f / 32.0f); }
                u32x2 o; o.x = pk4_fp8(h0[0], h0[1], h0[2], h0[3]); o.y = pk4_fp8(h1[0], h1[1], h1[2], h1[3]);
                *(u32x2*)(O + (size_t)(row0 + ai * 128 + m * 16) * ldo + col0) = o; }
    } };
struct EpiMoeDown { bf16* Y; const int* rowtk; const float* roww;
    static constexpr int NMID = 0, MID0 = -1, MID1 = -1;
    DEV void operator()(const Acc& acc, const pg8::Unit& u, int wr, int wc, int fr, int fq) const {
        const int row0 = u.pm * 256 + wr * 64 + fr, col0 = u.pn * 256 + wc * 32 + 8 * fq;
#pragma unroll
        for (int ai = 0; ai < 2; ++ai)
#pragma unroll
            for (int m = 0; m < 4; ++m) { const int r = row0 + ai * 128 + m * 16; const int tk = rowtk[r]; const float w = roww[r] * (1.0f / 256.0f);
                if (tk >= 0) { bf16* yp = Y + ((size_t)(tk & 1) * T + (size_t)(tk >> 1)) * D + col0;
#pragma unroll
                    for (int bj = 0; bj < 2; ++bj) *(u32x4*)(yp + bj * 128) = pack8(acc[ai][bj][m][0] * w, acc[ai][bj][m][1] * w); } }
    } };
constexpr int MOE_NG = 1;
struct MoeOrder {
    const char* A; const char* Bt; int lda, ldb; size_t estride; int t0, ashift, nM, nN, nwg, G, c; int toff[9];
    DEV void init(const void* A_, int lda_, const void* Bt_, int ldb_, size_t estride_, const unsigned* cnt, int grp, int rel, int nN_, int G_, int c_) {
        A = (const char*)A_; Bt = (const char*)Bt_; lda = lda_; ldb = ldb_; estride = estride_; nN = nN_; G = G_; c = c_;
        int s = 0;
#pragma unroll
        for (int e = 0; e < 8; ++e) { toff[e] = s; s += ((int)cnt[e * 32] + 255) >> 8; }
        toff[8] = s;
        const int per = (s + MOE_NG - 1) / MOE_NG; t0 = grp * per; int t1 = t0 + per; if (t1 > s) t1 = s; if (t0 > s) t0 = s; nM = t1 - t0; nwg = nM * nN; ashift = rel ? t0 : 0;
    }
    DEV bool next(int i, pg8::Unit& u) const {
        const long L = (long)i * G + c; if (L >= nwg) return false;
        int wgid = (int)L; { const int q = nwg / 8, r = nwg % 8, xcd = wgid % 8, off = wgid / 8; wgid = (xcd < r ? xcd * (q + 1) : r * (q + 1) + (xcd - r) * q) + off; }
        const int nig = 8 * nN, gid = wgid / nig, fm = gid * 8, gsz = (nM - fm) < 8 ? (nM - fm) : 8;
        u.pm = t0 + fm + ((wgid % nig) % gsz); u.pn = (wgid % nig) / gsz; return true;
    }
    DEV int expert(int pm) const { int e = 0;
#pragma unroll
        for (int q = 1; q < 8; ++q) e += (pm >= toff[q]) ? 1 : 0;
        return e; }
    DEV const char* a_ptr(const pg8::Unit& u) const { return A + (size_t)(u.pm - ashift) * 256 * lda * 2; }
    DEV const char* b_ptr(const pg8::Unit& u) const { return Bt + (size_t)expert(u.pm) * estride + (size_t)u.pn * 256 * ldb * 2; }
};

struct CvJob { const float* W; const float* W2; bf16* WT; int kind, ld, ldt, nnb; float f8;  };
DEV f32x4 cv_ld4(const CvJob& j, int k, int n) {
    const f32x4 z = (f32x4){0.f, 0.f, 0.f, 0.f};
    if (j.kind == 0) return *(const f32x4*)(j.W + (size_t)k * j.ld + n);
    if (j.kind == 2) { const int pn = n >> 8, c = n & 255; const float* W = j.W + (ptrdiff_t)(c >> 7) * (j.W2 - j.W); return *(const f32x4*)(W + (size_t)k * j.ld + pn * 128 + (c & 127)); }
    if (n < 1664) return *(const f32x4*)(j.W + (size_t)k * IN_COLS + OFF_RWKV + n);
    if (n < 1680) return j.W2 ? *(const f32x4*)(j.W2 + (size_t)k * 16 + (n - 1664)) : z;
    if (n < 1792) return z;
    if (n < 4864) return *(const f32x4*)(j.W + (size_t)k * IN_COLS + OFF_GATE + (n - 1792));
    if (n < 5120) return *(const f32x4*)(j.W + (size_t)k * IN_COLS + (n - 4864));
    return *(const f32x4*)(j.W + (size_t)k * IN_COLS + OFF_CONV + (n - 5120));
}
DEV void tr_load(const CvJob& j, int r, int lane, f32x4 (&v)[8]) {
    const int k0 = (r / j.nnb) * 64, n0 = (r % j.nnb) * 32, kr = lane >> 3, c4 = (lane & 7) * 4;
#pragma unroll
    for (int i = 0; i < 8; ++i) v[i] = cv_ld4(j, k0 + i * 8 + kr, n0 + c4);
}
DEV void tr_store(const f32x4 (&v)[8], const CvJob& j, int r, LAS float* scr, int lane) {
    const int k0 = (r / j.nnb) * 64, n0 = (r % j.nnb) * 32, kr = lane >> 3, c4 = (lane & 7) * 4;
#pragma unroll
    for (int i = 0; i < 8; ++i) { LAS float* s = scr + (i * 8 + kr) * 33 + c4; s[0] = v[i].x; s[1] = v[i].y; s[2] = v[i].z; s[3] = v[i].w; }
    asm volatile("s_waitcnt lgkmcnt(0)" ::: "memory");
    const int c = lane & 7;
#pragma unroll
    for (int jj = 0; jj < 4; ++jj) { const int n = (lane >> 3) + 8 * jj; const LAS float* s = scr + (8 * c) * 33 + n;
        if (j.f8 != 0.f) { const float f = j.f8; u32x2 o; o.x = pk4_fp8(f * s[0 * 33], f * s[1 * 33], f * s[2 * 33], f * s[3 * 33]); o.y = pk4_fp8(f * s[4 * 33], f * s[5 * 33], f * s[6 * 33], f * s[7 * 33]);
            *(u32x2*)((unsigned char*)j.WT + (size_t)(n0 + n) * j.ldt + k0 + 8 * c) = o; }
        else { u32x4 o; o.x = pk2(s[0 * 33], s[1 * 33]); o.y = pk2(s[2 * 33], s[3 * 33]); o.z = pk2(s[4 * 33], s[5 * 33]); o.w = pk2(s[6 * 33], s[7 * 33]);
            *(u32x4*)(j.WT + (size_t)(n0 + n) * j.ldt + k0 + 8 * c) = o; } }
    asm volatile("s_waitcnt lgkmcnt(0)" ::: "memory");
}
template <class Dec>
DEV void tr_run(const Dec& dec, int total, LAS float* scr, int gw, int ngw, int lane) {
    f32x4 va[8], vb[8]; CvJob ja, jb; int ra = 0, rb = 0;
    int it = gw;
    if (it < total) { dec(it, ja, ra); tr_load(ja, ra, lane, va); }
    for (; it < total; it += 2 * ngw) {
        const int i2 = it + ngw, i3 = it + 2 * ngw;
        if (i2 < total) { dec(i2, jb, rb); tr_load(jb, rb, lane, vb); }
        tr_store(va, ja, ra, scr, lane);
        if (i3 < total) { dec(i3, ja, ra); tr_load(ja, ra, lane, va); }
        if (i2 < total) tr_store(vb, jb, rb, scr, lane);
    }
}
struct DecPro { const Params* p;
    DEV void operator()(int it, CvJob& j, int& r) const {
        const Params& P = *p;
        if (it < 2 * 3712) { const int l = it / 3712; r = it % 3712;
            bf16* WmixT = (bf16*)(P.ws + WS_WMIX) + (size_t)l * D * D;
            if (r < 2816) { j = CvJob{P.in[5] + (size_t)l * D * IN_COLS, l ? P.in[26] : nullptr, (bf16*)(P.ws + WS_WIN) + (size_t)l * ZN * D, 1, IN_COLS, D, ZN / 32, 0.f}; return; }
            r -= 2816; if (r < 128) { j = CvJob{P.in[13] + (size_t)l * 256 * D, nullptr, WmixT + 256, 0, D, D, D / 32, 0.f}; return; }
            r -= 128; if (r < 256) { j = CvJob{P.in[25] + (size_t)l * 512 * D, nullptr, WmixT + 512, 0, D, D, D / 32, 0.f}; return; }
            r -= 256; j = CvJob{P.in[30] + (size_t)l * D * D, nullptr, (bf16*)(P.ws + WS_WO) + (size_t)l * D * D, 0, D, D, D / 32, 0.f}; return; }
        r = it - 2 * 3712;
        if (r < 2816) { j = CvJob{P.in[31], P.in[32], (bf16*)(P.ws + WS_W13), 2, DFF, D, 2 * DFF / 32, 0.f}; return; }
        r -= 2816; j = CvJob{P.in[33], nullptr, (bf16*)(P.ws + WS_W2), 0, D, DFF, D / 32, 0.f};
    } };
struct DecMoe { const Params* p;
    DEV void operator()(int it, CvJob& j, int& r) const {
        const Params& P = *p; const int e = it / 5376; r = it % 5376;
        if (r < 3584) { j = CvJob{P.in[35] + (size_t)e * D * DFE, P.in[36] + (size_t)e * D * DFE, (bf16*)(P.ws + WS_MW13 + (size_t)e * 2 * DFE * D), 2, DFE, D, 2 * DFE / 32, 32.0f}; return; }
        r -= 3584; j = CvJob{P.in[37] + (size_t)e * DFE * D, nullptr, (bf16*)(P.ws + WS_MW2 + (size_t)e * D * DFE), 0, D, DFE, D / 32, 64.0f};
    } };
DEV void convert_phase(const Params& p, LAS unsigned char* lds) {
    const int tid = tid_fresh(), lane = tid & 63, wv = __builtin_amdgcn_readfirstlane(tid >> 6);
    LAS float* scr = (LAS float*)(lds + 32768 + wv * 8704);
    const int gw = blockIdx.x * 8 + wv, ngw = gridDim.x * 8;
    for (int l = 0; l < NL; ++l) {
        bf16* WmixT = (bf16*)(p.ws + WS_WMIX) + (size_t)l * D * D;
        const float* pw = p.in[6] + (size_t)l * 4 * 64 * 64; const float* ps = p.in[7] + l * 256; const float* pp = p.in[8] + (size_t)l * 256 * D;
        for (int it = gw; it < 32 * 16; it += ngw) {
            const int k8 = it >> 4, n = (it & 15) * 64 + lane, g = k8 >> 3;
            float a[8];
#pragma unroll
            for (int e = 0; e < 8; ++e) a[e] = 0.f;
#pragma unroll 8
            for (int d = 0; d < 64; ++d) { const float pv = pp[(size_t)(g * 64 + d) * D + n] * ps[g * 64 + d];
#pragma unroll
                for (int e = 0; e < 8; ++e) a[e] += pw[(size_t)(k8 * 8 + e) * 64 + d] * pv; }
            u32x4 o; o.x = pk2(a[0], a[1]); o.y = pk2(a[2], a[3]); o.z = pk2(a[4], a[5]); o.w = pk2(a[6], a[7]);
            *(u32x4*)(WmixT + (size_t)n * D + k8 * 8) = o;
        }
    }
    for (int it = gw; it < 2 * 8 * 2 * 2 * 5; it += ngw) {
        const int kind = it % 5, hf = (it / 5) & 1, q = (it / 10) & 1, hh = (it / 20) & 7, l = it / 160, fr = lane & 15, fq = lane >> 4;
        const int ch = hh * 64 + q * 32 + (fr >> 2) * 8 + hf * 4 + (fr & 3);
        float t8[8];
#pragma unroll
        for (int e = 0; e < 8; ++e) { const int k = 8 * fq + e;
            t8[e] = kind == 0 ? p.in[16][(size_t)(l * 32 + k) * 512 + ch] : kind == 1 ? p.in[18][(size_t)(l * 32 + k) * 512 + ch] : kind == 2 ? p.in[19][(size_t)(l * 64 + k) * 512 + ch]
                  : kind == 3 ? p.in[19][(size_t)(l * 64 + 32 + k) * 512 + ch] : ((l && k < 16) ? p.in[29][(size_t)k * 512 + ch] : 0.f); }
        u32x4 o; o.x = pk2(t8[0], t8[1]); o.y = pk2(t8[2], t8[3]); o.z = pk2(t8[4], t8[5]); o.w = pk2(t8[6], t8[7]);
        *(u32x4*)((bf16*)(p.ws + WS_LORA) + ((size_t)it * 64 + lane) * 8) = o;
    }
    tr_run(DecPro{&p}, 2 * 3712 + 2816 + 1408, scr, gw, ngw, lane);
}
DEV void convert_moe_phase(const Params& p, LAS unsigned char* lds) {
    const int tid = tid_fresh(), lane = tid & 63, wv = __builtin_amdgcn_readfirstlane(tid >> 6);
    LAS float* scr = (LAS float*)(lds + 32768 + wv * 8704);
    tr_run(DecMoe{&p}, NE * 5376, scr, blockIdx.x * 8 + wv, gridDim.x * 8, lane);
}
DEV void dispatch_phase(const Params& p) {
    const int tid = tid_fresh(), lane = tid & 63, wv = tid >> 6;
    const unsigned* cnt = (const unsigned*)(p.ws + WS_CTL);
    const int* LT = (const int*)(p.ws + WS_LTOK); const float* LW = (const float*)(p.ws + WS_LW);
    int* RT = (int*)(p.ws + WS_ROWTK); float* RW_ = (float*)(p.ws + WS_ROWW);
    const bf16* H = (const bf16*)(p.ws + WS_H); bf16* Hs = (bf16*)(p.ws + WS_HS);
    int off[9]; { int s = 0;
#pragma unroll
        for (int e = 0; e < 8; ++e) { off[e] = s; s += (((int)cnt[e * 32] + 255) >> 8) << 8; } off[8] = s; }
    const int nw = gridDim.x * 8;
    for (int row0 = blockIdx.x * 8 + wv; row0 < off[8]; row0 += 4 * nw) {
        int tk[4]; float w[4]; u32x4 v0[4], v1[4];
#pragma unroll
        for (int k = 0; k < 4; ++k) { const int row = row0 + k * nw; tk[k] = -1; w[k] = 0.f;
            if (row < off[8]) { int e = 0;
#pragma unroll
                for (int q = 1; q < 8; ++q) e += (row >= off[q]) ? 1 : 0;
                const int idx = row - off[e];
                if (idx < (int)cnt[e * 32]) { tk[k] = LT[e * T + idx]; w[k] = LW[e * T + idx]; } } }
#pragma unroll
        for (int k = 0; k < 4; ++k) { v0[k] = (u32x4){0u, 0u, 0u, 0u}; v1[k] = v0[k];
            if (tk[k] >= 0) { const bf16* hr = H + (size_t)(tk[k] >> 1) * D; v0[k] = *(const u32x4*)(hr + lane * 16); v1[k] = *(const u32x4*)(hr + lane * 16 + 8); } }
#pragma unroll
        for (int k = 0; k < 4; ++k) { const int row = row0 + k * nw;
            if (row < off[8]) { f32x4 a0, a1, b0, b1; unpack8(v0[k], a0, a1); unpack8(v1[k], b0, b1);
                u32x4 o; o.x = pk4_fp8(a0[0], a0[1], a0[2], a0[3]); o.y = pk4_fp8(a1[0], a1[1], a1[2], a1[3]); o.z = pk4_fp8(b0[0], b0[1], b0[2], b0[3]); o.w = pk4_fp8(b1[0], b1[1], b1[2], b1[3]);
                *(u32x4*)((unsigned char*)Hs + (size_t)row * D + lane * 16) = o;
                if (lane == 0) { RT[row] = tk[k]; RW_[row] = w[k]; } } }
    }
}

#define XB_TMO      128
#define XB_XCNT(j)  (256  + 64 * (j))
#define XB_XSUB(j)  (1280 + 64 * (j))
#define XB_XGEN(j)  (2304 + 64 * (j))
#define XB_TOP      3328
#define XB_TOPGEN   3392
#define XCD_BAR_WORDS 3456
#define XB_SPIN_CAP (1u << 18)
__device__ __forceinline__ unsigned xb_ld(unsigned* p)              { return __hip_atomic_load(p, __ATOMIC_RELAXED, __HIP_MEMORY_SCOPE_AGENT); }
__device__ __forceinline__ unsigned xb_add(unsigned* p, unsigned v) { return __hip_atomic_fetch_add(p, v, __ATOMIC_RELAXED, __HIP_MEMORY_SCOPE_AGENT); }
__device__ __forceinline__ unsigned xb_xcc_id() { return (unsigned)__builtin_amdgcn_s_getreg((3 << 11) | 20) & 0xFu; }
#define XB_SPIN(cond, bar) do { unsigned _sp = 0; while (cond) { __builtin_amdgcn_s_sleep(1); \
    if ((++_sp & 255u) == 0u) { if (xb_ld(&(bar)[XB_TMO])) break; if (_sp > XB_SPIN_CAP) { atomicAdd(&(bar)[XB_TMO], 1u); break; } } } } while (0)
struct XcdBarrier { unsigned* bar; unsigned x; volatile LAS unsigned* st; };
__device__ __forceinline__ XcdBarrier xcd_barrier_post(unsigned* bar, volatile LAS unsigned* st) {
    XcdBarrier b; b.bar = bar; b.x = xb_xcc_id(); b.st = st;
    if (threadIdx.x == 0) (void)xb_add(&bar[XB_XCNT(b.x)], 1u);
    return b;
}
__device__ __forceinline__ void xcd_barrier_complete(unsigned* bar, unsigned x, unsigned& nloc, unsigned& nx) {
    const unsigned G = gridDim.x * gridDim.y * gridDim.z;
    unsigned sum, cnt, mine, sp = 0u;
    for (;;) {
        sum = 0u; cnt = 0u; mine = 0u;
#pragma unroll
        for (unsigned j = 0; j < 16; ++j) { const unsigned c = xb_ld(&bar[XB_XCNT(j)]); sum += c; cnt += (c > 0u) ? 1u : 0u; mine = (j == x) ? c : mine; }
        if (sum == G) break;
        __builtin_amdgcn_s_sleep(1);
        if ((++sp & 255u) == 0u) { if (xb_ld(&bar[XB_TMO])) break; if (sp > XB_SPIN_CAP) { atomicAdd(&bar[XB_TMO], 1u); break; } }
    }
    nloc = mine > 0u ? mine : 1u; nx = cnt > 0u ? cnt : 1u;
}
__device__ __forceinline__ void xcd_barrier(const XcdBarrier& b) {
    asm volatile("s_waitcnt vmcnt(0)" ::: "memory");
    __syncthreads();
    if (threadIdx.x == 0) {
        unsigned* bar = b.bar;
        __builtin_amdgcn_s_waitcnt(0);
        unsigned nloc = b.st[0], nx = b.st[1];
        if (nloc == 0u) { xcd_barrier_complete(bar, b.x, nloc, nx); b.st[0] = nloc; b.st[1] = nx; }
        const unsigned old = xb_add(&bar[XB_XSUB(b.x)], 1u);
        const unsigned gen = old / nloc;
        if (old + 1u == (gen + 1u) * nloc) {
            __builtin_amdgcn_fence(__ATOMIC_RELEASE, "agent");
            asm volatile("s_waitcnt vmcnt(0)" ::: "memory");
            const unsigned og = xb_add(&bar[XB_TOP], 1u);
            const unsigned tg = og / nx;
            if (og + 1u == (tg + 1u) * nx) xb_add(&bar[XB_TOPGEN], 1u);
            else XB_SPIN(xb_ld(&bar[XB_TOPGEN]) == tg, bar);
            __builtin_amdgcn_fence(__ATOMIC_ACQUIRE, "agent");
            xb_add(&bar[XB_XGEN(b.x)], 1u);
            asm volatile("s_waitcnt vmcnt(0)" ::: "memory");
        } else {
            XB_SPIN(xb_ld(&bar[XB_XGEN(b.x)]) == gen, bar);
            __builtin_amdgcn_fence(__ATOMIC_ACQUIRE, "agent");
            asm volatile("s_waitcnt vmcnt(0)" ::: "memory");
        }
    }
    __syncthreads();
}

constexpr int LDS_BYTES = 147456;
constexpr int MISC_OFF = 131072 + 320;
constexpr int NPH = 29;
__global__ void __launch_bounds__(512, 2) fwd(const Params p, const int lo, const int hi) {
    extern __shared__ __attribute__((aligned(16))) unsigned char lds_[];
    LAS unsigned char* lds = (LAS unsigned char*)lds_;
    volatile LAS unsigned* MISC = (volatile LAS unsigned*)(lds + MISC_OFF);
    for (int u = threadIdx.x; u < (LDS_BYTES - 131072) / 4; u += 512) ((LAS unsigned*)(lds + 131072))[u] = 0u;
    __syncthreads();
    unsigned* ctl = (unsigned*)(p.ws + WS_CTL);
    XcdBarrier bar; bar.bar = ctl + 1024; bar.x = 0; bar.st = nullptr;
    if (hi - lo > 1) bar = xcd_barrier_post(ctl + 1024, MISC + 8);
#ifndef ENMASK
#define ENMASK 0xFFFFFFFFu
#endif
#define EN(x) (((ENMASK) >> (x)) & 1u)
#define IN(k) (lo <= (k) && (k) < hi)
#define SEAM(k) do { if (IN(k) && IN((k) + 1)) xcd_barrier(bar); } while (0)
#ifndef PROF_SEL
#define PROF_SEL -1
#endif
    volatile LAS unsigned long long* pfw = (volatile LAS unsigned long long*)(lds + MISC_OFF + 64);
#define TICK(ty) do { if (PROF_SEL >= 0 && blockIdx.x == 0 && threadIdx.x == 0) { const unsigned long long now_ = __builtin_amdgcn_s_memrealtime(); if ((ty) == PROF_SEL) pfw[1] = pfw[1] + (now_ - pfw[0]); pfw[0] = now_; } } while (0)
    TICK(-2);
    const int G = gridDim.x, bx = blockIdx.x;
    float* X = p.out;
    const float* MOD = (const float*)(p.ws + WS_MOD);
    bf16* H = (bf16*)(p.ws + WS_H); bf16* U = (bf16*)(p.ws + WS_U); bf16* MRG = (bf16*)(p.ws + WS_MRG);

    if (EN(0) && IN(0)) { mod_phase(p, lds); convert_phase(p, lds); }
    SEAM(0); TICK(0);
    for (int l = 0; l < NL; ++l) {
        const int pb = 1 + l * 11;
        const float* xin = l == 0 ? p.in[0] : X;
        if (EN(1) && IN(pb + 0)) norm_phase<false>(p, l * 2, xin, lds);
        SEAM(pb + 0); TICK(1);
        if (EN(2) && IN(pb + 1)) {
            pg8::StaticOrder S; S.init(H, D, (const bf16*)(p.ws + WS_WIN) + (size_t)l * ZN * D, D, T / 256, ZN / 256, G, bx);
            pg8::gemm_phase(lds, D, D, D, S, EpiZ{p.ws});
        }
        SEAM(pb + 1); TICK(2);
        if (EN(3) && IN(pb + 2)) mixer_phase(p, l, lds);
        SEAM(pb + 2); TICK(3);
        if (EN(4) && IN(pb + 3)) scan_pass1(p, lds);
        SEAM(pb + 3); TICK(4);
        if (EN(5) && IN(pb + 4)) scan_carry(p, lds);
        SEAM(pb + 4); TICK(5);
        if (EN(6) && IN(pb + 5)) scan_pass2(p, l, lds);
        SEAM(pb + 5); TICK(6);
        if (EN(7) && IN(pb + 6)) {
            pg8::StaticOrder S; S.init(U, D, (const bf16*)(p.ws + WS_WMIX) + (size_t)l * D * D, D, T / 256, D / 256, G, bx);
            pg8::gemm_phase(lds, D, D, D, S, EpiMix{(const bf16*)(p.ws + WS_ZG), MRG});
        }
        SEAM(pb + 6); TICK(7);
        if (EN(8) && IN(pb + 7)) {
            pg8::StaticOrder S; S.init(MRG, D, (const bf16*)(p.ws + WS_WO) + (size_t)l * D * D, D, T / 256, D / 256, G, bx);
            pg8::gemm_phase(lds, D, D, D, S, EpiRes{xin, X, MOD + (size_t)((l * 2) * 4) * 3072 + 2048});
        }
        SEAM(pb + 7); TICK(8);
        if (l == 0) {
            if (EN(9) && IN(9)) norm_phase<false>(p, 1, X, lds);
            SEAM(9); TICK(9);
            if (EN(10) && IN(10)) {
                pg8::StaticOrder S; S.init(H, D, (const bf16*)(p.ws + WS_W13), D, T / 256, 2 * DFF / 256, G, bx);
                pg8::gemm_phase(lds, D, D, D, S, EpiSwi{(bf16*)(p.ws + WS_HID), DFF, 0});
            }
            SEAM(10); TICK(10);
            if (EN(11) && IN(11)) {
                pg8::StaticOrder S; S.init((const bf16*)(p.ws + WS_HID), DFF, (const bf16*)(p.ws + WS_W2), DFF, T / 256, D / 256, G, bx);
                pg8::gemm_phase(lds, DFF, DFF, DFF, S, EpiRes{X, X, MOD + (size_t)(1 * 4) * 3072 + 2048});
            }
            SEAM(11); TICK(11);
        } else {
            if (EN(12) && IN(20)) { norm_phase<true>(p, 3, X, lds); TICK(17); convert_moe_phase(p, lds); }
            SEAM(20); TICK(12);
            if (EN(13) && IN(21)) dispatch_phase(p);
            SEAM(21); TICK(13);
            const unsigned* cnt = (const unsigned*)(p.ws + WS_CTL);
            for (int g = 0; g < MOE_NG; ++g) {
                if (EN(14) && IN(22 + 2 * g)) {
                    MoeOrder S; S.init(p.ws + WS_HS, D / 2, p.ws + WS_MW13, D / 2, (size_t)2 * DFE * D, cnt, g, 0, 2 * DFE / 256, G, bx);
                    pg8::gemm_phase<EpiSwi8, MoeOrder, true>(lds, D / 2, D / 2, D / 2, S, EpiSwi8{p.ws + WS_EH, DFE});
                }
                SEAM(22 + 2 * g); TICK(14);
                if (EN(15) && IN(23 + 2 * g)) {
                    MoeOrder S; S.init(p.ws + WS_EH, DFE / 2, p.ws + WS_MW2, DFE / 2, (size_t)D * DFE, cnt, g, 1, D / 256, G, bx);
                    pg8::gemm_phase<EpiMoeDown, MoeOrder, true>(lds, DFE / 2, DFE / 2, DFE / 2, S, EpiMoeDown{(bf16*)(p.ws + WS_Y), (const int*)(p.ws + WS_ROWTK), (const float*)(p.ws + WS_ROWW)});
                }
                SEAM(23 + 2 * g); TICK(15);
            }
            if (EN(16) && IN(22 + 2 * MOE_NG)) final_phase<true>(p);
            TICK(16);
            if (PROF_SEL >= 0 && blockIdx.x == 0 && threadIdx.x == 0) { const unsigned long long t0_ = __builtin_amdgcn_s_memrealtime(); const unsigned long long w_ = 4ull * pfw[1]; while (__builtin_amdgcn_s_memrealtime() - t0_ < w_) __builtin_amdgcn_s_sleep(8); }
        }
    }
#undef IN
#undef SEAM
}
__global__ void k_fill(float* o, int n, float c) { int i = blockIdx.x * blockDim.x + threadIdx.x; if (i < n) o[i] = c; }

#ifndef ONE_LAUNCH
#define ONE_LAUNCH 1
#endif
extern "C" void kernel_launch(void* const* d_in, const int* in_sizes, int n_in, void* d_out, int out_size, void* d_ws, size_t ws_size, hipStream_t stream) {
    if (n_in != 39 || out_size != T * D || ws_size < WS_NEED) { hipLaunchKernelGGL(k_fill, dim3((out_size + 255) / 256), dim3(256), 0, stream, (float*)d_out, out_size, 3.0f); return; }
    static int grid = 0;
    if (!grid) {
        int dev = 0, cus = 0;
        (void)hipGetDevice(&dev); (void)hipDeviceGetAttribute(&cus, hipDeviceAttributeMultiprocessorCount, dev);
        (void)hipFuncSetAttribute((const void*)fwd, hipFuncAttributeMaxDynamicSharedMemorySize, LDS_BYTES);
        int per_cu = 0; (void)hipOccupancyMaxActiveBlocksPerMultiprocessor(&per_cu, (const void*)fwd, 512, LDS_BYTES);
        (void)hipGetLastError();
        grid = cus > 0 ? cus : 256;
    }
    Params p{};
    for (int i = 0; i < 39; ++i) p.in[i] = (const float*)d_in[i];
    p.out = (float*)d_out; p.ws = (unsigned char*)d_ws;
    (void)hipMemsetAsync((unsigned char*)d_ws + WS_CTL, 0, 32768, stream);
#if ONE_LAUNCH
    hipLaunchKernelGGL(fwd, dim3(grid), dim3(512), LDS_BYTES, stream, p, 0, NPH);
#else
    for (int k = 0; k < NPH; ++k) hipLaunchKernelGGL(fwd, dim3(grid), dim3(512), LDS_BYTES, stream, p, k, k + 1);
#endif
}
```

```cpp
#include <hip/hip_runtime.h>
#include <cstdint>
#include <cstdio>

#define DEV __device__ __forceinline__
#define LAS __attribute__((address_space(3)))
typedef unsigned short bf16;
typedef float f32x4 __attribute__((ext_vector_type(4)));
typedef float f32x2 __attribute__((ext_vector_type(2)));
typedef unsigned u32x4 __attribute__((ext_vector_type(4)));
typedef unsigned u32x2 __attribute__((ext_vector_type(2)));

constexpr int D = 1024, NB = 4, SEQ = 4096, T = NB * SEQ, NL = 2;
constexpr int IN_COLS = 5504, OFF_CONV = 256, OFF_RWKV = 768, OFF_GATE = 2432;
constexpr int RW = 512, NH = 8, HD = 64;
constexpr int DFF = 2816, NE = 8, DFE = 3584;
constexpr int ZR_W = 1792, ZG_W = 3072, ZP_W = 256, ZC_W = 512, ZN = 5632;
constexpr int NCH = 64, CH = 64;
constexpr int SCH = 384;
constexpr float RMS_EPS = 1e-6f, LN_EPS = 1e-5f, GN_EPS = 64e-5f;

constexpr size_t MiB = 1u << 20;
constexpr size_t WS_CTL = 0;
constexpr size_t WS_MOD = 1 * MiB;
constexpr size_t WS_H = 51 * MiB;
constexpr size_t WS_U = 83 * MiB;
constexpr size_t WS_VF = 115 * MiB;
constexpr size_t WS_G = 147 * MiB;
constexpr size_t WS_BON = 163 * MiB;
constexpr size_t WS_ZG = 164 * MiB;
constexpr size_t WS_ZR = 260 * MiB;
constexpr size_t WS_ZP = 316 * MiB;
constexpr size_t WS_ZC = 324 * MiB;
constexpr size_t WS_LS = 260 * MiB;
constexpr size_t WS_PM = 292 * MiB;
constexpr size_t WS_SC = 340 * MiB;
constexpr size_t WS_LORA = 2 * MiB;
constexpr size_t WS_H8 = 436 * MiB;
constexpr size_t WS_WIN8 = 452 * MiB;
constexpr size_t WS_WIN = 4 * MiB;
constexpr size_t WS_WMIX = 26 * MiB;
constexpr size_t WS_WO = 30 * MiB;
constexpr size_t WS_W13 = 34 * MiB;
constexpr size_t WS_W2 = 45 * MiB;
constexpr size_t WS_MRG = 51 * MiB;
constexpr size_t WS_HID = 340 * MiB;
constexpr size_t WS_MW13 = 83 * MiB;
constexpr size_t WS_MW2 = 195 * MiB;
constexpr size_t WS_HS = 251 * MiB;
constexpr size_t WS_EH = 319 * MiB;
constexpr size_t WS_Y = 438 * MiB;
constexpr size_t WS_LTOK = 502 * MiB;
constexpr size_t WS_LW = 503 * MiB;
constexpr size_t WS_ROWTK = 504 * MiB;
constexpr size_t WS_ROWW = 505 * MiB;
constexpr size_t WS_NEED = 532 * MiB;

struct Params {
    const float* in[39];
    float* out; unsigned char* ws;
};

DEV int tid_fresh() { int t = threadIdx.x; asm volatile("" : "+v"(t)); return t; }
DEV float bf2f(bf16 b) { return __uint_as_float(((unsigned)b) << 16); }
DEV unsigned f2bf(float f) { unsigned u = __float_as_uint(f); return (u + 0x7fffu + ((u >> 16) & 1u)) >> 16; }
DEV unsigned pk2(float lo, float hi) { return f2bf(lo) | (f2bf(hi) << 16); }
typedef float f32x16 __attribute__((ext_vector_type(16)));
#define DPPF(old, x, ctrl, rmask) __builtin_bit_cast(float, __builtin_amdgcn_update_dpp(__builtin_bit_cast(int, (float)(old)), __builtin_bit_cast(int, (float)(x)), ctrl, rmask, 0xF, false))
DEV float wave_sum(float x) {
    x += DPPF(0.f, x, 0xB1, 0xF); x += DPPF(0.f, x, 0x4E, 0xF); x += DPPF(0.f, x, 0x141, 0xF); x += DPPF(0.f, x, 0x140, 0xF);
    x += DPPF(0.f, x, 0x142, 0xA); x += DPPF(0.f, x, 0x143, 0xC);
    return __builtin_bit_cast(float, __builtin_amdgcn_readlane(__builtin_bit_cast(int, x), 63));
}
#define SLD16(dst, ptr, off) asm volatile("s_load_dwordx16 %0, %1, %2 glc" : "=s"(dst) : "s"(ptr), "n"(off))
#define SLD4(dst, ptr, off) asm volatile("s_load_dwordx4 %0, %1, %2 glc" : "=s"(dst) : "s"(ptr), "n"(off))
DEV float sigmoidf_(float x) { return 1.0f / (1.0f + __expf(-x)); }
DEV float siluf_(float x) { return x / (1.0f + __expf(-x)); }
DEV float fsig_(float x) { return __builtin_amdgcn_rcpf(1.0f + __expf(-x)); }
DEV f32x4 ld4bf(const bf16* p_) { const u32x2 w = *(const u32x2*)p_; return (f32x4){__uint_as_float(w.x << 16), __uint_as_float(w.x & 0xffff0000u), __uint_as_float(w.y << 16), __uint_as_float(w.y & 0xffff0000u)}; }
DEV u32x4 pack8b(const f32x4& a, const f32x4& b) { u32x4 w; w.x = pk2(a.x, a.y); w.y = pk2(a.z, a.w); w.z = pk2(b.x, b.y); w.w = pk2(b.z, b.w); return w; }
DEV unsigned pkh(float a, float b) { typedef _Float16 h2 __attribute__((ext_vector_type(2))); const h2 t = {(_Float16)a, (_Float16)b}; return __builtin_bit_cast(unsigned, t); }
DEV unsigned pk4_fp8(float a, float b, float c, float d) { int w = 0; w = __builtin_amdgcn_cvt_pk_fp8_f32(a, b, w, false); w = __builtin_amdgcn_cvt_pk_fp8_f32(c, d, w, true); return (unsigned)w; }
DEV u32x4 packh8(const f32x4& a, const f32x4& b) { u32x4 w; w.x = pkh(a.x, a.y); w.y = pkh(a.z, a.w); w.z = pkh(b.x, b.y); w.w = pkh(b.z, b.w); return w; }
DEV void unpack8(const u32x4& w, f32x4& a, f32x4& b) {
    a.x = __uint_as_float(w.x << 16); a.y = __uint_as_float(w.x & 0xffff0000u); a.z = __uint_as_float(w.y << 16); a.w = __uint_as_float(w.y & 0xffff0000u);
    b.x = __uint_as_float(w.z << 16); b.y = __uint_as_float(w.z & 0xffff0000u); b.z = __uint_as_float(w.w << 16); b.w = __uint_as_float(w.w & 0xffff0000u); }
DEV float softplusf_(float y) { return fmaxf(y, 0.f) + log1pf(__expf(-fabsf(y))); }

DEV void mod_phase(const Params& p, LAS unsigned char* lds) {
    LAS float* sc = (LAS float*)lds;
    LAS float* red = (LAS float*)(lds + 16384);
    const int tid = tid_fresh(), lane = tid & 63, wv = tid >> 6;
    const float* c = p.in[1];
    for (int i = tid; i < 4096; i += 512) sc[i] = siluf_(c[i]);
    __syncthreads();
    float* MOD = (float*)(p.ws + WS_MOD);
    for (int item = blockIdx.x; item < 4 * 48; item += gridDim.x) {
        const int lk = item / 48, nb = item % 48, n = nb * 64 + lane;
        const float* W = p.in[2] + (size_t)lk * 1024 * 3072;
        float a0 = 0.f, a1 = 0.f, a2 = 0.f, a3 = 0.f;
#pragma unroll 16
        for (int k = wv * 128; k < wv * 128 + 128; ++k) {
            const float w = W[(size_t)k * 3072 + n];
            a0 += sc[k] * w; a1 += sc[1024 + k] * w; a2 += sc[2048 + k] * w; a3 += sc[3072 + k] * w;
        }
        red[(wv * 4 + 0) * 64 + lane] = a0; red[(wv * 4 + 1) * 64 + lane] = a1; red[(wv * 4 + 2) * 64 + lane] = a2; red[(wv * 4 + 3) * 64 + lane] = a3;
        __syncthreads();
        if (tid < 256) {
            const int b = tid >> 6; float s = p.in[3][lk * 3072 + n];
            for (int w8 = 0; w8 < 8; ++w8) s += red[(w8 * 4 + b) * 64 + lane];
            MOD[(size_t)(lk * 4 + b) * 3072 + n] = s;
        }
        __syncthreads();
    }
}

template <bool ROUTER, bool ALSO8 = false>
DEV void norm_phase(const Params& p, int lk, const float* xin, LAS unsigned char* lds) {
    const int tid = tid_fresh(), lane = tid & 63, wv = tid >> 6;
    const int gw = blockIdx.x * 8 + wv, ngw = gridDim.x * 8;
    bf16* H = (bf16*)(p.ws + WS_H);
    const float* MOD = (const float*)(p.ws + WS_MOD);
    const float* g = p.in[4] + (size_t)lk * 1024;
    LAS unsigned* wgc = (LAS unsigned*)lds;
    for (int r0 = gw * 8; r0 < T; r0 += ngw * 8) {
        const int b = r0 / SEQ;
        const float* mod = MOD + (size_t)(lk * 4 + b) * 3072;
        int s_ea = 0, s_eb = 0; float s_wa = 0.f, s_wb = 0.f;
        if (ROUTER) { if (tid < 8) wgc[tid] = 0u; __syncthreads(); }
        f32x4 gs[4], sh[4];
#pragma unroll
        for (int j = 0; j < 4; ++j) {
            const int d = 4 * lane + 256 * j;
            const f32x4 gg = *(const f32x4*)(g + d), scl = *(const f32x4*)(mod + 1024 + d);
            gs[j] = gg * (scl + 1.0f); sh[j] = *(const f32x4*)(mod + d);
        }
        f32x4 vn[4];
#pragma unroll
        for (int j = 0; j < 4; ++j) vn[j] = *(const f32x4*)(xin + (size_t)r0 * D + 4 * lane + 256 * j);
        for (int r = r0; r < r0 + 8; ++r) {
            f32x4 v[4]; float ss = 0.f;
            const float* xn = xin + (size_t)(r + 1 < r0 + 8 ? r + 1 : r) * D;
#pragma unroll
            for (int j = 0; j < 4; ++j) { v[j] = vn[j]; vn[j] = *(const f32x4*)(xn + 4 * lane + 256 * j); ss += (v[j].x * v[j].x + v[j].y * v[j].y) + (v[j].z * v[j].z + v[j].w * v[j].w); }
            const float rstd = 1.0f / sqrtf(wave_sum(ss) * (1.0f / D) + RMS_EPS);
#pragma unroll
            for (int j = 0; j < 4; ++j) v[j] = v[j] * rstd * gs[j] + sh[j];
#pragma unroll
            for (int j = 0; j < 4; ++j) { u32x2 o; o.x = pk2(v[j].x, v[j].y); o.y = pk2(v[j].z, v[j].w); *(u32x2*)(H + (size_t)r * D + 4 * lane + 256 * j) = o;
                if (ALSO8) *(unsigned*)(p.ws + WS_H8 + (size_t)r * D + 4 * lane + 256 * j) = pk4_fp8(v[j].x, v[j].y, v[j].z, v[j].w); }
            if (ROUTER) {
                const float* R = p.in[34];
                float lg[8];
#pragma unroll
                for (int e = 0; e < 8; ++e) lg[e] = 0.f;
#pragma unroll
                for (int j = 0; j < 4; ++j)
#pragma unroll
                    for (int q = 0; q < 4; ++q) {
                        const int d = 4 * lane + 256 * j + q; const float hv = v[j][q];
                        const f32x4 w0 = *(const f32x4*)(R + (size_t)d * 8), w1 = *(const f32x4*)(R + (size_t)d * 8 + 4);
                        lg[0] += hv * w0.x; lg[1] += hv * w0.y; lg[2] += hv * w0.z; lg[3] += hv * w0.w;
                        lg[4] += hv * w1.x; lg[5] += hv * w1.y; lg[6] += hv * w1.z; lg[7] += hv * w1.w;
                    }
#pragma unroll
                for (int e = 0; e < 8; ++e) lg[e] = wave_sum(lg[e]);
                int ea = 0; float va = lg[0];
#pragma unroll
                for (int e = 1; e < 8; ++e) if (lg[e] > va) { va = lg[e]; ea = e; }
                int eb = -1; float vb = -3.0e38f;
#pragma unroll
                for (int e = 0; e < 8; ++e) if (e != ea && lg[e] > vb) { vb = lg[e]; eb = e; }
                const float wa = 1.0f / (1.0f + __expf(vb - va)), wb = 1.0f - wa;
                if (lane == r - r0) { s_ea = ea; s_eb = eb; s_wa = wa; s_wb = wb; }
            }
        }
        if (ROUTER) {
            unsigned pa = 0u, pb = 0u;
            if (lane < 8) { pa = atomicAdd((unsigned*)(wgc + s_ea), 1u); pb = atomicAdd((unsigned*)(wgc + s_eb), 1u); }
            __syncthreads();
            if (tid < 8) wgc[8 + tid] = atomicAdd((unsigned*)(p.ws + WS_CTL) + tid * 32, wgc[tid]);
            __syncthreads();
            if (lane < 8) {
                int* LT = (int*)(p.ws + WS_LTOK); float* LW = (float*)(p.ws + WS_LW);
                const int r = r0 + lane; const unsigned ga = wgc[8 + s_ea] + pa, gb = wgc[8 + s_eb] + pb;
                LT[s_ea * T + ga] = r * 2 + 0; LW[s_ea * T + ga] = s_wa;
                LT[s_eb * T + gb] = r * 2 + 1; LW[s_eb * T + gb] = s_wb;
            }
            __syncthreads();
        }
    }
}

template <int WIN>
DEV void pool_rows(const LAS bf16* sp, bf16* U, int m0, int tl0, int half, int ch) {
    float u[32 + WIN - 1];
#pragma unroll
    for (int k = 0; k < 32 + WIN - 1; ++k) u[k] = bf2f(sp[(half * 32 + 16 - WIN + k) * 256 + ch]);
    float s = 0.f;
#pragma unroll
    for (int k = 0; k < WIN - 1; ++k) s += u[k];
#pragma unroll
    for (int i = 0; i < 32; ++i) {
        s += u[i + WIN - 1];
        const int tl = tl0 + half * 32 + i; const float cnt = (float)((tl + 1) < WIN ? (tl + 1) : WIN);
        U[(size_t)(m0 + half * 32 + i) * D + ch] = (bf16)f2bf(s / cnt - u[i + WIN - 1]);
        s -= u[i];
    }
}
DEV void mixer_phase(const Params& p, int l, LAS unsigned char* lds) {
    const bf16* Zr = (const bf16*)(p.ws + WS_ZR); const bf16* Zp = (const bf16*)(p.ws + WS_ZP); const bf16* Zc = (const bf16*)(p.ws + WS_ZC);
    bf16* U = (bf16*)(p.ws + WS_U); float* VF = (float*)(p.ws + WS_VF); bf16* G = (bf16*)(p.ws + WS_G); float* BON = (float*)(p.ws + WS_BON);
    for (int blk = blockIdx.x; blk < T / 64; blk += gridDim.x) {
        int tid_ = threadIdx.x; asm volatile("" : "+v"(tid_));
        const int tid = tid_, lane = tid & 63, wv = __builtin_amdgcn_readfirstlane(tid >> 6);
        const int m0 = blk * 64, b = m0 / SEQ, tl0 = m0 % SEQ;
        {
            LAS bf16* sp = (LAS bf16*)lds;
            { u32x4 pv[5];
#pragma unroll
              for (int k = 0; k < 5; ++k) { const int ci = tid + k * 512, tt = ci >> 5, c8 = (ci & 31) * 8, tl = tl0 - 15 + tt;
                  pv[k] = (u32x4){0u, 0u, 0u, 0u}; if (ci < 79 * 32 && tl >= 0) pv[k] = *(const u32x4*)(Zp + (size_t)(b * SEQ + tl) * ZP_W + c8); }
#pragma unroll
              for (int k = 0; k < 5; ++k) { const int ci = tid + k * 512, tt = ci >> 5, c8 = (ci & 31) * 8; if (ci < 79 * 32) *(LAS u32x4*)(sp + tt * 256 + c8) = pv[k]; } }
            __syncthreads();
            const int ch = tid & 255, half = tid >> 8, gi = (wv & 3);
            switch (gi) { case 0: pool_rows<2>(sp, U, m0, tl0, half, ch); break; case 1: pool_rows<4>(sp, U, m0, tl0, half, ch); break;
                          case 2: pool_rows<8>(sp, U, m0, tl0, half, ch); break; default: pool_rows<16>(sp, U, m0, tl0, half, ch); break; }
            __syncthreads();
        }
        {
            LAS float* ug = (LAS float*)lds;
            LAS float* cw = (LAS float*)(lds + 94 * 1024);
            { u32x4 av[6], bv[6];
#pragma unroll
              for (int k = 0; k < 6; ++k) { const int idx = tid + k * 512, tt = idx >> 5, c8 = (idx & 31) * 8, tl = tl0 - 30 + tt;
                  av[k] = (u32x4){0u, 0u, 0u, 0u}; bv[k] = av[k];
                  if (idx < 94 * 32 && tl >= 0) { const bf16* zr = Zc + (size_t)(b * SEQ + tl) * ZC_W; av[k] = *(const u32x4*)(zr + c8); bv[k] = *(const u32x4*)(zr + 256 + c8); } }
              f32x4 wv4[4]; const float* CW = p.in[9] + (size_t)l * 31 * 256;
#pragma unroll
              for (int k = 0; k < 4; ++k) { const int idx = tid + k * 512; wv4[k] = idx < 31 * 64 ? *(const f32x4*)(CW + idx * 4) : (f32x4){0.f, 0.f, 0.f, 0.f}; }
#pragma unroll
              for (int k = 0; k < 6; ++k) { const int idx = tid + k * 512, tt = idx >> 5, c8 = (idx & 31) * 8;
                  if (idx < 94 * 32) { f32x4 a0, a1, b0, b1; unpack8(av[k], a0, a1); unpack8(bv[k], b0, b1);
#pragma unroll
                      for (int e = 0; e < 4; ++e) { a0[e] *= fsig_(b0[e]); a1[e] *= fsig_(b1[e]); }
                      *(LAS f32x4*)(ug + tt * 256 + c8) = a0; *(LAS f32x4*)(ug + tt * 256 + c8 + 4) = a1; } }
#pragma unroll
              for (int k = 0; k < 4; ++k) { const int idx = tid + k * 512; if (idx < 31 * 64) *(LAS f32x4*)(cw + idx * 4) = wv4[k]; } }
            __syncthreads();
            const int c4 = 4 * lane;
            const f32x4 cb = *(const f32x4*)(p.in[10] + l * 256 + c4), lg = *(const f32x4*)(p.in[11] + l * 256 + c4), lb = *(const f32x4*)(p.in[12] + l * 256 + c4);
            {
                f32x4 wk[31];
#pragma unroll
                for (int k = 0; k < 31; ++k) wk[k] = *(const LAS f32x4*)(cw + k * 256 + c4);
                f32x4 acc[8];
#pragma unroll
                for (int j = 0; j < 8; ++j) acc[j] = cb;
#pragma unroll
                for (int r = 0; r < 38; ++r) {
                    const f32x4 x = *(const LAS f32x4*)(ug + (wv * 8 + r) * 256 + c4);
#pragma unroll
                    for (int j = 0; j < 8; ++j) if (r - j >= 0 && r - j <= 30) acc[j] += x * wk[r - j];
                }
#pragma unroll
                for (int j = 0; j < 8; ++j) {
                    const int i = wv * 8 + j;
                    const float mean = wave_sum((acc[j].x + acc[j].y) + (acc[j].z + acc[j].w)) * (1.0f / 256.0f);
                    const f32x4 d = acc[j] - mean;
                    const float var = wave_sum((d.x * d.x + d.y * d.y) + (d.z * d.z + d.w * d.w)) * (1.0f / 256.0f);
                    const float rstd = 1.0f / sqrtf(var + LN_EPS);
                    const f32x4 un = d * rstd * lg + lb;
                    u32x2 o; o.x = pk2(un.x * fsig_(un.x), un.y * fsig_(un.y)); o.y = pk2(un.z * fsig_(un.z), un.w * fsig_(un.w));
                    *(u32x2*)(U + (size_t)(m0 + i) * D + 256 + c4) = o;
                }
            }
            __syncthreads();
        }
        {
            typedef short bf16x8 __attribute__((ext_vector_type(8)));
            LAS bf16* LAb = (LAS bf16*)lds;
            const float* mu = p.in[14] + (size_t)l * 1664;
            { u32x4 zc[3], zq[3];
#pragma unroll
              for (int k = 0; k < 3; ++k) { const int idx = tid + k * 512, i = idx / 20, k8 = idx % 20, m = m0 + i, tl = tl0 + i;
                  zc[k] = (u32x4){0u, 0u, 0u, 0u}; zq[k] = zc[k];
                  if (idx < 64 * 20 && k8 < 18) { zc[k] = *(const u32x4*)(Zr + (size_t)m * ZR_W + 1536 + k8 * 8); if (tl > 0) zq[k] = *(const u32x4*)(Zr + (size_t)(m - 1) * ZR_W + 1536 + k8 * 8); } }
#pragma unroll
              for (int k = 0; k < 3; ++k) { const int idx = tid + k * 512, i = idx / 20, k8 = idx % 20;
                  if (idx < 64 * 20) { f32x4 c0, c1, q0, q1; unpack8(zc[k], c0, c1); unpack8(zq[k], q0, q1);
                      const float* mp = k8 < 16 ? mu + 1536 + k8 * 8 : p.in[27] + (k8 - 16) * 8;
                      f32x4 m0v = (f32x4){0.f, 0.f, 0.f, 0.f}, m1v = m0v; if (k8 < 18) { m0v = *(const f32x4*)mp; m1v = *(const f32x4*)(mp + 4); }
                      c0 = c0 + (q0 - c0) * m0v; c1 = c1 + (q1 - c1) * m1v;
                      if (k8 < 4) {
#pragma unroll
                          for (int e = 0; e < 4; ++e) { c0[e] = 1.0f - 2.0f * __builtin_amdgcn_rcpf(1.0f + __expf(2.0f * c0[e])); c1[e] = 1.0f - 2.0f * __builtin_amdgcn_rcpf(1.0f + __expf(2.0f * c1[e])); }
                      } else if (k8 >= 8 && k8 < 16) {
#pragma unroll
                          for (int e = 0; e < 4; ++e) { c0[e] = fsig_(c0[e]); c1[e] = fsig_(c1[e]); }
                      }
                      *(LAS u32x4*)(LAb + i * 168 + k8 * 8) = pack8b(c0, c1); } } }
            const int hh = wv, fr = lane & 15;
            __syncthreads();
            const f32x4 z4 = (f32x4){0.f, 0.f, 0.f, 0.f};
            bf16* SCh = (bf16*)(p.ws + WS_SC);
            LAS float* invL = (LAS float*)(lds + 24576) + wv * 64;
            LAS float* bonL = (LAS float*)(lds + 26624) + wv * 256;
            { int fq_ = lane >> 4; asm volatile("" : "+v"(fq_)); const int fq = fq_;
#pragma unroll 1
            for (int mt = 0; mt < 4; ++mt) {
                const int i = mt * 16 + fr, m = m0 + i, tl = tl0 + i;
                const bf16* zt = Zr + (size_t)m * ZR_W; const bf16* zp = zt - ZR_W; const bool hasp = tl > 0;
                float ss = 0.f;
#pragma unroll
                for (int q = 0; q < 2; ++q) {
                    const int c = hh * 64 + q * 32 + 8 * fq;
                    f32x4 kt0, kt1, kq0 = z4, kq1 = z4; unpack8(*(const u32x4*)(zt + 512 + c), kt0, kt1); if (hasp) unpack8(*(const u32x4*)(zp + 512 + c), kq0, kq1);
                    const f32x4 ka = (kt0 + (kq0 - kt0) * *(const f32x4*)(mu + 512 + c)) * *(const f32x4*)(p.in[20] + l * 512 + c);
                    const f32x4 kb = (kt1 + (kq1 - kt1) * *(const f32x4*)(mu + 512 + c + 4)) * *(const f32x4*)(p.in[20] + l * 512 + c + 4);
                    ss += ((ka.x * ka.x + ka.y * ka.y) + (ka.z * ka.z + ka.w * ka.w)) + ((kb.x * kb.x + kb.y * kb.y) + (kb.z * kb.z + kb.w * kb.w));
                }
                ss += __shfl_xor(ss, 16); ss += __shfl_xor(ss, 32);
                if (fq == 0) invL[i] = 1.0f / fmaxf(sqrtf(ss), 1e-12f);
            } }
            for (int q = 0; q < 2; ++q) {
                int fq_ = lane >> 4; asm volatile("" : "+v"(fq_));
                const int fq = fq_;
                bf16x8 Bw[2], Ba[2], Bg[2][2], Bv[2];
#pragma unroll
                for (int hf = 0; hf < 2; ++hf) {
                    const bf16* fp = (const bf16*)(p.ws + WS_LORA) + ((size_t)((((l * 8 + hh) * 2 + q) * 2 + hf) * 5) * 64 + lane) * 8;
                    Bw[hf] = *(const bf16x8*)(fp); Ba[hf] = *(const bf16x8*)(fp + 512); Bg[hf][0] = *(const bf16x8*)(fp + 1024); Bg[hf][1] = *(const bf16x8*)(fp + 1536); Bv[hf] = *(const bf16x8*)(fp + 2048);
                }
                const int c = hh * 64 + q * 32 + 8 * fq;
#pragma unroll 1
                for (int mt = 0; mt < 4; ++mt) {
                    const int i = mt * 16 + fr, m = m0 + i, tl = tl0 + i;
                    const float inv_i = invL[i];
                    bf16x8 Af[5];
#pragma unroll
                    for (int ks = 0; ks < 5; ++ks) Af[ks] = *(const LAS bf16x8*)(LAb + i * 168 + 32 * ks + 8 * fq);
                    const bf16* zt = Zr + (size_t)m * ZR_W; const bf16* zp = zt - ZR_W; const bool hasp = tl > 0;
                    bf16* rec = SCh + ((size_t)(b * NH + hh) * SEQ + tl) * SCH + fq * 96;
                    f32x4 rt[2], kt[2], vt[2], rq[2] = {z4, z4}, kq[2] = {z4, z4}, vq[2] = {z4, z4};
                    unpack8(*(const u32x4*)(zt + c), rt[0], rt[1]); unpack8(*(const u32x4*)(zt + 512 + c), kt[0], kt[1]); unpack8(*(const u32x4*)(zt + 1024 + c), vt[0], vt[1]);
                    if (hasp) { unpack8(*(const u32x4*)(zp + c), rq[0], rq[1]); unpack8(*(const u32x4*)(zp + 512 + c), kq[0], kq[1]); unpack8(*(const u32x4*)(zp + 1024 + c), vq[0], vq[1]); }
                    f32x4 om[2], kka[2], kpv[2], r4[2], kkv[2], v4[2], gg[2];
                    float bon = 0.f;
#pragma unroll
                    for (int hf = 0; hf < 2; ++hf) {
                        const int cc = c + 4 * hf;
                        const f32x4 aw_ = __builtin_amdgcn_mfma_f32_16x16x32_bf16(Bw[hf], Af[0], z4, 0, 0, 0);
                        const f32x4 aa_ = __builtin_amdgcn_mfma_f32_16x16x32_bf16(Ba[hf], Af[1], z4, 0, 0, 0);
                        gg[hf] = __builtin_amdgcn_mfma_f32_16x16x32_bf16(Bg[hf][1], Af[3], __builtin_amdgcn_mfma_f32_16x16x32_bf16(Bg[hf][0], Af[2], z4, 0, 0, 0), 0, 0, 0);
                        r4[hf] = rt[hf] + (rq[hf] - rt[hf]) * *(const f32x4*)(mu + cc);
                        const f32x4 k4 = kt[hf] + (kq[hf] - kt[hf]) * *(const f32x4*)(mu + 512 + cc);
                        v4[hf] = vt[hf] + (vq[hf] - vt[hf]) * *(const f32x4*)(mu + 1024 + cc);
                        const f32x4 wl = aw_ + *(const f32x4*)(p.in[15] + l * 512 + cc), al = aa_ + *(const f32x4*)(p.in[17] + l * 512 + cc);
                        f32x4 a4;
#pragma unroll
                        for (int e = 0; e < 4; ++e) {
                            const float y = -wl[e];
                            const float sp = fmaxf(y, 0.f) + __logf(1.0f + __expf(-fabsf(y)));
                            om[hf][e] = 1.0f - __expf(-__expf(-sp - 0.5f)); a4[e] = fsig_(al[e]);
                        }
                        kkv[hf] = k4 * *(const f32x4*)(p.in[20] + l * 512 + cc) * inv_i;
                        kpv[hf] = k4 * ((a4 - 1.0f) * *(const f32x4*)(p.in[21] + l * 512 + cc) + 1.0f); kka[hf] = kkv[hf] * a4;
                        const f32x4 rk = r4[hf] * kpv[hf] * *(const f32x4*)(p.in[22] + l * 512 + cc);
                        bon += (rk.x + rk.y) + (rk.z + rk.w);
                        if (l) {
                            const f32x4 vl = __builtin_amdgcn_mfma_f32_16x16x32_bf16(Bv[hf], Af[4], z4, 0, 0, 0) + *(const f32x4*)(p.in[28] + cc), vf = *(const f32x4*)(VF + (size_t)m * RW + cc);
#pragma unroll
                            for (int e = 0; e < 4; ++e) v4[hf][e] = v4[hf][e] + (vf[e] - v4[hf][e]) * fsig_(vl[e]);
                        } else *(f32x4*)(VF + (size_t)m * RW + cc) = v4[hf];
                    }
                    if (q == 0) bonL[mt * 64 + lane] = bon; else bon += bonL[mt * 64 + lane];
                    if (q == 1) { bon += __shfl_xor(bon, 16); bon += __shfl_xor(bon, 32); if (fq == 0) BON[(size_t)m * NH + hh] = bon; }
                    *(u32x4*)(rec + q * 40) = packh8(om[0], om[1]); *(u32x4*)(rec + q * 40 + 8) = packh8(kka[0], kka[1]); *(u32x4*)(rec + q * 40 + 16) = packh8(kpv[0], kpv[1]);
                    *(u32x4*)(rec + q * 40 + 24) = packh8(r4[0], r4[1]); *(u32x4*)(rec + q * 40 + 32) = packh8(kkv[0], kkv[1]);
                    *(u32x4*)(rec + 80 + q * 8) = packh8(v4[0], v4[1]);
                    u32x4 go; go.x = pk2(gg[0].x, gg[0].y); go.y = pk2(gg[0].z, gg[0].w); go.z = pk2(gg[1].x, gg[1].y); go.w = pk2(gg[1].z, gg[1].w);
                    *(u32x4*)(G + (size_t)m * RW + c) = go;
                }
            }
            __syncthreads();
        }
    }
}

struct RecRegs { u32x2 g2; unsigned g1; };
DEV void rec_load(RecRegs& r, const bf16* rec, int lane) { r.g2 = *(const u32x2*)(rec + lane * 4); r.g1 = *(const unsigned*)(rec + 256 + lane * 2); }
DEV void rec_put(const RecRegs& r, LAS unsigned char* slot, int lane) { *(LAS u32x2*)(slot + lane * 8) = r.g2; *(LAS unsigned*)(slot + 512 + lane * 4) = r.g1; }
DEV float h2f(unsigned short h) { return (float)__builtin_bit_cast(_Float16, h); }
DEV void blk4h_full(float& s0, float& s1, float& s2, float& s3, float (&o)[4], float (&san)[4], float sa, float vv, unsigned d0, unsigned d1, unsigned a0, unsigned a1, unsigned p0, unsigned p1, unsigned r0, unsigned r1, unsigned k0, unsigned k1) {
    asm volatile(
        "v_fma_mix_f32 %0, -%14, %0, %0 op_sel:[0,0,0] op_sel_hi:[1,0,0]\n v_fma_mix_f32 %1, -%14, %1, %1 op_sel:[1,0,0] op_sel_hi:[1,0,0]\n"
        "v_fma_mix_f32 %2, -%15, %2, %2 op_sel:[0,0,0] op_sel_hi:[1,0,0]\n v_fma_mix_f32 %3, -%15, %3, %3 op_sel:[1,0,0] op_sel_hi:[1,0,0]\n"
        "v_fma_mix_f32 %0, %16, %12, %0 op_sel:[0,0,0] op_sel_hi:[1,0,0]\n v_fma_mix_f32 %1, %16, %12, %1 op_sel:[1,0,0] op_sel_hi:[1,0,0]\n"
        "v_fma_mix_f32 %2, %17, %12, %2 op_sel:[0,0,0] op_sel_hi:[1,0,0]\n v_fma_mix_f32 %3, %17, %12, %3 op_sel:[1,0,0] op_sel_hi:[1,0,0]\n"
        "v_fma_mix_f32 %0, %18, %13, %0 op_sel:[0,0,0] op_sel_hi:[1,0,0]\n v_fma_mix_f32 %1, %18, %13, %1 op_sel:[1,0,0] op_sel_hi:[1,0,0]\n"
        "v_fma_mix_f32 %2, %19, %13, %2 op_sel:[0,0,0] op_sel_hi:[1,0,0]\n v_fma_mix_f32 %3, %19, %13, %3 op_sel:[1,0,0] op_sel_hi:[1,0,0]\n"
        "v_fma_mix_f32 %4, %20, %0, %4 op_sel:[0,0,0] op_sel_hi:[1,0,0]\n v_fma_mix_f32 %5, %20, %1, %5 op_sel:[1,0,0] op_sel_hi:[1,0,0]\n"
        "v_fma_mix_f32 %6, %21, %2, %6 op_sel:[0,0,0] op_sel_hi:[1,0,0]\n v_fma_mix_f32 %7, %21, %3, %7 op_sel:[1,0,0] op_sel_hi:[1,0,0]\n"
        "v_fma_mix_f32 %8, %22, %0, %8 op_sel:[0,0,0] op_sel_hi:[1,0,0]\n v_fma_mix_f32 %9, %22, %1, %9 op_sel:[1,0,0] op_sel_hi:[1,0,0]\n"
        "v_fma_mix_f32 %10, %23, %2, %10 op_sel:[0,0,0] op_sel_hi:[1,0,0]\n v_fma_mix_f32 %11, %23, %3, %11 op_sel:[1,0,0] op_sel_hi:[1,0,0]\n"
        : "+v"(s0), "+v"(s1), "+v"(s2), "+v"(s3), "+v"(o[0]), "+v"(o[1]), "+v"(o[2]), "+v"(o[3]), "+v"(san[0]), "+v"(san[1]), "+v"(san[2]), "+v"(san[3])
        : "v"(sa), "v"(vv), "v"(d0), "v"(d1), "v"(a0), "v"(a1), "v"(p0), "v"(p1), "v"(r0), "v"(r1), "v"(k0), "v"(k1));
}
DEV void blk4h_two(float& s0, float& s1, float& s2, float& s3, float& q0, float& q1, float& q2, float& q3, float (&sanl)[4], float (&sanp)[4], float sal, float sap, float vv,
                   unsigned d0, unsigned d1, unsigned a0, unsigned a1, unsigned p0, unsigned p1, unsigned k0, unsigned k1) {
    asm volatile(
        "v_fma_mix_f32 %0, -%19, %0, %0 op_sel:[0,0,0] op_sel_hi:[1,0,0]\n v_fma_mix_f32 %1, -%19, %1, %1 op_sel:[1,0,0] op_sel_hi:[1,0,0]\n"
        "v_fma_mix_f32 %2, -%20, %2, %2 op_sel:[0,0,0] op_sel_hi:[1,0,0]\n v_fma_mix_f32 %3, -%20, %3, %3 op_sel:[1,0,0] op_sel_hi:[1,0,0]\n"
        "v_fma_mix_f32 %4, -%19, %4, %4 op_sel:[0,0,0] op_sel_hi:[1,0,0]\n v_fma_mix_f32 %5, -%19, %5, %5 op_sel:[1,0,0] op_sel_hi:[1,0,0]\n"
        "v_fma_mix_f32 %6, -%20, %6, %6 op_sel:[0,0,0] op_sel_hi:[1,0,0]\n v_fma_mix_f32 %7, -%20, %7, %7 op_sel:[1,0,0] op_sel_hi:[1,0,0]\n"
        "v_fma_mix_f32 %0, %21, %16, %0 op_sel:[0,0,0] op_sel_hi:[1,0,0]\n v_fma_mix_f32 %1, %21, %16, %1 op_sel:[1,0,0] op_sel_hi:[1,0,0]\n"
        "v_fma_mix_f32 %2, %22, %16, %2 op_sel:[0,0,0] op_sel_hi:[1,0,0]\n v_fma_mix_f32 %3, %22, %16, %3 op_sel:[1,0,0] op_sel_hi:[1,0,0]\n"
        "v_fma_mix_f32 %4, %21, %17, %4 op_sel:[0,0,0] op_sel_hi:[1,0,0]\n v_fma_mix_f32 %5, %21, %17, %5 op_sel:[1,0,0] op_sel_hi:[1,0,0]\n"
        "v_fma_mix_f32 %6, %22, %17, %6 op_sel:[0,0,0] op_sel_hi:[1,0,0]\n v_fma_mix_f32 %7, %22, %17, %7 op_sel:[1,0,0] op_sel_hi:[1,0,0]\n"
        "v_fma_mix_f32 %0, %23, %18, %0 op_sel:[0,0,0] op_sel_hi:[1,0,0]\n v_fma_mix_f32 %1, %23, %18, %1 op_sel:[1,0,0] op_sel_hi:[1,0,0]\n"
        "v_fma_mix_f32 %2, %24, %18, %2 op_sel:[0,0,0] op_sel_hi:[1,0,0]\n v_fma_mix_f32 %3, %24, %18, %3 op_sel:[1,0,0] op_sel_hi:[1,0,0]\n"
        "v_fma_mix_f32 %8, %25, %0, %8 op_sel:[0,0,0] op_sel_hi:[1,0,0]\n v_fma_mix_f32 %9, %25, %1, %9 op_sel:[1,0,0] op_sel_hi:[1,0,0]\n"
        "v_fma_mix_f32 %10, %26, %2, %10 op_sel:[0,0,0] op_sel_hi:[1,0,0]\n v_fma_mix_f32 %11, %26, %3, %11 op_sel:[1,0,0] op_sel_hi:[1,0,0]\n"
        "v_fma_mix_f32 %12, %25, %4, %12 op_sel:[0,0,0] op_sel_hi:[1,0,0]\n v_fma_mix_f32 %13, %25, %5, %13 op_sel:[1,0,0] op_sel_hi:[1,0,0]\n"
        "v_fma_mix_f32 %14, %26, %6, %14 op_sel:[0,0,0] op_sel_hi:[1,0,0]\n v_fma_mix_f32 %15, %26, %7, %15 op_sel:[1,0,0] op_sel_hi:[1,0,0]\n"
        : "+v"(s0), "+v"(s1), "+v"(s2), "+v"(s3), "+v"(q0), "+v"(q1), "+v"(q2), "+v"(q3), "+v"(sanl[0]), "+v"(sanl[1]), "+v"(sanl[2]), "+v"(sanl[3]), "+v"(sanp[0]), "+v"(sanp[1]), "+v"(sanp[2]), "+v"(sanp[3])
        : "v"(sal), "v"(sap), "v"(vv), "v"(d0), "v"(d1), "v"(a0), "v"(a1), "v"(p0), "v"(p1), "v"(k0), "v"(k1));
}
#define BLK_OFF(b8) (((b8) >> 1) * 192 + ((b8) & 1) * 80)
#define BLK_J0(b8) (((b8) & 1) * 32 + ((b8) >> 1) * 8)

DEV void scan_pass1(const Params& p, LAS unsigned char* lds) {
    const int tid = tid_fresh(), lane = tid & 63, wv = __builtin_amdgcn_readfirstlane(tid >> 6);
    const bf16* SC = (const bf16*)(p.ws + WS_SC); float* LS = (float*)(p.ws + WS_LS); float* PM = (float*)(p.ws + WS_PM);
    LAS unsigned char* ring = lds + wv * 1536;
    const int lq = lane >> 5, lfq = (lane >> 3) & 3, le = lane & 7;
    const int voff = lfq * 192 + 160 + lq * 16 + le * 2, koff = lfq * 192 + lq * 80 + 64 + le * 2;
    for (int u = blockIdx.x * 8 + wv; u < 32 * NCH; u += gridDim.x * 8) {
        const int c = u % NCH;
        const bf16* rec = SC + (size_t)u * CH * SCH;
        float S[64], Q[64];
        int ln = lane; asm volatile("" : "+v"(ln));
#pragma unroll
        for (int j = 0; j < 64; ++j) { S[j] = 0.f; Q[j] = (j == ln) ? 1.f : 0.f; }
        RecRegs r1, r2, r3;
        { RecRegs r0; rec_load(r0, rec, lane); rec_put(r0, ring, lane); }
        rec_load(r1, rec + SCH, lane); rec_load(r2, rec + 2 * SCH, lane);
        float sal = 0.f, sap = -h2f(*(const LAS unsigned short*)(ring + koff));
        for (int t = 0; t < CH; t += 2) {
#pragma unroll
            for (int h = 0; h < 2; ++h) {
                LAS unsigned char* cur = ring + h * 768; LAS unsigned char* nxt = ring + (h ^ 1) * 768;
                rec_load(r3, rec + 3 * SCH, lane);
                rec_put(r1, nxt, lane); r1 = r2; r2 = r3;
                const float vv = h2f(*(const LAS unsigned short*)(cur + voff));
                float sanl[4] = {0.f, 0.f, 0.f, 0.f}, sanp[4] = {0.f, 0.f, 0.f, 0.f};
#define P1_LD(X, B8) do { X##0 = *(const LAS u32x4*)(cur + BLK_OFF(B8)); X##1 = *(const LAS u32x4*)(cur + BLK_OFF(B8) + 16); X##2 = *(const LAS u32x4*)(cur + BLK_OFF(B8) + 32); X##3 = *(const LAS u32x4*)(nxt + BLK_OFF(B8) + 64); } while (0)
#define P1_CB(J0, H, D, A, P, K) blk4h_two(S[(J0)], S[(J0) + 1], S[(J0) + 2], S[(J0) + 3], Q[(J0)], Q[(J0) + 1], Q[(J0) + 2], Q[(J0) + 3], sanl, sanp, sal, sap, vv, D[2 * (H)], D[2 * (H) + 1], A[2 * (H)], A[2 * (H) + 1], P[2 * (H)], P[2 * (H) + 1], K[2 * (H)], K[2 * (H) + 1])
#define P1_BLK(B8, X, Y) do { if ((B8) < 7) P1_LD(Y, (B8) + 1); __builtin_amdgcn_sched_barrier(0); P1_CB(BLK_J0(B8), 0, X##0, X##1, X##2, X##3); P1_CB(BLK_J0(B8) + 4, 1, X##0, X##1, X##2, X##3); __builtin_amdgcn_sched_barrier(0); } while (0)
                u32x4 oa0, oa1, oa2, oa3, ob0, ob1, ob2, ob3;
                P1_LD(oa, 0);
                P1_BLK(0, oa, ob); P1_BLK(1, ob, oa); P1_BLK(2, oa, ob); P1_BLK(3, ob, oa); P1_BLK(4, oa, ob); P1_BLK(5, ob, oa); P1_BLK(6, oa, ob); P1_BLK(7, ob, oa);
#undef P1_LD
#undef P1_CB
#undef P1_BLK
                sal = -((sanl[0] + sanl[1]) + (sanl[2] + sanl[3])); sap = -((sanp[0] + sanp[1]) + (sanp[2] + sanp[3])); rec += SCH;
            }
        }
        asm volatile("" :: "v"(r1.g2), "v"(r1.g1), "v"(r2.g2), "v"(r2.g1));
        float* o = LS + ((size_t)u * 64 + lane) * 64;
#pragma unroll
        for (int j = 0; j < 64; j += 4) *(f32x4*)(o + j) = (f32x4){S[j], S[j + 1], S[j + 2], S[j + 3]};
        if (c > 0) {
            o = PM + ((size_t)u * 64 + lane) * 64;
#pragma unroll
            for (int j = 0; j < 64; j += 4) *(f32x4*)(o + j) = (f32x4){Q[j], Q[j + 1], Q[j + 2], Q[j + 3]};
        }
    }
}
DEV float rdl(float v, int j) { return __builtin_bit_cast(float, __builtin_amdgcn_readlane(__builtin_bit_cast(int, v), j)); }
DEV void scan_carry(const Params& p, LAS unsigned char* lds) {
    const int tid = tid_fresh(), lane = tid & 63, wv = __builtin_amdgcn_readfirstlane(tid >> 6);
    float* LS = (float*)(p.ws + WS_LS); const float* PM = (const float*)(p.ws + WS_PM);
    LAS float* Pb = (LAS float*)lds;
    for (int u = blockIdx.x; u < 32 * 8; u += gridDim.x) {
        const int bh = u >> 3, i = (u & 7) * 8 + wv;
        float* Lp = LS + (size_t)bh * NCH * 4096 + i * 64 + lane;
        const float* Pp = PM + (size_t)bh * NCH * 4096 + (wv * 8) * 64 + lane;
        float s = 0.f, pr[8];
#pragma unroll
        for (int j = 0; j < 8; ++j) pr[j] = Pp[(size_t)1 * 4096 + j * 64];
        float Lc = Lp[0];
        __builtin_amdgcn_s_barrier();
        for (int c = 0; c < NCH; ++c) {
            LAS float* cur = Pb + (c & 1) * 4096; LAS float* nxt = Pb + ((c + 1) & 1) * 4096;
            if (c + 1 < NCH) {
#pragma unroll
                for (int j = 0; j < 8; ++j) nxt[(wv * 8 + j) * 64 + lane] = pr[j];
            }
            const int c2 = c + 2 < NCH ? c + 2 : NCH - 1, c1 = c + 1 < NCH ? c + 1 : NCH - 1;
#pragma unroll
            for (int j = 0; j < 8; ++j) pr[j] = Pp[(size_t)c2 * 4096 + j * 64];
            const float Ln = Lp[(size_t)c1 * 4096];
            float acc = Lc;
            if (c > 0) {
                float a0 = 0.f, a1 = 0.f, a2 = 0.f, a3 = 0.f;
#pragma unroll
                for (int j = 0; j < 64; j += 4) { a0 += rdl(s, j) * cur[j * 64 + lane]; a1 += rdl(s, j + 1) * cur[(j + 1) * 64 + lane]; a2 += rdl(s, j + 2) * cur[(j + 2) * 64 + lane]; a3 += rdl(s, j + 3) * cur[(j + 3) * 64 + lane]; }
                acc += (a0 + a1) + (a2 + a3);
            }
            Lp[(size_t)c * 4096] = s; s = acc; Lc = Ln;
            asm volatile("s_waitcnt lgkmcnt(0)" ::: "memory"); __builtin_amdgcn_s_barrier(); asm volatile("" ::: "memory");
        }
    }
}
DEV void scan_pass2(const Params& p, int l, LAS unsigned char* lds) {
    const int tid = tid_fresh(), lane = tid & 63, wv = __builtin_amdgcn_readfirstlane(tid >> 6);
    const bf16* SC = (const bf16*)(p.ws + WS_SC); const float* LS = (const float*)(p.ws + WS_LS);
    const bf16* G = (const bf16*)(p.ws + WS_G); const float* BON = (const float*)(p.ws + WS_BON); bf16* U = (bf16*)(p.ws + WS_U);
    LAS unsigned char* ring = lds + wv * 1536;
    const int voff = ((lane >> 3) & 3) * 192 + 160 + (lane >> 5) * 16 + (lane & 7) * 2;
    for (int u = blockIdx.x * 8 + wv; u < 32 * NCH; u += gridDim.x * 8) {
        const int bh = u / NCH, c = u % NCH, b = bh >> 3, hh = bh & 7;
        const bf16* rec = SC + (size_t)u * CH * SCH;
        const float lg = p.in[23][l * 512 + hh * 64 + lane], lb = p.in[24][l * 512 + hh * 64 + lane];
        float S[64];
        const float* s0 = LS + ((size_t)u * 64 + lane) * 64;
#pragma unroll
        for (int j = 0; j < 64; j += 4) { const f32x4 v = *(const f32x4*)(s0 + j); S[j] = v.x; S[j + 1] = v.y; S[j + 2] = v.z; S[j + 3] = v.w; }
        RecRegs r1, r2, r3;
        { RecRegs r0; rec_load(r0, rec, lane); rec_put(r0, ring, lane); }
        rec_load(r1, rec + SCH, lane); rec_load(r2, rec + 2 * SCH, lane);
        float sa = 0.f;
        if (c > 0) {
#pragma unroll
            for (int b8 = 0; b8 < 8; ++b8) { const u32x4 kv = *(const LAS u32x4*)(ring + BLK_OFF(b8) + 64);
#pragma unroll
                for (int e = 0; e < 4; ++e) { sa -= S[BLK_J0(b8) + 2 * e] * h2f((unsigned short)(kv[e] & 0xffffu)); sa -= S[BLK_J0(b8) + 2 * e + 1] * h2f((unsigned short)(kv[e] >> 16)); } }
        }
        const int m0 = b * SEQ + c * CH;
        for (int t = 0; t < CH; t += 2) {
#pragma unroll
            for (int h = 0; h < 2; ++h) {
                LAS unsigned char* cur = ring + h * 768; LAS unsigned char* nxt = ring + (h ^ 1) * 768;
                rec_load(r3, rec + 3 * SCH, lane);
                rec_put(r1, nxt, lane); r1 = r2; r2 = r3;
                const float vv = h2f(*(const LAS unsigned short*)(cur + voff));
                const int m = m0 + t + h;
                const float bon = BON[(size_t)m * NH + hh], gt = bf2f(G[(size_t)m * RW + hh * 64 + lane]);
                float o4[4] = {0.f, 0.f, 0.f, 0.f}, san4[4] = {0.f, 0.f, 0.f, 0.f};
#define P2_LD(X, B8) do { X##0 = *(const LAS u32x4*)(cur + BLK_OFF(B8)); X##1 = *(const LAS u32x4*)(cur + BLK_OFF(B8) + 16); X##2 = *(const LAS u32x4*)(cur + BLK_OFF(B8) + 32); X##3 = *(const LAS u32x4*)(cur + BLK_OFF(B8) + 48); X##4 = *(const LAS u32x4*)(nxt + BLK_OFF(B8) + 64); } while (0)
#define P2_CB(J0, H, D, A, P, R, K) blk4h_full(S[(J0)], S[(J0) + 1], S[(J0) + 2], S[(J0) + 3], o4, san4, sa, vv, D[2 * (H)], D[2 * (H) + 1], A[2 * (H)], A[2 * (H) + 1], P[2 * (H)], P[2 * (H) + 1], R[2 * (H)], R[2 * (H) + 1], K[2 * (H)], K[2 * (H) + 1])
#define P2_BLK(B8, X, Y) do { if ((B8) < 7) P2_LD(Y, (B8) + 1); __builtin_amdgcn_sched_barrier(0); P2_CB(BLK_J0(B8), 0, X##0, X##1, X##2, X##3, X##4); P2_CB(BLK_J0(B8) + 4, 1, X##0, X##1, X##2, X##3, X##4); __builtin_amdgcn_sched_barrier(0); } while (0)
                u32x4 oa0, oa1, oa2, oa3, oa4, ob0, ob1, ob2, ob3, ob4;
                P2_LD(oa, 0);
                P2_BLK(0, oa, ob); P2_BLK(1, ob, oa); P2_BLK(2, oa, ob); P2_BLK(3, ob, oa); P2_BLK(4, oa, ob); P2_BLK(5, ob, oa); P2_BLK(6, oa, ob); P2_BLK(7, ob, oa);
#undef P2_LD
#undef P2_CB
#undef P2_BLK
                sa = -((san4[0] + san4[1]) + (san4[2] + san4[3])); rec += SCH;
                const float o = (o4[0] + o4[1]) + (o4[2] + o4[3]);
                const float mean = wave_sum(o) * (1.0f / 64.0f), dlt = o - mean;
                const float var = wave_sum(dlt * dlt) * (1.0f / 64.0f);
                const float on = dlt * (1.0f / sqrtf(var + GN_EPS)) * lg + lb;
                U[(size_t)m * D + 512 + hh * 64 + lane] = (bf16)f2bf((on + bon * vv) * gt);
            }
        }
        asm volatile("" :: "v"(r1.g2), "v"(r1.g1), "v"(r2.g2), "v"(r2.g1));
    }
}

template <bool MOE>
DEV void final_phase(const Params& p) {
    const int tid = tid_fresh(), lane = tid & 63, wv = tid >> 6;
    const float* g = p.in[38]; float* X = p.out;
    const bf16* Y = (const bf16*)(p.ws + WS_Y);
    const float* MOD = (const float*)(p.ws + WS_MOD);
    const int nw = gridDim.x * 8;
    for (int r0 = blockIdx.x * 8 + wv; r0 < T; r0 += 2 * nw) {
        f32x4 v[2][4]; u32x2 y0[2][4], y1[2][4];
#pragma unroll
        for (int k = 0; k < 2; ++k) { const int r = r0 + k * nw < T ? r0 + k * nw : r0;
#pragma unroll
            for (int j = 0; j < 4; ++j) { const int d = 4 * lane + 256 * j; v[k][j] = *(const f32x4*)(X + (size_t)r * D + d);
                if (MOE) { y0[k][j] = *(const u32x2*)(Y + (size_t)r * D + d); y1[k][j] = *(const u32x2*)(Y + (size_t)(T + r) * D + d); } } }
#pragma unroll
        for (int k = 0; k < 2; ++k) { const int r = r0 + k * nw;
            if (r < T) {
                const int b = r / SEQ;
                const float* gate = MOD + (size_t)(3 * 4 + b) * 3072 + 2048;
                float ss = 0.f;
#pragma unroll
                for (int j = 0; j < 4; ++j) { const int d = 4 * lane + 256 * j;
                    if (MOE) { const f32x4 gt = *(const f32x4*)(gate + d); f32x4 ys;
                        ys.x = __uint_as_float(y0[k][j].x << 16) + __uint_as_float(y1[k][j].x << 16); ys.y = __uint_as_float(y0[k][j].x & 0xffff0000u) + __uint_as_float(y1[k][j].x & 0xffff0000u);
                        ys.z = __uint_as_float(y0[k][j].y << 16) + __uint_as_float(y1[k][j].y << 16); ys.w = __uint_as_float(y0[k][j].y & 0xffff0000u) + __uint_as_float(y1[k][j].y & 0xffff0000u);
                        v[k][j] += gt * ys; }
                    ss += (v[k][j].x * v[k][j].x + v[k][j].y * v[k][j].y) + (v[k][j].z * v[k][j].z + v[k][j].w * v[k][j].w); }
                const float rstd = 1.0f / sqrtf(wave_sum(ss) * (1.0f / D) + RMS_EPS);
#pragma unroll
                for (int j = 0; j < 4; ++j) { const int d = 4 * lane + 256 * j; *(f32x4*)(X + (size_t)r * D + d) = v[k][j] * rstd * *(const f32x4*)(g + d); }
            } }
    }
}

namespace pg8 {
typedef short bf16x8 __attribute__((ext_vector_type(8)));
constexpr int BM = 256, BK = 64, HALF = 128, HTB = HALF * BK * 2  , STAGE_BYTES = 8 * HTB, NXCD = 8, WGM = 8;
DEV int lds_byte(int r, int c) { const int st = (r >> 4) * 2 + (c >> 5), rr = r & 15, cc = c & 31, ob = rr * 64 + cc * 2; return st * 1024 + (ob ^ (((ob >> 9) & 1) << 5)); }
DEV void stage_rc(int b, int& R, int& C) { const int st = b / 1024, sb = b % 1024, swz = sb ^ (((sb >> 9) & 1) << 5); R = (st >> 1) * 16 + swz / 64; C = (st & 1) * 32 + (swz % 64) / 2; }
DEV int perm32(int rho) { const int n = rho >> 4, i = rho & 15; return 8 * (i >> 2) + 4 * n + (i & 3); }
struct Unit { int pm, pn; };
struct StaticOrder {
    const char* A; const char* Bt; int lda, ldb; int nM, nN, nwg, G, c;
    DEV void init(const void* A_, int lda_, const void* Bt_, int ldb_, int nM_, int nN_, int G_, int c_) { A = (const char*)A_; Bt = (const char*)Bt_; lda = lda_; ldb = ldb_; nM = nM_; nN = nN_; nwg = nM * nN; G = G_; c = c_; }
    DEV bool map(long L, Unit& u) const {
        if (L >= nwg) return false;
        int wgid = (int)L; { const int q = nwg / NXCD, r = nwg % NXCD, xcd = wgid % NXCD, off = wgid / NXCD; wgid = (xcd < r ? xcd * (q + 1) : r * (q + 1) + (xcd - r) * q) + off; }
        const int nig = WGM * nN, gid = wgid / nig, fm = gid * WGM, gsz = (nM - fm) < WGM ? (nM - fm) : WGM;
        u.pm = fm + ((wgid % nig) % gsz); u.pn = (wgid % nig) / gsz; return true;
    }
    DEV bool next(int i, Unit& u) const { return map((long)i * G + c, u); }
    DEV const char* a_ptr(const Unit& u) const { return A + (size_t)u.pm * BM * lda * 2; }
    DEV const char* b_ptr(const Unit& u) const { return Bt + (size_t)u.pn * BM * ldb * 2; }
};
struct InOrderA : StaticOrder {
    DEV bool next(int i, Unit& u) const { if (!StaticOrder::next(i, u)) return false; u.pn = u.pn < 7 ? u.pn : u.pn + 12; return true; }
};
struct InOrderG : StaticOrder {
    DEV bool next(int i, Unit& u) const {
        bool ok;
        if (G != 256 || nwg != 768) ok = StaticOrder::next(i, u);
        else if (i < 2) ok = map((long)i * 256 + c, u);
        else if (i < 4 && c >= 128) ok = map(512 + (long)(i - 2) * 128 + (c - 128), u);
        else ok = false;
        if (ok) u.pn += 7;
        return ok;
    }
    DEV const char* b_ptr(const Unit& u) const { return Bt + (size_t)(u.pn - 7) * BM * ldb * 2; }
};
template <class Epi, class Sched, bool FP8 = false>
DEV void gemm_phase(LAS unsigned char* lds, const int K, const int lda, const int ldb, const Sched& S, const Epi& E) {
    const int tid = tid_fresh(), wid = __builtin_amdgcn_readfirstlane(tid >> 6), lane = tid & 63, wr = wid >> 2, wc = wid & 3, fr = lane & 15, fq = lane >> 4;
    const int nt = K / BK;
    unsigned voffA[2], voffB[2];
#pragma unroll
    for (int i = 0; i < 2; ++i) { int R, C; stage_rc(tid * 16 + i * 8192, R, C); const int Rb = (R & ~31) + perm32(R & 31);
        voffA[i] = (unsigned)(R * lda + C) * 2u; voffB[i] = (unsigned)(Rb * ldb + C) * 2u; }
    const size_t kstep = (size_t)(BK * 2);
    const size_t hstepA = (size_t)HALF * lda * 2, hstepB = (size_t)HALF * ldb * 2;
    const unsigned ldsw = (unsigned)wid * 1024u;
    const int aoff = lds_byte(wr * 64 + fr, fq * 8), boff = lds_byte(wc * 32 + fr, fq * 8);
#define PG8_SA(b, h) (((b) * 2 + (h)) * HTB)
#define PG8_SB(b, h) ((4 + (b) * 2 + (h)) * HTB)
#define PG8_STAGE(bufoff, gbase, voff) do { _Pragma("unroll") for (int _i = 0; _i < 2; ++_i) \
        __builtin_amdgcn_global_load_lds((const unsigned*)((const char*)(gbase) + (voff)[_i]), (LAS unsigned*)(lds + (bufoff) + ldsw + _i * 8192), 16, 0, 0); } while (0)
#define PG8_LD8(p_) __builtin_shufflevector(*(const LAS v4i_*)(p_), *(const LAS v4i_*)((p_) + 1024), 0, 1, 2, 3, 4, 5, 6, 7)
#define PG8_LDA(dst, b, h) do { _Pragma("unroll") for (int m = 0; m < 4; ++m) { if constexpr (FP8) dst##8[m] = PG8_LD8(lds + PG8_SA(b, h) + aoff + m * 2048); else { _Pragma("unroll") for (int k = 0; k < 2; ++k) dst[m][k] = *(const LAS bf16x8*)(lds + PG8_SA(b, h) + aoff + m * 2048 + k * 1024); } } } while (0)
#define PG8_LDB(dst, b, h) do { _Pragma("unroll") for (int n = 0; n < 2; ++n) { if constexpr (FP8) dst##8[n] = PG8_LD8(lds + PG8_SB(b, h) + boff + n * 2048); else { _Pragma("unroll") for (int k = 0; k < 2; ++k) dst[n][k] = *(const LAS bf16x8*)(lds + PG8_SB(b, h) + boff + n * 2048 + k * 1024); } } } while (0)
#define PG8_MMA(ai, bj, At, Bt) do { __builtin_amdgcn_s_setprio(1); _Pragma("unroll") for (int m = 0; m < 4; ++m) _Pragma("unroll") for (int n = 0; n < 2; ++n) { \
        if constexpr (FP8) asm volatile("v_mfma_scale_f32_16x16x128_f8f6f4 %0, %1, %2, %0, %3, %3 op_sel_hi:[0,0,0]" : "+v"(acc[ai][bj][m][n]) : "v"(Bt##8[n]), "v"(At##8[m]), "v"(one_scale));   \
        else { _Pragma("unroll") for (int k = 0; k < 2; ++k) acc[ai][bj][m][n] = __builtin_amdgcn_mfma_f32_16x16x32_bf16(Bt[n][k], At[m][k], acc[ai][bj][m][n], 0, 0, 0); } } \
        __builtin_amdgcn_s_setprio(0); } while (0)
#define PG8_WAIT_V(n) asm volatile("s_waitcnt vmcnt(" #n ")" ::: "memory")
#define PG8_WAIT_L(n) asm volatile("s_waitcnt lgkmcnt(" #n ")" ::: "memory")
#define PG8_BAR __builtin_amdgcn_s_barrier()
#define PG8_SCHED __builtin_amdgcn_sched_barrier(0)
#define PG8_PIN do { if constexpr (FP8) __builtin_amdgcn_sched_barrier(0); } while (0)
    Unit cur, nxt; int ui = 0;
    if (!S.next(0, cur)) return;
    f32x4 acc[2][2][4][2];
#pragma unroll
    for (int a = 0; a < 2; ++a)
#pragma unroll
        for (int b = 0; b < 2; ++b)
#pragma unroll
            for (int m = 0; m < 4; ++m)
#pragma unroll
                for (int n = 0; n < 2; ++n) acc[a][b][m][n] = (f32x4){0.f, 0.f, 0.f, 0.f};
    typedef int v8i_ __attribute__((ext_vector_type(8))); typedef int v4i_ __attribute__((ext_vector_type(4)));
    const int one_scale = 0x7f7f7f7f;
    bf16x8 At[4][2], B0[2][2], B1[2][2]; v8i_ At8[4], B08[2], B18[2];
    const char* cA = S.a_ptr(cur); const char* cB = S.b_ptr(cur);
    PG8_STAGE(PG8_SB(0, 0), cB, voffB); PG8_STAGE(PG8_SB(0, 1), cB + hstepB, voffB); PG8_STAGE(PG8_SA(0, 0), cA, voffA); PG8_STAGE(PG8_SA(0, 1), cA + hstepA, voffA);
    if (wr == 1) PG8_BAR;
    PG8_WAIT_V(2); PG8_BAR;
    PG8_STAGE(PG8_SB(1, 0), cB + kstep, voffB); PG8_STAGE(PG8_SA(1, 0), cA + kstep, voffA); PG8_STAGE(PG8_SB(1, 1), cB + hstepB + kstep, voffB);
    PG8_WAIT_V(6); PG8_BAR;
    for (;;) {
        const bool has_next = S.next(ui + 1, nxt);
        const char* nA = has_next ? S.a_ptr(nxt) : cA; const char* nB = has_next ? S.b_ptr(nxt) : cB;
        for (int t = 0; t < nt; t += 2) {
            const bool last = (t == nt - 2);
            const char* a1 = cA + (size_t)(t + 1) * kstep;
            const char* a2 = last ? nA : cA + (size_t)(t + 2) * kstep; const char* b2 = last ? nB : cB + (size_t)(t + 2) * kstep;
            const char* a3 = a2 + kstep; const char* b3 = b2 + kstep;
            if constexpr (Epi::NMID > 0) { if (t == Epi::MID0 || t == Epi::MID1) E.mid(acc, cur, t == Epi::MID0 ? 0 : 1, wr, wc, fr, fq); }
            PG8_LDB(B0, 0, 0); PG8_LDB(B1, 0, 1); PG8_SCHED; PG8_LDA(At, 0, 0); PG8_STAGE(PG8_SA(1, 1), a1 + hstepA, voffA);
            PG8_WAIT_V(8); PG8_WAIT_L(0); PG8_BAR; PG8_PIN; PG8_MMA(0, 0, At, B0); PG8_MMA(0, 1, At, B1); PG8_PIN; PG8_BAR; PG8_SCHED;
            PG8_LDA(At, 0, 1); PG8_STAGE(PG8_SB(0, 0), b2, voffB); PG8_STAGE(PG8_SB(0, 1), b2 + hstepB, voffB); PG8_STAGE(PG8_SA(0, 0), a2, voffA);
            PG8_WAIT_V(8); PG8_WAIT_L(0); PG8_BAR; PG8_PIN; PG8_MMA(1, 0, At, B0); PG8_MMA(1, 1, At, B1); PG8_PIN; PG8_BAR; PG8_SCHED;
            PG8_LDB(B0, 1, 0); PG8_LDB(B1, 1, 1); PG8_SCHED; PG8_LDA(At, 1, 0); PG8_STAGE(PG8_SA(0, 1), a2 + hstepA, voffA);
            PG8_WAIT_V(8); PG8_WAIT_L(0); PG8_BAR; PG8_PIN; PG8_MMA(0, 0, At, B0); PG8_MMA(0, 1, At, B1); PG8_PIN; PG8_BAR; PG8_SCHED;
            PG8_LDA(At, 1, 1); PG8_STAGE(PG8_SB(1, 0), b3, voffB); PG8_STAGE(PG8_SB(1, 1), b3 + hstepB, voffB); PG8_STAGE(PG8_SA(1, 0), a3, voffA);
            PG8_WAIT_V(8); PG8_WAIT_L(0); PG8_BAR; PG8_PIN; PG8_MMA(1, 0, At, B0); PG8_MMA(1, 1, At, B1); PG8_PIN; PG8_BAR; PG8_SCHED;
        }
        if (wr == 0) PG8_BAR;
        if constexpr (FP8) asm volatile("s_nop 15\n s_nop 15\n s_nop 7" ::: "memory");
        E(acc, cur, wr, wc, fr, fq);
        if (!has_next) break;
#pragma unroll
        for (int a = 0; a < 2; ++a)
#pragma unroll
            for (int b = 0; b < 2; ++b)
#pragma unroll
                for (int m = 0; m < 4; ++m)
#pragma unroll
                    for (int n = 0; n < 2; ++n) acc[a][b][m][n] = (f32x4){0.f, 0.f, 0.f, 0.f};
        cur = nxt; cA = nA; cB = nB; ++ui;
        if (wr == 1) PG8_BAR;
    }
    PG8_WAIT_V(0);
    PG8_BAR;
#undef PG8_SA
#undef PG8_SB
#undef PG8_STAGE
#undef PG8_LDA
#undef PG8_LD8
#undef PG8_LDB
#undef PG8_MMA
#undef PG8_WAIT_V
#undef PG8_WAIT_L
#undef PG8_BAR
#undef PG8_SCHED
#undef PG8_PIN
}
}

typedef f32x4 Acc[2][2][4][2];
DEV unsigned cvt_pk_bf16(float lo, float hi) { unsigned r; asm volatile("v_cvt_pk_bf16_f32 %0, %1, %2" : "=v"(r) : "v"(lo), "v"(hi)); return r; }
DEV float fsig(float x) { return __builtin_amdgcn_rcpf(1.0f + __builtin_amdgcn_exp2f(-1.44269504f * x)); }
DEV u32x4 pack8(const f32x4& a, const f32x4& b) { u32x4 w; w.x = cvt_pk_bf16(a.x, a.y); w.y = cvt_pk_bf16(a.z, a.w); w.z = cvt_pk_bf16(b.x, b.y); w.w = cvt_pk_bf16(b.z, b.w); return w; }
struct EpiZ { unsigned char* ws; float zs;
    static constexpr int NMID = 0, MID0 = -1, MID1 = -1;
    DEV void operator()(const Acc& acc, const pg8::Unit& u, int wr, int wc, int fr, int fq) const {
        bf16* base; int ld, colt; bool sig = false;
        if (u.pn < 7) { base = (bf16*)(ws + WS_ZR); ld = ZR_W; colt = u.pn * 256; }
        else if (u.pn < 19) { base = (bf16*)(ws + WS_ZG); ld = ZG_W; colt = (u.pn - 7) * 256; sig = true; }
        else if (u.pn == 19) { base = (bf16*)(ws + WS_ZP); ld = ZP_W; colt = 0; }
        else { base = (bf16*)(ws + WS_ZC); ld = ZC_W; colt = (u.pn - 20) * 256; }
        const int row0 = u.pm * 256 + wr * 64 + fr, col0 = colt + wc * 32 + 8 * fq;
#pragma unroll
        for (int ai = 0; ai < 2; ++ai)
#pragma unroll
            for (int m = 0; m < 4; ++m) { bf16* rowp = base + (size_t)(row0 + ai * 128 + m * 16) * ld + col0;
#pragma unroll
                for (int bj = 0; bj < 2; ++bj) { f32x4 v0 = acc[ai][bj][m][0], v1 = acc[ai][bj][m][1];
                    if (sig) {
#pragma unroll
                        for (int e = 0; e < 4; ++e) { v0[e] = fsig(v0[e] * zs); v1[e] = fsig(v1[e] * zs); } }
                    *(u32x4*)(rowp + bj * 128) = pack8(v0, v1); } }
    } };
struct EpiMix { const bf16* Zg; bf16* O;
    static constexpr int NMID = 2, MID0 = 4, MID1 = 8;
    DEV void mid(Acc& acc, const pg8::Unit& u, int seg, int wr, int wc, int fr, int fq) const {
        const int row0 = u.pm * 256 + wr * 64 + fr, col0 = u.pn * 256 + wc * 32 + 8 * fq;
        const bf16* gp = Zg + (size_t)row0 * ZG_W + seg * 1024 + col0;
#pragma unroll
        for (int ai = 0; ai < 2; ++ai) {
            u32x4 nv[4][2], dv[4][2];
#pragma unroll
            for (int m = 0; m < 4; ++m) { const bf16* q = gp + (size_t)(ai * 128 + m * 16) * ZG_W;
#pragma unroll
                for (int bj = 0; bj < 2; ++bj) { nv[m][bj] = *(const u32x4*)(q + bj * 128); dv[m][bj] = *(const u32x4*)(q + 1024 + bj * 128); } }
#pragma unroll
            for (int m = 0; m < 4; ++m)
#pragma unroll
                for (int bj = 0; bj < 2; ++bj) { f32x4 n0, n1, d0, d1; unpack8(nv[m][bj], n0, n1); unpack8(dv[m][bj], d0, d1);
#pragma unroll
                    for (int e = 0; e < 4; ++e) { acc[ai][bj][m][0][e] *= n0[e] * __builtin_amdgcn_rcpf(d0[e]); acc[ai][bj][m][1][e] *= n1[e] * __builtin_amdgcn_rcpf(d1[e]); } }
            asm volatile("" ::: "memory");
        }
    }
    DEV void operator()(const Acc& acc, const pg8::Unit& u, int wr, int wc, int fr, int fq) const {
        const int row0 = u.pm * 256 + wr * 64 + fr, col0 = u.pn * 256 + wc * 32 + 8 * fq;
#pragma unroll
        for (int ai = 0; ai < 2; ++ai) {
            u32x4 gv[4][2];
#pragma unroll
            for (int m = 0; m < 4; ++m)
#pragma unroll
                for (int bj = 0; bj < 2; ++bj) gv[m][bj] = *(const u32x4*)(Zg + (size_t)(row0 + ai * 128 + m * 16) * ZG_W + 2048 + col0 + bj * 128);
#pragma unroll
            for (int m = 0; m < 4; ++m)
#pragma unroll
                for (int bj = 0; bj < 2; ++bj) { f32x4 g0, g1; unpack8(gv[m][bj], g0, g1);
                    *(u32x4*)(O + (size_t)(row0 + ai * 128 + m * 16) * D + col0 + bj * 128) = pack8(acc[ai][bj][m][0] * g0, acc[ai][bj][m][1] * g1); }
            asm volatile("" ::: "memory");
        }
    } };
struct EpiRes { const float* xin; float* xout; const float* gate;
    static constexpr int NMID = 0, MID0 = -1, MID1 = -1;
    DEV void operator()(const Acc& acc, const pg8::Unit& u, int wr, int wc, int fr, int fq) const {
        const int row0 = u.pm * 256 + wr * 64 + fr, col0 = u.pn * 256 + wc * 32 + 8 * fq;
        const float* g = gate + (size_t)(u.pm >> 4) * 3072 + col0;
        f32x4 gv[2][2];
#pragma unroll
        for (int bj = 0; bj < 2; ++bj)
#pragma unroll
            for (int n = 0; n < 2; ++n) gv[bj][n] = *(const f32x4*)(g + bj * 128 + 4 * n);
#pragma unroll
        for (int ai = 0; ai < 2; ++ai)
#pragma unroll
            for (int m = 0; m < 4; ++m) { const size_t off = (size_t)(row0 + ai * 128 + m * 16) * D + col0;
#pragma unroll
                for (int bj = 0; bj < 2; ++bj)
#pragma unroll
                    for (int n = 0; n < 2; ++n) { const f32x4 x = *(const f32x4*)(xin + off + bj * 128 + 4 * n); *(f32x4*)(xout + off + bj * 128 + 4 * n) = x + gv[bj][n] * acc[ai][bj][m][n]; }
                if (m == 3) asm volatile("" ::: "memory"); }
    } };
struct EpiSwi { bf16* O; int ldo, row_shift;
    static constexpr int NMID = 0, MID0 = -1, MID1 = -1;
    DEV void operator()(const Acc& acc, const pg8::Unit& u, int wr, int wc, int fr, int fq) const {
        const int row0 = u.pm * 256 - row_shift + wr * 64 + fr, col0 = u.pn * 128 + wc * 32 + 8 * fq;
#pragma unroll
        for (int ai = 0; ai < 2; ++ai)
#pragma unroll
            for (int m = 0; m < 4; ++m) { f32x4 h0, h1;
#pragma unroll
                for (int e = 0; e < 4; ++e) { const float a = acc[ai][0][m][0][e], b = acc[ai][0][m][1][e]; h0[e] = a * fsig(a) * acc[ai][1][m][0][e]; h1[e] = b * fsig(b) * acc[ai][1][m][1][e]; }
                *(u32x4*)(O + (size_t)(row0 + ai * 128 + m * 16) * ldo + col0) = pack8(h0, h1); }
    } };
struct EpiSwi8 { unsigned char* O; int ldo;
    static constexpr int NMID = 0, MID0 = -1, MID1 = -1;
    DEV void operator()(const Acc& acc, const pg8::Unit& u, int wr, int wc, int fr, int fq) const {
        const int row0 = u.pm * 256 + wr * 64 + fr, col0 = u.pn * 128 + wc * 32 + 8 * fq;
#pragma unroll
        for (int ai = 0; ai < 2; ++ai)
#pragma unroll
            for (int m = 0; m < 4; ++m) { f32x4 h0, h1;
#pragma unroll
                for (int e = 0; e < 4; ++e) { const float a = acc[ai][0][m][0][e] * (1.0f / 32.0f), b = acc[ai][0][m][1][e] * (1.0f / 32.0f);
                    h0[e] = a * fsig(a) * acc[ai][1][m][0][e] * (4.0f / 32.0f); h1[e] = b * fsig(b) * acc[ai][1][m][1][e] * (4.0f / 32.0f); }
                u32x2 o; o.x = pk4_fp8(h0[0], h0[1], h0[2], h0[3]); o.y = pk4_fp8(h1[0], h1[1], h1[2], h1[3]);
                *(u32x2*)(O + (size_t)(row0 + ai * 128 + m * 16) * ldo + col0) = o; }
    } };
struct EpiMoeDown { bf16* Y; const int* rowtk; const float* roww;
    static constexpr int NMID = 0, MID0 = -1, MID1 = -1;
    DEV void operator()(const Acc& acc, const pg8::Unit& u, int wr, int wc, int fr, int fq) const {
        const int row0 = u.pm * 256 + wr * 64 + fr, col0 = u.pn * 256 + wc * 32 + 8 * fq;
#pragma unroll
        for (int ai = 0; ai < 2; ++ai)
#pragma unroll
            for (int m = 0; m < 4; ++m) { const int r = row0 + ai * 128 + m * 16; const int tk = rowtk[r]; const float w = roww[r] * (1.0f / 256.0f);
                if (tk >= 0) { bf16* yp = Y + ((size_t)(tk & 1) * T + (size_t)(tk >> 1)) * D + col0;
#pragma unroll
                    for (int bj = 0; bj < 2; ++bj) *(u32x4*)(yp + bj * 128) = pack8(acc[ai][bj][m][0] * w, acc[ai][bj][m][1] * w); } }
    } };
constexpr int MOE_NG = 1;
struct MoeOrder {
    const char* A; const char* Bt; int lda, ldb; size_t estride; int t0, ashift, nM, nN, nwg, G, c; int toff[9];
    DEV void init(const void* A_, int lda_, const void* Bt_, int ldb_, size_t estride_, const unsigned* cnt, int grp, int rel, int nN_, int G_, int c_) {
        A = (const char*)A_; Bt = (const char*)Bt_; lda = lda_; ldb = ldb_; estride = estride_; nN = nN_; G = G_; c = c_;
        int s = 0;
#pragma unroll
        for (int e = 0; e < 8; ++e) { toff[e] = s; s += ((int)cnt[e * 32] + 255) >> 8; }
        toff[8] = s;
        const int per = (s + MOE_NG - 1) / MOE_NG; t0 = grp * per; int t1 = t0 + per; if (t1 > s) t1 = s; if (t0 > s) t0 = s; nM = t1 - t0; nwg = nM * nN; ashift = rel ? t0 : 0;
    }
    DEV bool next(int i, pg8::Unit& u) const {
        const long L = (long)i * G + c; if (L >= nwg) return false;
        int wgid = (int)L; { const int q = nwg / 8, r = nwg % 8, xcd = wgid % 8, off = wgid / 8; wgid = (xcd < r ? xcd * (q + 1) : r * (q + 1) + (xcd - r) * q) + off; }
        const int nig = 8 * nN, gid = wgid / nig, fm = gid * 8, gsz = (nM - fm) < 8 ? (nM - fm) : 8;
        u.pm = t0 + fm + ((wgid % nig) % gsz); u.pn = (wgid % nig) / gsz; return true;
    }
    DEV int expert(int pm) const { int e = 0;
#pragma unroll
        for (int q = 1; q < 8; ++q) e += (pm >= toff[q]) ? 1 : 0;
        return e; }
    DEV const char* a_ptr(const pg8::Unit& u) const { return A + (size_t)(u.pm - ashift) * 256 * lda * 2; }
    DEV const char* b_ptr(const pg8::Unit& u) const { return Bt + (size_t)expert(u.pm) * estride + (size_t)u.pn * 256 * ldb * 2; }
};

struct CvJob { const float* W; const float* W2; bf16* WT; int kind, ld, ldt, nnb; float f8;  };
DEV f32x4 cv_ld4(const CvJob& j, int k, int n) {
    const f32x4 z = (f32x4){0.f, 0.f, 0.f, 0.f};
    if (j.kind == 0) return *(const f32x4*)(j.W + (size_t)k * j.ld + n);
    if (j.kind == 2) { const int pn = n >> 8, c = n & 255; const float* W = j.W + (ptrdiff_t)(c >> 7) * (j.W2 - j.W); return *(const f32x4*)(W + (size_t)k * j.ld + pn * 128 + (c & 127)); }
    if (n < 1664) return *(const f32x4*)(j.W + (size_t)k * IN_COLS + OFF_RWKV + n);
    if (n < 1680) return j.W2 ? *(const f32x4*)(j.W2 + (size_t)k * 16 + (n - 1664)) : z;
    if (n < 1792) return z;
    if (n < 4864) return *(const f32x4*)(j.W + (size_t)k * IN_COLS + OFF_GATE + (n - 1792));
    if (n < 5120) return *(const f32x4*)(j.W + (size_t)k * IN_COLS + (n - 4864));
    return *(const f32x4*)(j.W + (size_t)k * IN_COLS + OFF_CONV + (n - 5120));
}
DEV void tr_load(const CvJob& j, int r, int lane, f32x4 (&v)[8]) {
    const int k0 = (r / j.nnb) * 64, n0 = (r % j.nnb) * 32, kr = lane >> 3, c4 = (lane & 7) * 4;
#pragma unroll
    for (int i = 0; i < 8; ++i) v[i] = cv_ld4(j, k0 + i * 8 + kr, n0 + c4);
}
DEV void tr_store(const f32x4 (&v)[8], const CvJob& j, int r, LAS float* scr, int lane) {
    const int k0 = (r / j.nnb) * 64, n0 = (r % j.nnb) * 32, kr = lane >> 3, c4 = (lane & 7) * 4;
#pragma unroll
    for (int i = 0; i < 8; ++i) { LAS float* s = scr + (i * 8 + kr) * 33 + c4; s[0] = v[i].x; s[1] = v[i].y; s[2] = v[i].z; s[3] = v[i].w; }
    asm volatile("s_waitcnt lgkmcnt(0)" ::: "memory");
    const int c = lane & 7;
#pragma unroll
    for (int jj = 0; jj < 4; ++jj) { const int n = (lane >> 3) + 8 * jj; const LAS float* s = scr + (8 * c) * 33 + n;
        if (j.f8 != 0.f) { const float f = j.f8; u32x2 o; o.x = pk4_fp8(f * s[0 * 33], f * s[1 * 33], f * s[2 * 33], f * s[3 * 33]); o.y = pk4_fp8(f * s[4 * 33], f * s[5 * 33], f * s[6 * 33], f * s[7 * 33]);
            *(u32x2*)((unsigned char*)j.WT + (size_t)(n0 + n) * j.ldt + k0 + 8 * c) = o; }
        else { u32x4 o; o.x = pk2(s[0 * 33], s[1 * 33]); o.y = pk2(s[2 * 33], s[3 * 33]); o.z = pk2(s[4 * 33], s[5 * 33]); o.w = pk2(s[6 * 33], s[7 * 33]);
            *(u32x4*)(j.WT + (size_t)(n0 + n) * j.ldt + k0 + 8 * c) = o; } }
    asm volatile("s_waitcnt lgkmcnt(0)" ::: "memory");
}
template <class Dec>
DEV void tr_run(const Dec& dec, int total, LAS float* scr, int gw, int ngw, int lane) {
    f32x4 va[8], vb[8]; CvJob ja, jb; int ra = 0, rb = 0;
    int it = gw;
    if (it < total) { dec(it, ja, ra); tr_load(ja, ra, lane, va); }
    for (; it < total; it += 2 * ngw) {
        const int i2 = it + ngw, i3 = it + 2 * ngw;
        if (i2 < total) { dec(i2, jb, rb); tr_load(jb, rb, lane, vb); }
        tr_store(va, ja, ra, scr, lane);
        if (i3 < total) { dec(i3, ja, ra); tr_load(ja, ra, lane, va); }
        if (i2 < total) tr_store(vb, jb, rb, scr, lane);
    }
}
struct DecPro { const Params* p;
    DEV void operator()(int it, CvJob& j, int& r) const {
        const Params& P = *p;
        if (it < 2 * 3712) { const int l = it / 3712; r = it % 3712;
            bf16* WmixT = (bf16*)(P.ws + WS_WMIX) + (size_t)l * D * D;
            if (r < 2816) { j = CvJob{P.in[5] + (size_t)l * D * IN_COLS, l ? P.in[26] : nullptr, (bf16*)(P.ws + WS_WIN) + (size_t)l * ZN * D, 1, IN_COLS, D, ZN / 32, 0.f}; return; }
            r -= 2816; if (r < 128) { j = CvJob{P.in[13] + (size_t)l * 256 * D, nullptr, WmixT + 256, 0, D, D, D / 32, 0.f}; return; }
            r -= 128; if (r < 256) { j = CvJob{P.in[25] + (size_t)l * 512 * D, nullptr, WmixT + 512, 0, D, D, D / 32, 0.f}; return; }
            r -= 256; j = CvJob{P.in[30] + (size_t)l * D * D, nullptr, (bf16*)(P.ws + WS_WO) + (size_t)l * D * D, 0, D, D, D / 32, 0.f}; return; }
        r = it - 2 * 3712;
        if (r < 2816) { j = CvJob{P.in[31], P.in[32], (bf16*)(P.ws + WS_W13), 2, DFF, D, 2 * DFF / 32, 0.f}; return; }
        r -= 2816; j = CvJob{P.in[33], nullptr, (bf16*)(P.ws + WS_W2), 0, D, DFF, D / 32, 0.f};
    } };
struct DecGate { const Params* p;
    DEV void operator()(int it, CvJob& j, int& r) const { const Params& P = *p; const int l = it / 1536; r = it % 1536;
        j = CvJob{P.in[5] + (size_t)l * D * IN_COLS + OFF_GATE, nullptr, (bf16*)(P.ws + WS_WIN8 + (size_t)l * ZG_W * D), 0, IN_COLS, D, ZG_W / 32, 32.0f}; } };
struct DecMoe { const Params* p;
    DEV void operator()(int it, CvJob& j, int& r) const {
        const Params& P = *p; const int e = it / 5376; r = it % 5376;
        if (r < 3584) { j = CvJob{P.in[35] + (size_t)e * D * DFE, P.in[36] + (size_t)e * D * DFE, (bf16*)(P.ws + WS_MW13 + (size_t)e * 2 * DFE * D), 2, DFE, D, 2 * DFE / 32, 32.0f}; return; }
        r -= 3584; j = CvJob{P.in[37] + (size_t)e * DFE * D, nullptr, (bf16*)(P.ws + WS_MW2 + (size_t)e * D * DFE), 0, D, DFE, D / 32, 64.0f};
    } };
DEV void convert_phase(const Params& p, LAS unsigned char* lds) {
    const int tid = tid_fresh(), lane = tid & 63, wv = __builtin_amdgcn_readfirstlane(tid >> 6);
    LAS float* scr = (LAS float*)(lds + 32768 + wv * 8704);
    const int gw = blockIdx.x * 8 + wv, ngw = gridDim.x * 8;
    for (int l = 0; l < NL; ++l) {
        bf16* WmixT = (bf16*)(p.ws + WS_WMIX) + (size_t)l * D * D;
        const float* pw = p.in[6] + (size_t)l * 4 * 64 * 64; const float* ps = p.in[7] + l * 256; const float* pp = p.in[8] + (size_t)l * 256 * D;
        for (int it = gw; it < 32 * 16; it += ngw) {
            const int k8 = it >> 4, n = (it & 15) * 64 + lane, g = k8 >> 3;
            float a[8];
#pragma unroll
            for (int e = 0; e < 8; ++e) a[e] = 0.f;
#pragma unroll 8
            for (int d = 0; d < 64; ++d) { const float pv = pp[(size_t)(g * 64 + d) * D + n] * ps[g * 64 + d];
#pragma unroll
                for (int e = 0; e < 8; ++e) a[e] += pw[(size_t)(k8 * 8 + e) * 64 + d] * pv; }
            u32x4 o; o.x = pk2(a[0], a[1]); o.y = pk2(a[2], a[3]); o.z = pk2(a[4], a[5]); o.w = pk2(a[6], a[7]);
            *(u32x4*)(WmixT + (size_t)n * D + k8 * 8) = o;
        }
    }
    for (int it = gw; it < 2 * 8 * 2 * 2 * 5; it += ngw) {
        const int kind = it % 5, hf = (it / 5) & 1, q = (it / 10) & 1, hh = (it / 20) & 7, l = it / 160, fr = lane & 15, fq = lane >> 4;
        const int ch = hh * 64 + q * 32 + (fr >> 2) * 8 + hf * 4 + (fr & 3);
        float t8[8];
#pragma unroll
        for (int e = 0; e < 8; ++e) { const int k = 8 * fq + e;
            t8[e] = kind == 0 ? p.in[16][(size_t)(l * 32 + k) * 512 + ch] : kind == 1 ? p.in[18][(size_t)(l * 32 + k) * 512 + ch] : kind == 2 ? p.in[19][(size_t)(l * 64 + k) * 512 + ch]
                  : kind == 3 ? p.in[19][(size_t)(l * 64 + 32 + k) * 512 + ch] : ((l && k < 16) ? p.in[29][(size_t)k * 512 + ch] : 0.f); }
        u32x4 o; o.x = pk2(t8[0], t8[1]); o.y = pk2(t8[2], t8[3]); o.z = pk2(t8[4], t8[5]); o.w = pk2(t8[6], t8[7]);
        *(u32x4*)((bf16*)(p.ws + WS_LORA) + ((size_t)it * 64 + lane) * 8) = o;
    }
    tr_run(DecPro{&p}, 2 * 3712 + 2816 + 1408, scr, gw, ngw, lane);
    tr_run(DecGate{&p}, 2 * 1536, scr, gw, ngw, lane);
}
DEV void convert_moe_phase(const Params& p, LAS unsigned char* lds) {
    const int tid = tid_fresh(), lane = tid & 63, wv = __builtin_amdgcn_readfirstlane(tid >> 6);
    LAS float* scr = (LAS float*)(lds + 32768 + wv * 8704);
    tr_run(DecMoe{&p}, NE * 5376, scr, blockIdx.x * 8 + wv, gridDim.x * 8, lane);
}
DEV void dispatch_phase(const Params& p) {
    const int tid = tid_fresh(), lane = tid & 63, wv = tid >> 6;
    const unsigned* cnt = (const unsigned*)(p.ws + WS_CTL);
    const int* LT = (const int*)(p.ws + WS_LTOK); const float* LW = (const float*)(p.ws + WS_LW);
    int* RT = (int*)(p.ws + WS_ROWTK); float* RW_ = (float*)(p.ws + WS_ROWW);
    const bf16* H = (const bf16*)(p.ws + WS_H); bf16* Hs = (bf16*)(p.ws + WS_HS);
    int off[9]; { int s = 0;
#pragma unroll
        for (int e = 0; e < 8; ++e) { off[e] = s; s += (((int)cnt[e * 32] + 255) >> 8) << 8; } off[8] = s; }
    const int nw = gridDim.x * 8;
    for (int row0 = blockIdx.x * 8 + wv; row0 < off[8]; row0 += 4 * nw) {
        int tk[4]; float w[4]; u32x4 v0[4], v1[4];
#pragma unroll
        for (int k = 0; k < 4; ++k) { const int row = row0 + k * nw; tk[k] = -1; w[k] = 0.f;
            if (row < off[8]) { int e = 0;
#pragma unroll
                for (int q = 1; q < 8; ++q) e += (row >= off[q]) ? 1 : 0;
                const int idx = row - off[e];
                if (idx < (int)cnt[e * 32]) { tk[k] = LT[e * T + idx]; w[k] = LW[e * T + idx]; } } }
#pragma unroll
        for (int k = 0; k < 4; ++k) { v0[k] = (u32x4){0u, 0u, 0u, 0u}; v1[k] = v0[k];
            if (tk[k] >= 0) { const bf16* hr = H + (size_t)(tk[k] >> 1) * D; v0[k] = *(const u32x4*)(hr + lane * 16); v1[k] = *(const u32x4*)(hr + lane * 16 + 8); } }
#pragma unroll
        for (int k = 0; k < 4; ++k) { const int row = row0 + k * nw;
            if (row < off[8]) { f32x4 a0, a1, b0, b1; unpack8(v0[k], a0, a1); unpack8(v1[k], b0, b1);
                u32x4 o; o.x = pk4_fp8(a0[0], a0[1], a0[2], a0[3]); o.y = pk4_fp8(a1[0], a1[1], a1[2], a1[3]); o.z = pk4_fp8(b0[0], b0[1], b0[2], b0[3]); o.w = pk4_fp8(b1[0], b1[1], b1[2], b1[3]);
                *(u32x4*)((unsigned char*)Hs + (size_t)row * D + lane * 16) = o;
                if (lane == 0) { RT[row] = tk[k]; RW_[row] = w[k]; } } }
    }
}

#define XB_TMO      128
#define XB_XCNT(j)  (256  + 64 * (j))
#define XB_XSUB(j)  (1280 + 64 * (j))
#define XB_XGEN(j)  (2304 + 64 * (j))
#define XB_TOP      3328
#define XB_TOPGEN   3392
#define XCD_BAR_WORDS 3456
#define XB_SPIN_CAP (1u << 18)
__device__ __forceinline__ unsigned xb_ld(unsigned* p)              { return __hip_atomic_load(p, __ATOMIC_RELAXED, __HIP_MEMORY_SCOPE_AGENT); }
__device__ __forceinline__ unsigned xb_add(unsigned* p, unsigned v) { return __hip_atomic_fetch_add(p, v, __ATOMIC_RELAXED, __HIP_MEMORY_SCOPE_AGENT); }
__device__ __forceinline__ unsigned xb_xcc_id() { return (unsigned)__builtin_amdgcn_s_getreg((3 << 11) | 20) & 0xFu; }
#define XB_SPIN(cond, bar) do { unsigned _sp = 0; while (cond) { __builtin_amdgcn_s_sleep(1); \
    if ((++_sp & 255u) == 0u) { if (xb_ld(&(bar)[XB_TMO])) break; if (_sp > XB_SPIN_CAP) { atomicAdd(&(bar)[XB_TMO], 1u); break; } } } } while (0)
struct XcdBarrier { unsigned* bar; unsigned x; volatile LAS unsigned* st; };
__device__ __forceinline__ XcdBarrier xcd_barrier_post(unsigned* bar, volatile LAS unsigned* st) {
    XcdBarrier b; b.bar = bar; b.x = xb_xcc_id(); b.st = st;
    if (threadIdx.x == 0) (void)xb_add(&bar[XB_XCNT(b.x)], 1u);
    return b;
}
__device__ __forceinline__ void xcd_barrier_complete(unsigned* bar, unsigned x, unsigned& nloc, unsigned& nx) {
    const unsigned G = gridDim.x * gridDim.y * gridDim.z;
    unsigned sum, cnt, mine, sp = 0u;
    for (;;) {
        sum = 0u; cnt = 0u; mine = 0u;
#pragma unroll
        for (unsigned j = 0; j < 16; ++j) { const unsigned c = xb_ld(&bar[XB_XCNT(j)]); sum += c; cnt += (c > 0u) ? 1u : 0u; mine = (j == x) ? c : mine; }
        if (sum == G) break;
        __builtin_amdgcn_s_sleep(1);
        if ((++sp & 255u) == 0u) { if (xb_ld(&bar[XB_TMO])) break; if (sp > XB_SPIN_CAP) { atomicAdd(&bar[XB_TMO], 1u); break; } }
    }
    nloc = mine > 0u ? mine : 1u; nx = cnt > 0u ? cnt : 1u;
}
__device__ __forceinline__ void xcd_barrier(const XcdBarrier& b) {
    asm volatile("s_waitcnt vmcnt(0)" ::: "memory");
    __syncthreads();
    if (threadIdx.x == 0) {
        unsigned* bar = b.bar;
        __builtin_amdgcn_s_waitcnt(0);
        unsigned nloc = b.st[0], nx = b.st[1];
        if (nloc == 0u) { xcd_barrier_complete(bar, b.x, nloc, nx); b.st[0] = nloc; b.st[1] = nx; }
        const unsigned old = xb_add(&bar[XB_XSUB(b.x)], 1u);
        const unsigned gen = old / nloc;
        if (old + 1u == (gen + 1u) * nloc) {
            __builtin_amdgcn_fence(__ATOMIC_RELEASE, "agent");
            asm volatile("s_waitcnt vmcnt(0)" ::: "memory");
            const unsigned og = xb_add(&bar[XB_TOP], 1u);
            const unsigned tg = og / nx;
            if (og + 1u == (tg + 1u) * nx) xb_add(&bar[XB_TOPGEN], 1u);
            else XB_SPIN(xb_ld(&bar[XB_TOPGEN]) == tg, bar);
            __builtin_amdgcn_fence(__ATOMIC_ACQUIRE, "agent");
            xb_add(&bar[XB_XGEN(b.x)], 1u);
            asm volatile("s_waitcnt vmcnt(0)" ::: "memory");
        } else {
            XB_SPIN(xb_ld(&bar[XB_XGEN(b.x)]) == gen, bar);
            __builtin_amdgcn_fence(__ATOMIC_ACQUIRE, "agent");
            asm volatile("s_waitcnt vmcnt(0)" ::: "memory");
        }
    }
    __syncthreads();
}

constexpr int LDS_BYTES = 147456;
constexpr int MISC_OFF = 131072 + 320;
constexpr int NPH = 29;
__global__ void __launch_bounds__(512, 2) fwd(const Params p, const int lo, const int hi) {
    extern __shared__ __attribute__((aligned(16))) unsigned char lds_[];
    LAS unsigned char* lds = (LAS unsigned char*)lds_;
    volatile LAS unsigned* MISC = (volatile LAS unsigned*)(lds + MISC_OFF);
    for (int u = threadIdx.x; u < (LDS_BYTES - 131072) / 4; u += 512) ((LAS unsigned*)(lds + 131072))[u] = 0u;
    __syncthreads();
    unsigned* ctl = (unsigned*)(p.ws + WS_CTL);
    XcdBarrier bar; bar.bar = ctl + 1024; bar.x = 0; bar.st = nullptr;
    if (hi - lo > 1) bar = xcd_barrier_post(ctl + 1024, MISC + 8);
#ifndef ENMASK
#define ENMASK 0xFFFFFFFFu
#endif
#define EN(x) (((ENMASK) >> (x)) & 1u)
#define IN(k) (lo <= (k) && (k) < hi)
#define SEAM(k) do { if (IN(k) && IN((k) + 1)) xcd_barrier(bar); } while (0)
#ifndef PROF_SEL
#define PROF_SEL -1
#endif
    volatile LAS unsigned long long* pfw = (volatile LAS unsigned long long*)(lds + MISC_OFF + 64);
#define TICK(ty) do { if (PROF_SEL >= 0 && blockIdx.x == 0 && threadIdx.x == 0) { const unsigned long long now_ = __builtin_amdgcn_s_memrealtime(); if ((ty) == PROF_SEL) pfw[1] = pfw[1] + (now_ - pfw[0]); pfw[0] = now_; } } while (0)
    TICK(-2);
    const int G = gridDim.x, bx = blockIdx.x;
    float* X = p.out;
    const float* MOD = (const float*)(p.ws + WS_MOD);
    bf16* H = (bf16*)(p.ws + WS_H); bf16* U = (bf16*)(p.ws + WS_U); bf16* MRG = (bf16*)(p.ws + WS_MRG);

    if (EN(0) && IN(0)) { mod_phase(p, lds); convert_phase(p, lds); }
    SEAM(0); TICK(0);
    for (int l = 0; l < NL; ++l) {
        const int pb = 1 + l * 11;
        const float* xin = l == 0 ? p.in[0] : X;
        if (EN(1) && IN(pb + 0)) norm_phase<false, true>(p, l * 2, xin, lds);
        SEAM(pb + 0); TICK(1);
        if (EN(2) && IN(pb + 1)) {
            pg8::InOrderA S; S.init(H, D, (const bf16*)(p.ws + WS_WIN) + (size_t)l * ZN * D, D, T / 256, 10, G, bx);
            pg8::gemm_phase(lds, D, D, D, S, EpiZ{p.ws, 1.0f});
            pg8::InOrderG S8; S8.init(p.ws + WS_H8, D / 2, p.ws + WS_WIN8 + (size_t)l * ZG_W * D, D / 2, T / 256, 12, G, bx);
            pg8::gemm_phase<EpiZ, pg8::InOrderG, true>(lds, D / 2, D / 2, D / 2, S8, EpiZ{p.ws, 1.0f / 32.0f});
        }
        SEAM(pb + 1); TICK(2);
        if (EN(3) && IN(pb + 2)) mixer_phase(p, l, lds);
        SEAM(pb + 2); TICK(3);
        if (EN(4) && IN(pb + 3)) scan_pass1(p, lds);
        SEAM(pb + 3); TICK(4);
        if (EN(5) && IN(pb + 4)) scan_carry(p, lds);
        SEAM(pb + 4); TICK(5);
        if (EN(6) && IN(pb + 5)) scan_pass2(p, l, lds);
        SEAM(pb + 5); TICK(6);
        if (EN(7) && IN(pb + 6)) {
            pg8::StaticOrder S; S.init(U, D, (const bf16*)(p.ws + WS_WMIX) + (size_t)l * D * D, D, T / 256, D / 256, G, bx);
            pg8::gemm_phase(lds, D, D, D, S, EpiMix{(const bf16*)(p.ws + WS_ZG), MRG});
        }
        SEAM(pb + 6); TICK(7);
        if (EN(8) && IN(pb + 7)) {
            pg8::StaticOrder S; S.init(MRG, D, (const bf16*)(p.ws + WS_WO) + (size_t)l * D * D, D, T / 256, D / 256, G, bx);
            pg8::gemm_phase(lds, D, D, D, S, EpiRes{xin, X, MOD + (size_t)((l * 2) * 4) * 3072 + 2048});
        }
        SEAM(pb + 7); TICK(8);
        if (l == 0) {
            if (EN(9) && IN(9)) norm_phase<false>(p, 1, X, lds);
            SEAM(9); TICK(9);
            if (EN(10) && IN(10)) {
                pg8::StaticOrder S; S.init(H, D, (const bf16*)(p.ws + WS_W13), D, T / 256, 2 * DFF / 256, G, bx);
                pg8::gemm_phase(lds, D, D, D, S, EpiSwi{(bf16*)(p.ws + WS_HID), DFF, 0});
            }
            SEAM(10); TICK(10);
            if (EN(11) && IN(11)) {
                pg8::StaticOrder S; S.init((const bf16*)(p.ws + WS_HID), DFF, (const bf16*)(p.ws + WS_W2), DFF, T / 256, D / 256, G, bx);
                pg8::gemm_phase(lds, DFF, DFF, DFF, S, EpiRes{X, X, MOD + (size_t)(1 * 4) * 3072 + 2048});
            }
            SEAM(11); TICK(11);
        } else {
            if (EN(12) && IN(20)) { norm_phase<true>(p, 3, X, lds); TICK(17); convert_moe_phase(p, lds); }
            SEAM(20); TICK(12);
            if (EN(13) && IN(21)) dispatch_phase(p);
            SEAM(21); TICK(13);
            const unsigned* cnt = (const unsigned*)(p.ws + WS_CTL);
            for (int g = 0; g < MOE_NG; ++g) {
                if (EN(14) && IN(22 + 2 * g)) {
                    MoeOrder S; S.init(p.ws + WS_HS, D / 2, p.ws + WS_MW13, D / 2, (size_t)2 * DFE * D, cnt, g, 0, 2 * DFE / 256, G, bx);
                    pg8::gemm_phase<EpiSwi8, MoeOrder, true>(lds, D / 2, D / 2, D / 2, S, EpiSwi8{p.ws + WS_EH, DFE});
                }
                SEAM(22 + 2 * g); TICK(14);
                if (EN(15) && IN(23 + 2 * g)) {
                    MoeOrder S; S.init(p.ws + WS_EH, DFE / 2, p.ws + WS_MW2, DFE / 2, (size_t)D * DFE, cnt, g, 1, D / 256, G, bx);
                    pg8::gemm_phase<EpiMoeDown, MoeOrder, true>(lds, DFE / 2, DFE / 2, DFE / 2, S, EpiMoeDown{(bf16*)(p.ws + WS_Y), (const int*)(p.ws + WS_ROWTK), (const float*)(p.ws + WS_ROWW)});
                }
                SEAM(23 + 2 * g); TICK(15);
            }
            if (EN(16) && IN(22 + 2 * MOE_NG)) final_phase<true>(p);
            TICK(16);
            if (PROF_SEL >= 0 && blockIdx.x == 0 && threadIdx.x == 0) { const unsigned long long t0_ = __builtin_amdgcn_s_memrealtime(); const unsigned long long w_ = 4ull * pfw[1]; while (__builtin_amdgcn_s_memrealtime() - t0_ < w_) __builtin_amdgcn_s_sleep(8); }
        }
    }
#undef IN
#undef SEAM
}
__global__ void k_fill(float* o, int n, float c) { int i = blockIdx.x * blockDim.x + threadIdx.x; if (i < n) o[i] = c; }

#ifndef ONE_LAUNCH
#define ONE_LAUNCH 1
#endif
extern "C" void kernel_launch(void* const* d_in, const int* in_sizes, int n_in, void* d_out, int out_size, void* d_ws, size_t ws_size, hipStream_t stream) {
    if (n_in != 39 || out_size != T * D || ws_size < WS_NEED) { hipLaunchKernelGGL(k_fill, dim3((out_size + 255) / 256), dim3(256), 0, stream, (float*)d_out, out_size, 3.0f); return; }
    static int grid = 0;
    if (!grid) {
        int dev = 0, cus = 0;
        (void)hipGetDevice(&dev); (void)hipDeviceGetAttribute(&cus, hipDeviceAttributeMultiprocessorCount, dev);
        (void)hipFuncSetAttribute((const void*)fwd, hipFuncAttributeMaxDynamicSharedMemorySize, LDS_BYTES);
        int per_cu = 0; (void)hipOccupancyMaxActiveBlocksPerMultiprocessor(&per_cu, (const void*)fwd, 512, LDS_BYTES);
        (void)hipGetLastError();
        grid = cus > 0 ? cus : 256;
    }
    Params p{};
    for (int i = 0; i < 39; ++i) p.in[i] = (const float*)d_in[i];
    p.out = (float*)d_out; p.ws = (unsigned char*)d_ws;
    (void)hipMemsetAsync((unsigned char*)d_ws + WS_CTL, 0, 32768, stream);
#if ONE_LAUNCH
    hipLaunchKernelGGL(fwd, dim3(grid), dim3(512), LDS_BYTES, stream, p, 0, NPH);
#else
    for (int k = 0; k < NPH; ++k) hipLaunchKernelGGL(fwd, dim3(grid), dim3(512), LDS_BYTES, stream, p, k, k + 1);
#endif
}
```
